# Optimizing an MI355X kernel written in HIP

```python
import jax, jax.numpy as jnp
from jax import lax
import numpy as np

D_MODEL = 2048
BATCH = 8
SEQ = 4096
DEPTH = 1
DEC_BATCH = 4
DEC_SEQ = 4096
PAST_LEN = 128

GRID_W = 64
HEAD_DIM = 128
NA_HEADS = 8
GQA_HEADS = 8
GQA_KV_HEADS = 2
NA_WIDTH = NA_HEADS * HEAD_DIM
GQA_WIDTH = GQA_HEADS * HEAD_DIM
KV_WIDTH = GQA_KV_HEADS * HEAD_DIM
NA_ROWS_MAX = 8
NA_COLS = 16
D_FF = 4 * D_MODEL
PLE_DIM = 256
ROPE_THETA = 10000.0
Q_BLOCK = 128
EPS = 1e-6
NEG_INF = -1e30
IN_COLS = 3 * NA_WIDTH + GQA_WIDTH + 2 * KV_WIDTH + 2 * D_MODEL

kernel_name = "hybrid_natten_gqa_encoder"


def rms_norm(x, g):
    xf = x.astype(jnp.float32)
    y = xf * lax.rsqrt(jnp.mean(xf * xf, axis=-1, keepdims=True) + EPS)
    return (y * g.astype(jnp.float32)).astype(x.dtype)


def neighbourhood_attention(q, k, v, rpb):
    B, S, H, Dh = q.shape
    rows = S // GRID_W
    kr = min(NA_ROWS_MAX, rows)
    r = jnp.arange(rows)
    c = jnp.arange(GRID_W)
    row_start = jnp.clip(r - kr // 2, 0, rows - kr)
    key_rows = row_start[:, None] + jnp.arange(kr)[None, :]
    col_start = jnp.clip(c - NA_COLS // 2, 0, GRID_W - NA_COLS)
    qg = q.reshape(B, rows, GRID_W, H, Dh)
    kg = k.reshape(B, rows, GRID_W, H, Dh)[:, key_rows]
    vg = v.reshape(B, rows, GRID_W, H, Dh)[:, key_rows]
    scale = Dh ** -0.5
    s = jnp.einsum('brqhd,brjkhd->brhqjk', qg.astype(jnp.float32) * scale,
                   kg.astype(jnp.float32))
    dr = key_rows - r[:, None]
    dc = jnp.clip(c[None, :] - c[:, None], -(NA_COLS - 1), NA_COLS - 1)
    bias = rpb[:, (dr + NA_ROWS_MAX - 1)[:, :, None, None],
               (dc + NA_COLS - 1)[None, None, :, :]]
    bias = bias.transpose(1, 0, 3, 2, 4).astype(jnp.float32)
    col_ok = (c[None, :] >= col_start[:, None]) & (c[None, :] < col_start[:, None] + NA_COLS)
    s = jnp.where(col_ok[:, None, :], s + bias[None], NEG_INF)
    p = jax.nn.softmax(s, axis=(-2, -1))
    out = jnp.einsum('brhqjk,brjkhd->brqhd', p.astype(v.dtype), vg)
    return out.reshape(B, S, H * Dh)


def rope_1d(x, pos):
    d = x.shape[-1]
    freqs = ROPE_THETA ** (-jnp.arange(0, d, 2, dtype=jnp.float32) / d)
    ang = pos.astype(jnp.float32)[:, None] * freqs[None, :]
    cos = jnp.cos(ang)[:, None, :]
    sin = jnp.sin(ang)[:, None, :]
    xf = x.astype(jnp.float32)
    x1, x2 = xf[..., : d // 2], xf[..., d // 2:]
    return jnp.concatenate([x1 * cos - x2 * sin, x2 * cos + x1 * sin], axis=-1).astype(x.dtype)


def axial_rope(x):
    S = x.shape[1]
    t = jnp.arange(S)
    half = x.shape[-1] // 2
    return jnp.concatenate([rope_1d(x[..., :half], t // GRID_W),
                            rope_1d(x[..., half:], t % GRID_W)], axis=-1)


def gqa_attention(q, k, v):
    B, S, Hq, Dh = q.shape
    Hkv = k.shape[2]
    G = Hq // Hkv
    nblk = S // Q_BLOCK
    scale = Dh ** -0.5
    qb = q.reshape(B, nblk, Q_BLOCK, Hkv, G, Dh).transpose(1, 0, 2, 3, 4, 5)
    kf = k.astype(jnp.float32)

    def attend(qblk):
        s = jnp.einsum('bqkgd,bskd->bkgqs', qblk.astype(jnp.float32) * scale, kf)
        p = jax.nn.softmax(s, axis=-1)
        return jnp.einsum('bkgqs,bskd->bqkgd', p.astype(v.dtype), v)

    out = lax.map(attend, qb)
    return out.transpose(1, 0, 2, 3, 4, 5).reshape(B, S, Hq * Dh)


def trunk(x, p, ln_mix_pre, w_in, q_norm, k_norm, na_rpb, w_na_branch, w_gqa_branch,
          w_mix_out, ln_mix_post, ln_mlp_pre, w_ff1, w_ff2, ln_mlp_post,
          ln_ple_pre, w_ple_gate, w_ple_proj, ln_ple_post):
    B, S, _ = x.shape
    splits = np.cumsum([NA_WIDTH, NA_WIDTH, NA_WIDTH, GQA_WIDTH, KV_WIDTH, KV_WIDTH, D_MODEL])
    for i in range(DEPTH):
        h = rms_norm(x, ln_mix_pre[i])
        proj = h @ w_in[i]
        na_q, na_k, na_v, g_q, g_k, g_v, gate_a, gate_b = jnp.split(proj, splits, axis=-1)
        a = neighbourhood_attention(na_q.reshape(B, S, NA_HEADS, HEAD_DIM),
                                    na_k.reshape(B, S, NA_HEADS, HEAD_DIM),
                                    na_v.reshape(B, S, NA_HEADS, HEAD_DIM), na_rpb[i])
        gq = axial_rope(rms_norm(g_q.reshape(B, S, GQA_HEADS, HEAD_DIM), q_norm[i]))
        gk = axial_rope(rms_norm(g_k.reshape(B, S, GQA_KV_HEADS, HEAD_DIM), k_norm[i]))
        b = gqa_attention(gq, gk, g_v.reshape(B, S, GQA_KV_HEADS, HEAD_DIM))
        merged = (jax.nn.sigmoid(gate_a) * (a @ w_na_branch[i])
                  + jax.nn.sigmoid(gate_b) * (b @ w_gqa_branch[i]))
        x = x + rms_norm(merged @ w_mix_out[i], ln_mix_post[i])
        h = rms_norm(x, ln_mlp_pre[i])
        f = jnp.square(jax.nn.relu(h @ w_ff1[i])) @ w_ff2[i]
        x = x + rms_norm(f, ln_mlp_post[i])
        gate = jax.nn.sigmoid(rms_norm(x, ln_ple_pre[i]) @ w_ple_gate[i])
        e = (p[i] @ w_ple_proj[i]) * gate
        x = x + rms_norm(e, ln_ple_post[i])
    return x


def setup_inputs(seed: int = 0) -> dict:
    key = jax.random.key(seed)
    ks = jax.random.split(key, 24)
    f32 = jnp.float32

    def dense(k, fan_in, fan_out):
        return jax.random.normal(k, (DEPTH, fan_in, fan_out), f32) * fan_in ** -0.5

    def gain(k, n):
        return 1.0 + 0.05 * jax.random.normal(k, (DEPTH, n), f32)

    return {
        "x_prompt": jax.random.normal(ks[0], (BATCH, SEQ, D_MODEL), f32),
        "x_sample": jax.random.normal(ks[1], (DEC_BATCH, DEC_SEQ, D_MODEL), f32),
        "p_prompt": jax.random.normal(ks[2], (DEPTH, BATCH, SEQ, PLE_DIM), f32),
        "p_sample": jax.random.normal(ks[3], (DEPTH, DEC_BATCH, DEC_SEQ, PLE_DIM), f32),
        "ln_mix_pre": gain(ks[4], D_MODEL),
        "w_in": dense(ks[5], D_MODEL, IN_COLS),
        "q_norm": gain(ks[6], HEAD_DIM),
        "k_norm": gain(ks[7], HEAD_DIM),
        "na_rpb": 0.1 * jax.random.normal(ks[8], (DEPTH, NA_HEADS, 2 * NA_ROWS_MAX - 1, 2 * NA_COLS - 1), f32),
        "w_na_branch": dense(ks[9], NA_WIDTH, D_MODEL),
        "w_gqa_branch": dense(ks[10], GQA_WIDTH, D_MODEL),
        "w_mix_out": dense(ks[11], D_MODEL, D_MODEL),
        "ln_mix_post": gain(ks[12], D_MODEL),
        "ln_mlp_pre": gain(ks[13], D_MODEL),
        "w_ff1": dense(ks[14], D_MODEL, D_FF),
        "w_ff2": dense(ks[15], D_FF, D_MODEL),
        "ln_mlp_post": gain(ks[16], D_MODEL),
        "ln_ple_pre": gain(ks[17], D_MODEL),
        "w_ple_gate": dense(ks[18], D_MODEL, D_MODEL),
        "w_ple_proj": dense(ks[19], PLE_DIM, D_MODEL),
        "ln_ple_post": gain(ks[20], D_MODEL),
    }


def reference(x_prompt, x_sample, p_prompt, p_sample, ln_mix_pre, w_in, q_norm, k_norm, na_rpb,
              w_na_branch, w_gqa_branch, w_mix_out, ln_mix_post, ln_mlp_pre, w_ff1, w_ff2,
              ln_mlp_post, ln_ple_pre, w_ple_gate, w_ple_proj, ln_ple_post):
    y_prompt = trunk(x_prompt, p_prompt, ln_mix_pre, w_in, q_norm, k_norm, na_rpb, w_na_branch,
                     w_gqa_branch, w_mix_out, ln_mix_post, ln_mlp_pre, w_ff1, w_ff2, ln_mlp_post,
                     ln_ple_pre, w_ple_gate, w_ple_proj, ln_ple_post)
    y_sample = trunk(x_sample, p_sample, ln_mix_pre, w_in, q_norm, k_norm, na_rpb, w_na_branch,
                     w_gqa_branch, w_mix_out, ln_mix_post, ln_mlp_pre, w_ff1, w_ff2, ln_mlp_post,
                     ln_ple_pre, w_ple_gate, w_ple_proj, ln_ple_post)
    return (y_prompt, y_sample)
```

```cpp
#include <hip/hip_runtime.h>
#include <hip/hip_cooperative_groups.h>
#include <hip/hip_bf16.h>
#include <cstdio>
#include <cstdint>
namespace cg = cooperative_groups;
namespace pg8 {
#define PG8_LAS __attribute__((address_space(3)))
typedef unsigned short bf16_t;
typedef short bf16x8 __attribute__((ext_vector_type(8)));
typedef float f32x4 __attribute__((ext_vector_type(4)));
typedef unsigned u32x4 __attribute__((ext_vector_type(4)));
constexpr int BM = 256, BK = 64, HALF = 128, HTB = HALF * BK * 2  , STAGE_BYTES = 8 * HTB, NXCD = 8, WGM = 8;

__host__ __device__ __forceinline__ int lds_byte(int r, int c) { const int st = (r >> 4) * 2 + (c >> 5), rr = r & 15, cc = c & 31, ob = rr * 64 + cc * 2; return st * 1024 + (ob ^ (((ob >> 9) & 1) << 5)); }
__host__ __device__ __forceinline__ void stage_rc(int b, int& R, int& C) { const int st = b / 1024, sb = b % 1024, swz = sb ^ (((sb >> 9) & 1) << 5); R = (st >> 1) * 16 + swz / 64; C = (st & 1) * 32 + (swz % 64) / 2; }
__host__ __device__ __forceinline__ int perm32(int rho) { const int n = rho >> 4, i = rho & 15; return 8 * (i >> 2) + 4 * n + (i & 3); }

struct Unit { int pm, pn, seg; };
struct Gemm { const bf16_t* A; const bf16_t* Bt; int M, N, K, lda, ldb; size_t segA = 0, segB = 0; };

struct StaticOrder {
    int nM, nN, nwg, G, c;
    __host__ __device__ void init(int M, int N, int G_, int c_) { nM = M / BM; nN = N / BM; nwg = nM * nN; G = G_; c = c_; }
    __host__ __device__ bool next(int i, Unit& u) const {
        const long L = (long)i * G + c; if (L >= nwg) return false;
        int wgid = (int)L; { const int q = nwg / NXCD, r = nwg % NXCD, xcd = wgid % NXCD, off = wgid / NXCD; wgid = (xcd < r ? xcd * (q + 1) : r * (q + 1) + (xcd - r) * q) + off; }
        const int nig = WGM * nN, gid = wgid / nig, fm = gid * WGM, gsz = (nM - fm) < WGM ? (nM - fm) : WGM;
        u.pm = fm + ((wgid % nig) % gsz); u.pn = (wgid % nig) / gsz; u.seg = 0; return true;
    }
    __device__ __forceinline__ void a_ready(const Unit&) const {}
    __device__ __forceinline__ void done(const Unit&) const {}
};

__device__ __forceinline__ unsigned cvt_pk_bf16(float lo, float hi) { unsigned r; asm volatile("v_cvt_pk_bf16_f32 %0, %1, %2" : "=v"(r) : "v"(lo), "v"(hi)); return r; }
typedef float f32x2 __attribute__((ext_vector_type(2)));
__device__ __forceinline__ f32x2 gelu_pk(f32x2 v) {
    const f32x2 av = __builtin_elementwise_abs(v), d = av * 0.2316418882f + 1.0f;
    f32x2 t; t.x = __builtin_amdgcn_rcpf(d.x); t.y = __builtin_amdgcn_rcpf(d.y);
    f32x2 q = t * 0.5307027145f + (-0.7265760135f); q = q * t + 0.7107068705f; q = q * t + (-0.142248368f); q = q * t + 0.127414796f; q = q * t;
    const f32x2 s = (v * v) * (-0.72134752044f);
    f32x2 e; e.x = __builtin_amdgcn_exp2f(s.x); e.y = __builtin_amdgcn_exp2f(s.y);
    const f32x2 m = v * (q * e), r = v - m;
    f32x2 o; o.x = v.x < 0.f ? m.x : r.x; o.y = v.y < 0.f ? m.y : r.y; return o;
}

template <int ACT  > struct EpiBf16 {
    static constexpr bool PERM = true, AFTER_DRAIN = false; static_assert(ACT == 0 || ACT == 1, "EpiBf16: ACT is 0 (none) or 1 (gelu_pk)");
    bf16_t* O; int ldc; const float* bias; int split_cols; size_t split_stride; float scale0;
    __device__ __forceinline__ void operator()(const f32x4 (&acc)[2][2][4][2], const Unit& u, int wr, int wc, int fr, int fq) const {
        const int row0 = u.pm * BM + wr * 64 + fr; int colt = u.pn * BM; bf16_t* base = O;
        float sc = 1.f; if (split_cols) { const int t = colt / split_cols; base += (size_t)t * split_stride; colt -= t * split_cols; if (t == 0) sc = scale0; }
        const int col0 = colt + wc * 32 + 8 * fq, bcol0 = u.pn * BM + wc * 32 + 8 * fq;
        f32x4 bv[2][2];
#pragma unroll
        for (int bj = 0; bj < 2; ++bj)
#pragma unroll
            for (int n = 0; n < 2; ++n) bv[bj][n] = bias ? *(const f32x4*)(bias + bcol0 + bj * HALF + 4 * n) : (f32x4){0.f, 0.f, 0.f, 0.f};
#pragma unroll
        for (int ai = 0; ai < 2; ++ai)
#pragma unroll
            for (int m = 0; m < 4; ++m) { bf16_t* rowp = base + (size_t)(row0 + ai * HALF + m * 16) * ldc + col0;
#pragma unroll
                for (int bj = 0; bj < 2; ++bj) { f32x4 v0 = acc[ai][bj][m][0] + bv[bj][0], v1 = acc[ai][bj][m][1] + bv[bj][1];
                    if (ACT == 1) { f32x2 a = gelu_pk((f32x2){v0[0], v0[1]}), b = gelu_pk((f32x2){v0[2], v0[3]}), c = gelu_pk((f32x2){v1[0], v1[1]}), d = gelu_pk((f32x2){v1[2], v1[3]});
                        v0 = (f32x4){a.x, a.y, b.x, b.y}; v1 = (f32x4){c.x, c.y, d.x, d.y}; }
                    v0 = v0 * sc; v1 = v1 * sc; u32x4 w; w.x = cvt_pk_bf16(v0[0], v0[1]); w.y = cvt_pk_bf16(v0[2], v0[3]); w.z = cvt_pk_bf16(v1[0], v1[1]); w.w = cvt_pk_bf16(v1[2], v1[3]);
                    *(u32x4*)(rowp + bj * HALF) = w; } }
    }
};
template <class Epi, class Sched, bool ALIGN_EPI = false, bool SP2 = false>
__device__ __forceinline__ void gemm_phase(PG8_LAS unsigned char* lds, const Gemm g, const Sched& S, const Epi& E) {
    int tid_l = threadIdx.x; asm volatile("" : "+v"(tid_l));
    const int tid = tid_l, wid = __builtin_amdgcn_readfirstlane(tid >> 6), lane = tid & 63, wr = wid >> 2, wc = wid & 3, fr = lane & 15, fq = lane >> 4;
    const int K = g.K, nt = K / BK;
    unsigned voffA[2], voffB[2];
#pragma unroll
    for (int i = 0; i < 2; ++i) { int R, C; stage_rc(tid * 16 + i * 8192, R, C); const int Rb = Epi::PERM ? ((R & ~31) + perm32(R & 31)) : R;
        voffA[i] = (unsigned)(R * g.lda + C) * 2u; voffB[i] = (unsigned)(Rb * g.ldb + C) * 2u; }
    const size_t kstep = (size_t)(BK * 2);
    const size_t hstepA = (size_t)HALF * g.lda * 2, hstepB = (size_t)HALF * g.ldb * 2;
    const size_t tstepA = 2 * hstepA, tstepB = 2 * hstepB;
    const unsigned ldsw = (unsigned)wid * 1024u;
    const int aoff = lds_byte(wr * 64 + fr, fq * 8), boff = lds_byte(wc * 32 + fr, fq * 8);
#define PG8_SA(b, h) (((b) * 2 + (h)) * HTB)
#define PG8_SB(b, h) ((4 + (b) * 2 + (h)) * HTB)
#define PG8_STAGE(bufoff, gbase, voff) do { _Pragma("unroll") for (int _i = 0; _i < 2; ++_i) \
        __builtin_amdgcn_global_load_lds((const unsigned*)((const char*)(gbase) + (voff)[_i]), (PG8_LAS unsigned*)(lds + (bufoff) + ldsw + _i * 8192), 16, 0, 0); } while (0)
#define PG8_LDA(dst, b, h) do { _Pragma("unroll") for (int m = 0; m < 4; ++m) _Pragma("unroll") for (int k = 0; k < 2; ++k) dst[m][k] = *(const PG8_LAS bf16x8*)(lds + PG8_SA(b, h) + aoff + m * 2048 + k * 1024); } while (0)
#define PG8_LDB(dst, b, h) do { _Pragma("unroll") for (int n = 0; n < 2; ++n) _Pragma("unroll") for (int k = 0; k < 2; ++k) dst[n][k] = *(const PG8_LAS bf16x8*)(lds + PG8_SB(b, h) + boff + n * 2048 + k * 1024); } while (0)
#define PG8_MMA(ai, bj, At, Bt) do { __builtin_amdgcn_s_setprio(1); _Pragma("unroll") for (int m = 0; m < 4; ++m) _Pragma("unroll") for (int n = 0; n < 2; ++n) _Pragma("unroll") for (int k = 0; k < 2; ++k) \
        acc[ai][bj][m][n] = __builtin_amdgcn_mfma_f32_16x16x32_bf16(Bt[n][k], At[m][k], acc[ai][bj][m][n], 0, 0, 0); __builtin_amdgcn_s_setprio(0); } while (0)
#define PG8_WAIT_V(n) asm volatile("s_waitcnt vmcnt(" #n ")" ::: "memory")
#define PG8_WAIT_L(n) asm volatile("s_waitcnt lgkmcnt(" #n ")" ::: "memory")
#define PG8_BAR __builtin_amdgcn_s_barrier()
#define PG8_SCHED __builtin_amdgcn_sched_barrier(0)
    Unit cur, nxt; int ui = 0;
    if (!S.next(0, cur)) return;
    f32x4 acc[2][2][4][2];
#pragma unroll
    for (int a = 0; a < 2; ++a)
#pragma unroll
        for (int b = 0; b < 2; ++b)
#pragma unroll
            for (int m = 0; m < 4; ++m)
#pragma unroll
                for (int n = 0; n < 2; ++n) acc[a][b][m][n] = (f32x4){0.f, 0.f, 0.f, 0.f};
    bf16x8 At[4][2], B0[2][2], B1[2][2];
    const char* cA = (const char*)g.A + (size_t)cur.seg * g.segA + (size_t)cur.pm * tstepA; const char* cB = (const char*)g.Bt + (size_t)cur.seg * g.segB + (size_t)cur.pn * tstepB;
    S.a_ready(cur);
    if constexpr (SP2) {
        PG8_STAGE(PG8_SB(0, 0), cB, voffB); PG8_STAGE(PG8_SB(0, 1), cB + hstepB, voffB); PG8_STAGE(PG8_SA(0, 0), cA, voffA); PG8_STAGE(PG8_SA(0, 1), cA + hstepA, voffA);
        if (wr == 1) PG8_BAR;
        PG8_WAIT_V(2); PG8_BAR;
        PG8_STAGE(PG8_SB(1, 0), cB + kstep, voffB); PG8_STAGE(PG8_SA(1, 0), cA + kstep, voffA); PG8_STAGE(PG8_SB(1, 1), cB + hstepB + kstep, voffB);
        PG8_WAIT_V(6); PG8_BAR;
    } else {
        PG8_STAGE(PG8_SB(0, 0), cB, voffB); PG8_STAGE(PG8_SA(0, 0), cA, voffA); PG8_STAGE(PG8_SB(0, 1), cB + hstepB, voffB); PG8_STAGE(PG8_SA(0, 1), cA + hstepA, voffA);
        if (wr == 1) PG8_BAR;
        PG8_WAIT_V(4); PG8_BAR;
        PG8_STAGE(PG8_SB(1, 0), cB + kstep, voffB); PG8_STAGE(PG8_SA(1, 0), cA + kstep, voffA); PG8_STAGE(PG8_SB(1, 1), cB + hstepB + kstep, voffB);
        PG8_WAIT_V(6); PG8_BAR;
    }
    for (;;) {
        const bool has_next = S.next(ui + 1, nxt);
        const char* nA = has_next ? (const char*)g.A + (size_t)nxt.seg * g.segA + (size_t)nxt.pm * tstepA : cA; const char* nB = has_next ? (const char*)g.Bt + (size_t)nxt.seg * g.segB + (size_t)nxt.pn * tstepB : cB;
        for (int t = 0; t < nt; t += 2) {
            const bool last = (t == nt - 2);
            const char* a1 = cA + (size_t)(t + 1) * kstep;
            const char* a2 = last ? nA : cA + (size_t)(t + 2) * kstep; const char* b2 = last ? nB : cB + (size_t)(t + 2) * kstep;
            const char* a3 = a2 + kstep; const char* b3 = b2 + kstep;
            if (last && has_next) S.a_ready(nxt);
            if constexpr (SP2) {
            PG8_LDB(B0, 0, 0); PG8_LDB(B1, 0, 1); PG8_SCHED; PG8_LDA(At, 0, 0); PG8_STAGE(PG8_SA(1, 1), a1 + hstepA, voffA);
            PG8_WAIT_V(8); PG8_WAIT_L(0); PG8_BAR; PG8_MMA(0, 0, At, B0); PG8_MMA(0, 1, At, B1); PG8_BAR; PG8_SCHED;
            PG8_LDA(At, 0, 1); PG8_STAGE(PG8_SB(0, 0), b2, voffB); PG8_STAGE(PG8_SB(0, 1), b2 + hstepB, voffB); PG8_STAGE(PG8_SA(0, 0), a2, voffA);
            PG8_WAIT_V(8); PG8_WAIT_L(0); PG8_BAR; PG8_MMA(1, 0, At, B0); PG8_MMA(1, 1, At, B1); PG8_BAR; PG8_SCHED;
            PG8_LDB(B0, 1, 0); PG8_LDB(B1, 1, 1); PG8_SCHED; PG8_LDA(At, 1, 0); PG8_STAGE(PG8_SA(0, 1), a2 + hstepA, voffA);
            PG8_WAIT_V(8); PG8_WAIT_L(0); PG8_BAR; PG8_MMA(0, 0, At, B0); PG8_MMA(0, 1, At, B1); PG8_BAR; PG8_SCHED;
            PG8_LDA(At, 1, 1); PG8_STAGE(PG8_SB(1, 0), b3, voffB); PG8_STAGE(PG8_SB(1, 1), b3 + hstepB, voffB); PG8_STAGE(PG8_SA(1, 0), a3, voffA);
            PG8_WAIT_V(8); PG8_WAIT_L(0); PG8_BAR; PG8_MMA(1, 0, At, B0); PG8_MMA(1, 1, At, B1); PG8_BAR; PG8_SCHED;
            } else {
            PG8_LDB(B0, 0, 0); PG8_SCHED; PG8_LDA(At, 0, 0); PG8_STAGE(PG8_SA(1, 1), a1 + hstepA, voffA);
            PG8_WAIT_L(8); PG8_BAR; PG8_WAIT_L(0); PG8_MMA(0, 0, At, B0); PG8_BAR; PG8_SCHED;
            PG8_LDB(B1, 0, 1); PG8_STAGE(PG8_SB(0, 0), b2, voffB);
            PG8_BAR; PG8_WAIT_L(0); PG8_MMA(0, 1, At, B1); PG8_BAR;
            PG8_LDA(At, 0, 1); PG8_STAGE(PG8_SA(0, 0), a2, voffA);
            PG8_BAR; PG8_WAIT_L(0); PG8_MMA(1, 0, At, B0); PG8_BAR; PG8_SCHED;
            PG8_STAGE(PG8_SB(0, 1), b2 + hstepB, voffB);
            PG8_WAIT_V(6); PG8_BAR; PG8_MMA(1, 1, At, B1); PG8_BAR;
            PG8_LDB(B0, 1, 0); PG8_SCHED; PG8_LDA(At, 1, 0); PG8_STAGE(PG8_SA(0, 1), a2 + hstepA, voffA);
            PG8_WAIT_L(8); PG8_BAR; PG8_WAIT_L(0); PG8_MMA(0, 0, At, B0); PG8_BAR; PG8_SCHED;
            PG8_LDB(B1, 1, 1); PG8_STAGE(PG8_SB(1, 0), b3, voffB);
            PG8_BAR; PG8_WAIT_L(0); PG8_MMA(0, 1, At, B1); PG8_BAR;
            PG8_LDA(At, 1, 1); PG8_STAGE(PG8_SA(1, 0), a3, voffA);
            PG8_BAR; PG8_WAIT_L(0); PG8_MMA(1, 0, At, B0); PG8_BAR; PG8_SCHED;
            PG8_STAGE(PG8_SB(1, 1), b3 + hstepB, voffB);
            PG8_WAIT_V(6); PG8_BAR; PG8_MMA(1, 1, At, B1); PG8_BAR;
            }
        }
        if constexpr (ALIGN_EPI) { if (wr == 0) PG8_BAR; }
        bool keep_acc = false;
        if constexpr (!Epi::AFTER_DRAIN) { if constexpr (Epi::SEG) { if (cur.seg == 0) { E.mid(acc, cur, wr, wc, fr, fq); keep_acc = true; } else E(acc, cur, wr, wc, fr, fq); } else E(acc, cur, wr, wc, fr, fq); S.done(cur); }
        if (!has_next) break;
        if (!keep_acc)
#pragma unroll
        for (int a = 0; a < 2; ++a)
#pragma unroll
            for (int b = 0; b < 2; ++b)
#pragma unroll
                for (int m = 0; m < 4; ++m)
#pragma unroll
                    for (int n = 0; n < 2; ++n) acc[a][b][m][n] = (f32x4){0.f, 0.f, 0.f, 0.f};
        cur = nxt; cA = nA; cB = nB; ++ui;
        if constexpr (ALIGN_EPI) { if (wr == 1) PG8_BAR; }
    }
    PG8_WAIT_V(0);
    if constexpr (!ALIGN_EPI) { if (wr == 0) PG8_BAR; }
    PG8_BAR;
    if constexpr (Epi::AFTER_DRAIN) { E.fused(acc, cur, wr, wc, fr, fq, lds, wid, lane); S.done(cur); }
#undef PG8_SA
#undef PG8_SB
#undef PG8_STAGE
#undef PG8_LDA
#undef PG8_LDB
#undef PG8_MMA
#undef PG8_WAIT_V
#undef PG8_WAIT_L
#undef PG8_BAR
#undef PG8_SCHED
}
}
namespace pg8 {
__device__ __forceinline__ float bf_lo(unsigned u) { return __uint_as_float(u << 16); }
__device__ __forceinline__ float bf_hi(unsigned u) { return __uint_as_float(u & 0xffff0000u); }
__device__ __forceinline__ float sigm(float x) { return __builtin_amdgcn_rcpf(1.f + __builtin_amdgcn_exp2f(-1.4426950408889634f * x)); }
template <int MODE> struct EpiX {
    static constexpr bool PERM = true, AFTER_DRAIN = false, SEG = false;
    bf16_t* O; int ldc; const bf16_t* G; int ldg; const float* RS = nullptr;
    __device__ __forceinline__ void operator()(const f32x4 (&acc)[2][2][4][2], const Unit& u, int wr, int wc, int fr, int fq) const {
        const int row0 = u.pm * BM + wr * 64 + fr; const int col0 = u.pn * BM + wc * 32 + 8 * fq;
#pragma unroll
        for (int ai = 0; ai < 2; ++ai)
#pragma unroll
            for (int m = 0; m < 4; ++m) { const size_t row = (size_t)(row0 + ai * HALF + m * 16);
#pragma unroll
                for (int bj = 0; bj < 2; ++bj) { const int col = col0 + bj * HALF;
                    const f32x4 a0 = acc[ai][bj][m][0], a1 = acc[ai][bj][m][1];
                    float v[8] = {a0[0], a0[1], a0[2], a0[3], a1[0], a1[1], a1[2], a1[3]};
                    bf16_t* op = O + row * ldc + col;
                    if (MODE == 5) op = O + ((((size_t)(col >> 12) * 64 + ((col >> 6) & 63)) * 8 + (row >> 7)) * 128 + (row & 127)) * 64 + (col & 63);
                    if (MODE == 1) {
                        const float rs = RS[row], rs2 = rs * rs;
#pragma unroll
                        for (int i = 0; i < 8; ++i) { const float r = fmaxf(v[i], 0.f); v[i] = r * r * rs2; } }
                    if (MODE == 2 || MODE == 3) { const u32x4 gw = *(const u32x4*)(G + row * ldg + col);
                        const float gf[8] = {bf_lo(gw.x), bf_hi(gw.x), bf_lo(gw.y), bf_hi(gw.y), bf_lo(gw.z), bf_hi(gw.z), bf_lo(gw.w), bf_hi(gw.w)};
#pragma unroll
                        for (int i = 0; i < 8; ++i) v[i] = sigm(gf[i]) * v[i]; }
                    if (MODE == 3) { const u32x4 ow = *(const u32x4*)op;
                        const float of[8] = {bf_lo(ow.x), bf_hi(ow.x), bf_lo(ow.y), bf_hi(ow.y), bf_lo(ow.z), bf_hi(ow.z), bf_lo(ow.w), bf_hi(ow.w)};
#pragma unroll
                        for (int i = 0; i < 8; ++i) v[i] += of[i]; }
                    if (MODE == 4) { const u32x4 ow = *(const u32x4*)op;
                        const float of[8] = {bf_lo(ow.x), bf_hi(ow.x), bf_lo(ow.y), bf_hi(ow.y), bf_lo(ow.z), bf_hi(ow.z), bf_lo(ow.w), bf_hi(ow.w)};
                        const float rs = RS[row];
#pragma unroll
                        for (int i = 0; i < 8; ++i) v[i] = of[i] * sigm(v[i] * rs); }
                    u32x4 w; w.x = cvt_pk_bf16(v[0], v[1]); w.y = cvt_pk_bf16(v[2], v[3]); w.z = cvt_pk_bf16(v[4], v[5]); w.w = cvt_pk_bf16(v[6], v[7]);
                    *(u32x4*)op = w; }
                if (MODE >= 2) asm volatile("" ::: "memory"); }
    }
};

struct SegOrder { StaticOrder base;
    __device__ bool next(int i, Unit& u) const { if (!base.next(i >> 1, u)) return false; u.seg = i & 1; return true; }
    __device__ __forceinline__ void a_ready(const Unit&) const {}
    __device__ __forceinline__ void done(const Unit&) const {} };
struct EpiGate {
    static constexpr bool PERM = true, AFTER_DRAIN = false, SEG = true;
    bf16_t* O; int ldc; const bf16_t* GA; const bf16_t* GB; int ldg;
    static __device__ __forceinline__ float eneg(float x) { return __builtin_amdgcn_exp2f(-1.4426950408889634f * fminf(fmaxf(x, -30.f), 30.f)); }
    __device__ __forceinline__ void mid(f32x4 (&acc)[2][2][4][2], const Unit& u, int wr, int wc, int fr, int fq) const {
        const int row0 = u.pm * BM + wr * 64 + fr; const int col0 = u.pn * BM + wc * 32 + 8 * fq;
#pragma unroll
        for (int ai = 0; ai < 2; ++ai)
#pragma unroll
            for (int m = 0; m < 4; ++m) { const size_t row = (size_t)(row0 + ai * HALF + m * 16);
#pragma unroll
                for (int bj = 0; bj < 2; ++bj) { const int col = col0 + bj * HALF;
                    const u32x4 aw = *(const u32x4*)(GA + row * ldg + col), bw = *(const u32x4*)(GB + row * ldg + col);
                    const float ga[8] = {bf_lo(aw.x), bf_hi(aw.x), bf_lo(aw.y), bf_hi(aw.y), bf_lo(aw.z), bf_hi(aw.z), bf_lo(aw.w), bf_hi(aw.w)};
                    const float gb[8] = {bf_lo(bw.x), bf_hi(bw.x), bf_lo(bw.y), bf_hi(bw.y), bf_lo(bw.z), bf_hi(bw.z), bf_lo(bw.w), bf_hi(bw.w)};
                    float r[8];
#pragma unroll
                    for (int i = 0; i < 8; ++i) r[i] = (1.f + eneg(gb[i])) * __builtin_amdgcn_rcpf(1.f + eneg(ga[i]));
                    acc[ai][bj][m][0] = acc[ai][bj][m][0] * (f32x4){r[0], r[1], r[2], r[3]}; acc[ai][bj][m][1] = acc[ai][bj][m][1] * (f32x4){r[4], r[5], r[6], r[7]}; }
                asm volatile("" ::: "memory"); }
    }
    __device__ __forceinline__ void operator()(const f32x4 (&acc)[2][2][4][2], const Unit& u, int wr, int wc, int fr, int fq) const {
        const int row0 = u.pm * BM + wr * 64 + fr; const int col0 = u.pn * BM + wc * 32 + 8 * fq;
#pragma unroll
        for (int ai = 0; ai < 2; ++ai)
#pragma unroll
            for (int m = 0; m < 4; ++m) { const size_t row = (size_t)(row0 + ai * HALF + m * 16);
#pragma unroll
                for (int bj = 0; bj < 2; ++bj) { const int col = col0 + bj * HALF;
                    const u32x4 bw = *(const u32x4*)(GB + row * ldg + col);
                    const float gb[8] = {bf_lo(bw.x), bf_hi(bw.x), bf_lo(bw.y), bf_hi(bw.y), bf_lo(bw.z), bf_hi(bw.z), bf_lo(bw.w), bf_hi(bw.w)};
                    const f32x4 a0 = acc[ai][bj][m][0], a1 = acc[ai][bj][m][1];
                    float v[8] = {a0[0], a0[1], a0[2], a0[3], a1[0], a1[1], a1[2], a1[3]};
#pragma unroll
                    for (int i = 0; i < 8; ++i) v[i] *= __builtin_amdgcn_rcpf(1.f + eneg(gb[i]));
                    u32x4 w; w.x = cvt_pk_bf16(v[0], v[1]); w.y = cvt_pk_bf16(v[2], v[3]); w.z = cvt_pk_bf16(v[4], v[5]); w.w = cvt_pk_bf16(v[6], v[7]);
                    *(u32x4*)(O + row * ldc + col) = w; }
                asm volatile("" ::: "memory"); }
    }
};
}
namespace gqa {
using bf16 = __hip_bfloat16;
constexpr int   D = 128, NW = 8, QBLK = 32, KVBLK = 64;
constexpr float SCALE = 0.088388347648318440f;
constexpr float THR = 8.f;
using f32x4 = __attribute__((ext_vector_type(4))) float;
constexpr int SDEPTH = 1;
constexpr int LDQ = 7680, LDK = 256, LDO = 1024;
constexpr size_t SHM_V = KVBLK * D * 2, SHM_K = KVBLK * D * 2, SHM_ATTN = 2 * SHM_V + 2 * SHM_K + NW * 64 * 4;
using bf16x8 = __attribute__((ext_vector_type(8))) short;
using s16x4  = __attribute__((ext_vector_type(4))) short;
using f32x16 = __attribute__((ext_vector_type(16))) float;
using f32x8  = __attribute__((ext_vector_type(8))) float;
using u32x4  = __attribute__((ext_vector_type(4))) unsigned;
#define KSWZ(row, colB) ((row) * 256 + ((colB) ^ (((row) & 7) << 4)))
#define SBAR() __builtin_amdgcn_sched_barrier(0)
__device__ __forceinline__ int crow(int r, int hi) { return (r & 3) + 8 * (r >> 2) + 4 * hi; }
__device__ __forceinline__ unsigned cvtpk(float lo, float hi) {
  unsigned r; asm volatile("v_cvt_pk_bf16_f32 %0, %1, %2" : "=v"(r) : "v"(lo), "v"(hi)); return r;
}
template <typename TIn> struct Stage;
template <> struct Stage<bf16>  { using T = bf16x8;
  __device__ static __forceinline__ T ld8(const bf16* p) { return *reinterpret_cast<const bf16x8*>(p); }
  __device__ static __forceinline__ bf16x8 tobf(T x) { return x; } };
template <> struct Stage<float> { using T = f32x8;
  __device__ static __forceinline__ T ld8(const float* p) { return *reinterpret_cast<const f32x8*>(p); }
  __device__ static __forceinline__ bf16x8 tobf(T x) {
    u32x4 w = {cvtpk(x[0], x[1]), cvtpk(x[2], x[3]), cvtpk(x[4], x[5]), cvtpk(x[6], x[7])}; return *reinterpret_cast<bf16x8*>(&w); } };

__device__ __forceinline__ void partialSM(f32x16& p0, f32x16& p1, float& m_reg, float& mn, float& alpha) {
  constexpr float C = SCALE * 1.4426950408889634f;
  float pmax = p0[0]; for (int r = 1; r < 16; ++r) pmax = fmaxf(pmax, p0[r]); for (int r = 0; r < 16; ++r) pmax = fmaxf(pmax, p1[r]);
  { auto rr = __builtin_amdgcn_permlane32_swap(__float_as_uint(pmax), __float_as_uint(pmax), false, false);
    pmax = fmaxf(__uint_as_float(rr[0]), __uint_as_float(rr[1])); }
  if (__builtin_expect(__all(pmax - m_reg <= THR / SCALE), 1)) { mn = m_reg; alpha = 1.f; }
  else { mn = fmaxf(m_reg, pmax); alpha = __builtin_amdgcn_exp2f((m_reg - mn) * C); m_reg = mn; }
  float mnC = -mn * C;
  for (int r = 0; r < 16; ++r) p0[r] = fmaf(p0[r], C, mnC); for (int r = 0; r < 16; ++r) p1[r] = fmaf(p1[r], C, mnC);
  for (int r = 0; r < 16; ++r) p0[r] = __builtin_amdgcn_exp2f(p0[r]);
}
__device__ __forceinline__ void finishSM(f32x16& p0, f32x16& p1, float alpha, float& l_reg, bf16x8& pa0, bf16x8& pa1, bf16x8& pa2, bf16x8& pa3) {
  for (int r = 0; r < 16; ++r) p1[r] = __builtin_amdgcn_exp2f(p1[r]);
  float ps = 0; for (int r = 0; r < 16; ++r) ps += p0[r]; for (int r = 0; r < 16; ++r) ps += p1[r];
  { auto rr = __builtin_amdgcn_permlane32_swap(__float_as_uint(ps), __float_as_uint(ps), false, false);
    ps = __uint_as_float(rr[0]) + __uint_as_float(rr[1]); }
  l_reg = l_reg * alpha + ps;
#define PK4(P, BASE, OUT) do { unsigned a0 = cvtpk(P[BASE + 0], P[BASE + 1]), a1 = cvtpk(P[BASE + 2], P[BASE + 3]);   \
    unsigned b0 = cvtpk(P[BASE + 4], P[BASE + 5]), b1 = cvtpk(P[BASE + 6], P[BASE + 7]);                              \
    auto r0 = __builtin_amdgcn_permlane32_swap(a0, b0, false, false); auto r1 = __builtin_amdgcn_permlane32_swap(a1, b1, false, false); \
    u32x4 w = {r0[0], r1[0], r0[1], r1[1]}; OUT = *reinterpret_cast<bf16x8*>(&w); } while (0)
  PK4(p0, 0, pa0); PK4(p0, 8, pa1); PK4(p1, 0, pa2); PK4(p1, 8, pa3);
#undef PK4
}
__device__ __forceinline__ void qkt(f32x16& p0, f32x16& p1, const bf16* Ks, const bf16x8* qr, int r32, int hi) {
  p0 = f32x16{}; p1 = f32x16{};
  for (int d0 = 0; d0 < 8; ++d0) { int cb = (d0 * 16 + hi * 8) * 2;
    bf16x8 b0 = *reinterpret_cast<const bf16x8*>((const char*)Ks + KSWZ(r32, cb));
    bf16x8 b1 = *reinterpret_cast<const bf16x8*>((const char*)Ks + KSWZ(32 + r32, cb));
    p0 = __builtin_amdgcn_mfma_f32_32x32x16_bf16(b0, qr[d0], p0, 0, 0, 0);
    p1 = __builtin_amdgcn_mfma_f32_32x32x16_bf16(b1, qr[d0], p1, 0, 0, 0); }
}
__device__ __forceinline__ int v_st(int k, int c) { const int kk = (k & ~0xC) | ((k & 4) << 1) | ((k & 8) >> 1); return ((kk >> 3) * 4 + (c >> 5)) * 512 + ((kk & 7) * 32 + (c & 31)) * 2; }
__device__ __forceinline__ int v_rd_base(int lane) { return ((lane & 3) << 3) | (((lane >> 2) & 3) << 6) | (((lane >> 4) & 1) << 5) | (((lane >> 5) & 1) << 8); }
constexpr int v_rd_off(int d0, int ks, int half) { return d0 * 512 + ks * 4096 + half * 2048; }
template <int OFF> __device__ __forceinline__ s16x4 tr_read(int vb) {
  s16x4 r; asm volatile("ds_read_b64_tr_b16 %0, %1 offset:%2" : "=&v"(r) : "v"(vb), "i"(OFF) : "memory"); return r;
}
template <int D0> __device__ __forceinline__ void pv_one(f32x16& od, int vb, bf16x8 pa0, bf16x8 pa1, bf16x8 pa2, bf16x8 pa3) {
  const s16x4 l0 = tr_read<v_rd_off(D0, 0, 0)>(vb), h0 = tr_read<v_rd_off(D0, 0, 1)>(vb), l1 = tr_read<v_rd_off(D0, 1, 0)>(vb), h1 = tr_read<v_rd_off(D0, 1, 1)>(vb);
  const s16x4 l2 = tr_read<v_rd_off(D0, 2, 0)>(vb), h2 = tr_read<v_rd_off(D0, 2, 1)>(vb), l3 = tr_read<v_rd_off(D0, 3, 0)>(vb), h3 = tr_read<v_rd_off(D0, 3, 1)>(vb);
  asm volatile("s_waitcnt lgkmcnt(0)" ::: "memory"); SBAR();
#define PK(L, H) (bf16x8){L[0], L[1], L[2], L[3], H[0], H[1], H[2], H[3]}
  od = __builtin_amdgcn_mfma_f32_32x32x16_bf16(pa0, PK(l0, h0), od, 0, 0, 0);
  od = __builtin_amdgcn_mfma_f32_32x32x16_bf16(pa1, PK(l1, h1), od, 0, 0, 0);
  od = __builtin_amdgcn_mfma_f32_32x32x16_bf16(pa2, PK(l2, h2), od, 0, 0, 0);
  od = __builtin_amdgcn_mfma_f32_32x32x16_bf16(pa3, PK(l3, h3), od, 0, 0, 0);
#undef PK
}
__device__ __forceinline__ void pv_d0(f32x16* o, int vb, bf16x8 pa0, bf16x8 pa1, bf16x8 pa2, bf16x8 pa3) {
  pv_one<0>(o[0], vb, pa0, pa1, pa2, pa3); pv_one<1>(o[1], vb, pa0, pa1, pa2, pa3); pv_one<2>(o[2], vb, pa0, pa1, pa2, pa3); pv_one<3>(o[3], vb, pa0, pa1, pa2, pa3);
}

template <typename TQ>
__device__ __forceinline__ void attn_dense_body(const TQ* Qb, const bf16* __restrict__ Kh, const bf16* __restrict__ Vh,
                                                bf16* Ob, int seq, char* lds, const float* __restrict__ qgain, const float* __restrict__ tab, int tok0) {
  using St = Stage<bf16>; using SQ = Stage<TQ>;
  int tid_l = threadIdx.x; asm volatile("" : "+v"(tid_l));
  const int tid = tid_l, wid = tid >> 6, lane = tid & 63, r32 = lane & 31, hi = lane >> 5;
  bf16* V_lds = (bf16*)lds; bf16* K_lds = (bf16*)(lds + 2 * SHM_V);
  float* ws = (float*)(lds + 2 * SHM_V + 2 * SHM_K) + wid * 64; float* li_l = ws; float* al_l = ws + 32;
  float m_reg = -1e30f, l_reg = 0; f32x16 o[4] = {}; bf16x8 qr[8];
  const TQ* Qw = Qb + (long)(wid * QBLK + r32) * LDQ + hi * 8;
  {
    float y[8][8]; float ss = 0.f;
#pragma unroll
    for (int d0 = 0; d0 < 8; ++d0) { const u32x4 w = *reinterpret_cast<const u32x4*>(Qw + d0 * 16);
      y[d0][0] = __uint_as_float(w.x << 16); y[d0][1] = __uint_as_float(w.x & 0xffff0000u); y[d0][2] = __uint_as_float(w.y << 16); y[d0][3] = __uint_as_float(w.y & 0xffff0000u);
      y[d0][4] = __uint_as_float(w.z << 16); y[d0][5] = __uint_as_float(w.z & 0xffff0000u); y[d0][6] = __uint_as_float(w.w << 16); y[d0][7] = __uint_as_float(w.w & 0xffff0000u);
#pragma unroll
      for (int j = 0; j < 8; ++j) ss += y[d0][j] * y[d0][j]; }
    { auto rr = __builtin_amdgcn_permlane32_swap(__float_as_uint(ss), __float_as_uint(ss), false, false); ss = __uint_as_float(rr[0]) + __uint_as_float(rr[1]); }
    const float rstd = __builtin_amdgcn_rsqf(ss * (1.f / 128.f) + 1e-6f);
#pragma unroll
    for (int d0 = 0; d0 < 8; ++d0) { const f32x4 ga = *reinterpret_cast<const f32x4*>(qgain + d0 * 16 + hi * 8), gb = *reinterpret_cast<const f32x4*>(qgain + d0 * 16 + hi * 8 + 4);
      y[d0][0] *= rstd * ga[0]; y[d0][1] *= rstd * ga[1]; y[d0][2] *= rstd * ga[2]; y[d0][3] *= rstd * ga[3]; y[d0][4] *= rstd * gb[0]; y[d0][5] *= rstd * gb[1]; y[d0][6] *= rstd * gb[2]; y[d0][7] *= rstd * gb[3]; }
    const int tok = tok0 + wid * QBLK + r32, prow = (tok >> 6) & 63, pcol = tok & 63;
#pragma unroll
    for (int hf = 0; hf < 2; ++hf) { const int pos = hf ? pcol : prow;
#pragma unroll
      for (int db = 0; db < 2; ++db) { const float* tp = tab + (pos * 32 + db * 16 + hi * 8) * 2;
        const f32x4 t0 = *reinterpret_cast<const f32x4*>(tp), t1 = *reinterpret_cast<const f32x4*>(tp + 4), t2 = *reinterpret_cast<const f32x4*>(tp + 8), t3 = *reinterpret_cast<const f32x4*>(tp + 12);
        const float cs[8] = {t0[0], t0[2], t1[0], t1[2], t2[0], t2[2], t3[0], t3[2]}, sn[8] = {t0[1], t0[3], t1[1], t1[3], t2[1], t2[3], t3[1], t3[3]};
#pragma unroll
        for (int j = 0; j < 8; ++j) { const float x1 = y[hf * 4 + db][j], x2 = y[hf * 4 + db + 2][j]; y[hf * 4 + db][j] = x1 * cs[j] - x2 * sn[j]; y[hf * 4 + db + 2][j] = x2 * cs[j] + x1 * sn[j]; } } }
#pragma unroll
    for (int d0 = 0; d0 < 8; ++d0) { u32x4 w = {cvtpk(y[d0][0], y[d0][1]), cvtpk(y[d0][2], y[d0][3]), cvtpk(y[d0][4], y[d0][5]), cvtpk(y[d0][6], y[d0][7])}; qr[d0] = *reinterpret_cast<bf16x8*>(&w); }
  }
  const int sr = tid >> 4, sc = (tid & 15) * 8, vst0 = v_st(sr, sc), vst1 = v_st(32 + sr, sc);
  const int vb0 = (int)(uintptr_t)V_lds + v_rd_base(lane);
  struct { typename St::T vs0, vs1, ks0, ks1; } sr_[SDEPTH];
  const unsigned voff0 = (unsigned)(sr * LDK + sc) * 2u, voff1 = voff0 + 32u * LDK * 2u;
#define SLOAD(i, k0) do { const char* vb_ = (const char*)Vh + (size_t)(k0) * (LDK * 2); const char* kb_ = (const char*)Kh + (size_t)(k0) * (LDK * 2); \
    sr_[i].vs0 = *(const bf16x8*)(vb_ + voff0); sr_[i].vs1 = *(const bf16x8*)(vb_ + voff1); \
    sr_[i].ks0 = *(const bf16x8*)(kb_ + voff0); sr_[i].ks1 = *(const bf16x8*)(kb_ + voff1); } while (0)
#define SWRITE(b, i) do { *(bf16x8*)((char*)V_lds + (b) * SHM_V + vst0) = St::tobf(sr_[i].vs0);          \
    *(bf16x8*)((char*)V_lds + (b) * SHM_V + vst1) = St::tobf(sr_[i].vs1); int kc = sc * 2;               \
    *(bf16x8*)((char*)K_lds + (b) * SHM_K + KSWZ(sr, kc)) = St::tobf(sr_[i].ks0);                       \
    *(bf16x8*)((char*)K_lds + (b) * SHM_K + KSWZ(32 + sr, kc)) = St::tobf(sr_[i].ks1); } while (0)
#define SWAIT() do { if constexpr (SDEPTH == 2) asm volatile("s_waitcnt vmcnt(4)" ::: "memory"); else asm volatile("s_waitcnt vmcnt(0)" ::: "memory"); } while (0)
#define RESC(a) do { if (__any((a) < 1.f)) { if (hi == 0) al_l[r32] = (a); asm volatile("s_waitcnt lgkmcnt(0)" ::: "memory"); \
    for (int d = 0; d < 4; ++d) for (int r = 0; r < 16; ++r) o[d][r] *= al_l[crow(r, hi)]; } } while (0)
  f32x16 pA0, pA1, pB0, pB1; float mnA, mnB, alA, alB; bf16x8 pa0, pa1, pa2, pa3; const int NT = seq / KVBLK;
  constexpr int SE = 0, SO = SDEPTH - 1;
  SLOAD(SE, 0); asm volatile("s_waitcnt vmcnt(0)" ::: "memory"); SWRITE(0, SE); __syncthreads();
  qkt(pA0, pA1, K_lds, qr, r32, hi); partialSM(pA0, pA1, m_reg, mnA, alA);
  SLOAD(SO, KVBLK); if constexpr (SDEPTH == 2) { if (2 < NT) SLOAD(SE, 2 * KVBLK); }
  SWAIT(); SWRITE(1, SO); __syncthreads();
  for (int j = 1; j + 1 < NT; j += 2) {
    SBAR(); qkt(pB0, pB1, (bf16*)((char*)K_lds + SHM_K), qr, r32, hi);
    finishSM(pA0, pA1, alA, l_reg, pa0, pa1, pa2, pa3); SBAR();
    SLOAD(SO, (j + SDEPTH) * KVBLK); SBAR();
    pv_d0(o, vb0, pa0, pa1, pa2, pa3); partialSM(pB0, pB1, m_reg, mnB, alB);
    __syncthreads(); SWAIT(); SWRITE(0, SE);
    RESC(alB); __syncthreads();
    SBAR(); qkt(pA0, pA1, K_lds, qr, r32, hi);
    finishSM(pB0, pB1, alB, l_reg, pa0, pa1, pa2, pa3); SBAR();
    if (SDEPTH == 1 || j + 3 < NT) SLOAD(SE, (j + 1 + SDEPTH) * KVBLK); SBAR();
    pv_d0(o, vb0 + (int)SHM_V, pa0, pa1, pa2, pa3); partialSM(pA0, pA1, m_reg, mnA, alA);
    __syncthreads(); SWAIT(); SWRITE(1, SO);
    RESC(alA); __syncthreads();
  }
  SBAR(); qkt(pB0, pB1, (bf16*)((char*)K_lds + SHM_K), qr, r32, hi);
  finishSM(pA0, pA1, alA, l_reg, pa0, pa1, pa2, pa3); SBAR();
  pv_d0(o, vb0, pa0, pa1, pa2, pa3); partialSM(pB0, pB1, m_reg, mnB, alB);
  __syncthreads(); RESC(alB);
  finishSM(pB0, pB1, alB, l_reg, pa0, pa1, pa2, pa3); SBAR();
  pv_d0(o, vb0 + (int)SHM_V, pa0, pa1, pa2, pa3);
  if (hi == 0) li_l[r32] = l_reg; asm volatile("s_waitcnt lgkmcnt(0)" ::: "memory");
  float rli[16];
#pragma unroll
  for (int r = 0; r < 16; ++r) rli[r] = __builtin_amdgcn_rcpf(li_l[crow(r, hi)]);
  bf16* Ow = Ob + (long)(wid * QBLK) * LDO;
#pragma unroll
  for (int r = 0; r < 16; ++r) { int orow = crow(r, hi);
    for (int d0 = 0; d0 < 4; ++d0) Ow[(long)orow * LDO + d0 * 32 + r32] = __builtin_bit_cast(bf16, (unsigned short)(cvtpk(o[d0][r] * rli[r], 0.f) & 0xffffu)); }
#undef SLOAD
#undef SWRITE
#undef SWAIT
#undef RESC
}
#undef KSWZ
#undef SBAR
}
#define LAS __attribute__((address_space(3)))
typedef unsigned short bf16_t;
typedef float f32x4 __attribute__((ext_vector_type(4)));
typedef unsigned u32x4 __attribute__((ext_vector_type(4)));
typedef unsigned u32x2 __attribute__((ext_vector_type(2)));
typedef short bf16x8 __attribute__((ext_vector_type(8)));

constexpr int T = 49152, TP = 32768, DM = 2048, SEQ = 4096, NBATCH = 12, DFF = 8192, PLE = 256;
constexpr int PP = 7680;
constexpr int C_NAQ = 0, C_NAK = 1024, C_GQ = 2048, C_GK = 3072, C_GV = 3328, C_GA = 3584, C_GB = 5632;
constexpr float EPS = 1e-6f;
constexpr size_t MiB = 1u << 20;
constexpr size_t WS_TAB = 0, WS_WIN = 1 * MiB, WS_WNA = 35 * MiB, WS_WGQA = 39 * MiB, WS_WMIX = 43 * MiB, WS_WFF1 = 51 * MiB, WS_WFF2 = 83 * MiB,
                 WS_WPG = 115 * MiB, WS_WPP = 123 * MiB, WS_PB = 124 * MiB, WS_VT = 148 * MiB, WS_PROJ = 244 * MiB, WS_END0 = 964 * MiB;
constexpr size_t WS_Y = 244 * MiB, WS_H = 436 * MiB, WS_HID = 628 * MiB, WS_EP = 628 * MiB, WS_END = 1012 * MiB;
constexpr int LDS_BYTES = 147456;
constexpr int NTHREADS = 512;

struct Params {
    const float* x_p; const float* x_s; const float* p_p; const float* p_s;
    const float* ln_mix_pre; const float* w_in; const float* q_norm; const float* k_norm; const float* na_rpb;
    const float* w_na; const float* w_gqa; const float* w_mix; const float* ln_mix_post; const float* ln_mlp_pre;
    const float* w_ff1; const float* w_ff2; const float* ln_mlp_post; const float* ln_ple_pre; const float* w_ple_gate; const float* w_ple_proj; const float* ln_ple_post;
    float* out; unsigned char* ws;
};

__device__ __forceinline__ unsigned pk_bf16(float lo, float hi) { unsigned r; asm volatile("v_cvt_pk_bf16_f32 %0, %1, %2" : "=v"(r) : "v"(lo), "v"(hi)); return r; }
__device__ __forceinline__ float bflo(unsigned u) { return __uint_as_float(u << 16); }
__device__ __forceinline__ float bfhi(unsigned u) { return __uint_as_float(u & 0xffff0000u); }
__device__ __forceinline__ float wave_sum(float v) {
#pragma unroll
    for (int o = 1; o < 64; o <<= 1) v += __shfl_xor(v, o);
    return v;
}

__device__ __forceinline__ void transpose_item(const float* W, int K, int N, bf16_t* WT, int k0, int n0, int drow0, LAS float* scr, int lane, const float* gk) {
#pragma unroll 8
    for (int i = 0; i < 32; ++i) { const int kk = 2 * i + (lane >> 5); scr[kk * 33 + (lane & 31)] = W[(size_t)(k0 + kk) * N + n0 + (lane & 31)] * (gk ? gk[k0 + kk] : 1.f); }
    asm volatile("s_waitcnt lgkmcnt(0)" ::: "memory");
    const int c = lane & 7;
#pragma unroll
    for (int j = 0; j < 4; ++j) { const int n = (lane >> 3) + 8 * j; const LAS float* s = scr + (8 * c) * 33 + n;
        u32x4 o; o.x = pk_bf16(s[0 * 33], s[1 * 33]); o.y = pk_bf16(s[2 * 33], s[3 * 33]); o.z = pk_bf16(s[4 * 33], s[5 * 33]); o.w = pk_bf16(s[6 * 33], s[7 * 33]);
        *(u32x4*)(WT + (size_t)(drow0 + n) * K + k0 + 8 * c) = o; }
    asm volatile("s_waitcnt lgkmcnt(0)" ::: "memory");
}
__device__ __forceinline__ bool transpose_mat(int& r, const float* W, int K, int N, bf16_t* WT, LAS float* scr, int lane, bool remap_in, const float* gk = nullptr) {
    const int nblk = N / 32, items = (K / 64) * nblk;
    if (r >= items) { r -= items; return false; }
    const int kb = r / nblk, nb = r % nblk, n0 = nb * 32;
    int d0 = n0;
    if (remap_in) d0 = (n0 < 2048) ? n0 : (n0 < 3072 ? n0 - 2048 + 7680 : n0 - 1024);
    transpose_item(W, K, N, WT, kb * 64, n0, d0, scr, lane, gk);
    return true;
}

__device__ __forceinline__ const float* xrow_in(const Params& P, int m) { return m < TP ? P.x_p + (size_t)m * DM : P.x_s + (size_t)(m - TP) * DM; }

template <int MODE>
__device__ __forceinline__ void row_pass(const Params& P, const bf16_t* Y, const bf16_t* XS, bf16_t* XB, float* RS, const float* g1, int gw, int ngw) {
    int tid_l = threadIdx.x; asm volatile("" : "+v"(tid_l)); const int lane = tid_l & 63;
    for (int m = gw; m < T; m += ngw) {
        float x[4][8];
        if (MODE == 0 || MODE == 1) { const float* base = xrow_in(P, m);
#pragma unroll
            for (int j = 0; j < 4; ++j) { const f32x4 a = *(const f32x4*)(base + j * 512 + lane * 8), b = *(const f32x4*)(base + j * 512 + lane * 8 + 4);
                x[j][0] = a[0]; x[j][1] = a[1]; x[j][2] = a[2]; x[j][3] = a[3]; x[j][4] = b[0]; x[j][5] = b[1]; x[j][6] = b[2]; x[j][7] = b[3]; }
        } else {
#pragma unroll
            for (int j = 0; j < 4; ++j) { const u32x4 w = *(const u32x4*)(XS + (size_t)m * DM + j * 512 + lane * 8);
                x[j][0] = bflo(w.x); x[j][1] = bfhi(w.x); x[j][2] = bflo(w.y); x[j][3] = bfhi(w.y); x[j][4] = bflo(w.z); x[j][5] = bfhi(w.z); x[j][6] = bflo(w.w); x[j][7] = bfhi(w.w); }
        }
        if (MODE != 0) {
            float y[4][8]; float ss = 0.f;
#pragma unroll
            for (int j = 0; j < 4; ++j) { const u32x4 w = *(const u32x4*)(Y + (size_t)m * DM + j * 512 + lane * 8);
                y[j][0] = bflo(w.x); y[j][1] = bfhi(w.x); y[j][2] = bflo(w.y); y[j][3] = bfhi(w.y); y[j][4] = bflo(w.z); y[j][5] = bfhi(w.z); y[j][6] = bflo(w.w); y[j][7] = bfhi(w.w);
#pragma unroll
                for (int i = 0; i < 8; ++i) ss += y[j][i] * y[j][i]; }
            const float rstd = __builtin_amdgcn_rsqf(wave_sum(ss) * (1.f / DM) + EPS);
#pragma unroll
            for (int j = 0; j < 4; ++j) { const f32x4 ga = *(const f32x4*)(g1 + j * 512 + lane * 8), gb = *(const f32x4*)(g1 + j * 512 + lane * 8 + 4);
                const float gg[8] = {ga[0], ga[1], ga[2], ga[3], gb[0], gb[1], gb[2], gb[3]};
#pragma unroll
                for (int i = 0; i < 8; ++i) x[j][i] += y[j][i] * rstd * gg[i]; }
        }
        if (MODE == 2) {
#pragma unroll
            for (int j = 0; j < 4; ++j) { float* o = P.out + (size_t)m * DM + j * 512 + lane * 8;
                *(f32x4*)o = (f32x4){x[j][0], x[j][1], x[j][2], x[j][3]}; *(f32x4*)(o + 4) = (f32x4){x[j][4], x[j][5], x[j][6], x[j][7]}; }
        } else {
            float ss = 0.f;
#pragma unroll
            for (int j = 0; j < 4; ++j)
#pragma unroll
                for (int i = 0; i < 8; ++i) ss += x[j][i] * x[j][i];
            const float rstd = __builtin_amdgcn_rsqf(wave_sum(ss) * (1.f / DM) + EPS);
            if (MODE == 0) {
#pragma unroll
                for (int j = 0; j < 4; ++j) { const f32x4 ga = *(const f32x4*)(g1 + j * 512 + lane * 8), gb = *(const f32x4*)(g1 + j * 512 + lane * 8 + 4);
                    u32x4 w; w.x = pk_bf16(x[j][0] * rstd * ga[0], x[j][1] * rstd * ga[1]); w.y = pk_bf16(x[j][2] * rstd * ga[2], x[j][3] * rstd * ga[3]);
                    w.z = pk_bf16(x[j][4] * rstd * gb[0], x[j][5] * rstd * gb[1]); w.w = pk_bf16(x[j][6] * rstd * gb[2], x[j][7] * rstd * gb[3]);
                    *(u32x4*)(XB + (size_t)m * DM + j * 512 + lane * 8) = w; }
            } else {
                if (lane == 0) RS[m] = rstd;
#pragma unroll
                for (int j = 0; j < 4; ++j) { u32x4 w; w.x = pk_bf16(x[j][0], x[j][1]); w.y = pk_bf16(x[j][2], x[j][3]); w.z = pk_bf16(x[j][4], x[j][5]); w.w = pk_bf16(x[j][6], x[j][7]);
                    *(u32x4*)(XB + (size_t)m * DM + j * 512 + lane * 8) = w; }
            }
        }
    }
}

__device__ __forceinline__ void qk_norm_rope(const Params& P, const bf16_t* PROJ, bf16_t* QC, bf16_t* KC, bf16_t* VC, const LAS float* tabl, int gw, int ngw, int lane_in) {
    (void)lane_in; int tid_l = threadIdx.x; asm volatile("" : "+v"(tid_l)); const int lane = tid_l & 63;
    const int hd4 = lane >> 4, c = lane & 15, half = c >> 3, isx2 = (c >> 2) & 1, i0 = (c & 3) * 8;
    float gq[8], gk[8];
#pragma unroll
    for (int i = 0; i < 8; ++i) { gq[i] = P.q_norm[c * 8 + i]; gk[i] = P.k_norm[c * 8 + i]; }
    for (int it0 = gw * 4; it0 < T; it0 += ngw * 4) {
        u32x4 wv[4];
#pragma unroll
        for (int k = 0; k < 4; ++k) { const int t = it0 + k, grp = 2;
            wv[k] = *(const u32x4*)(PROJ + (size_t)t * PP + C_GQ + (grp * 4 + hd4) * 128 + c * 8); }
#pragma unroll
        for (int k = 0; k < 4; ++k) {
            const int t = it0 + k, grp = 2;
            const u32x4 w = wv[k];
            float x[8] = {bflo(w.x), bfhi(w.x), bflo(w.y), bfhi(w.y), bflo(w.z), bfhi(w.z), bflo(w.w), bfhi(w.w)};
            float ss = 0.f;
#pragma unroll
            for (int i = 0; i < 8; ++i) ss += x[i] * x[i];
            ss += __shfl_xor(ss, 1); ss += __shfl_xor(ss, 2); ss += __shfl_xor(ss, 4); ss += __shfl_xor(ss, 8);
            const float rstd = __builtin_amdgcn_rsqf(ss * (1.f / 128.f) + EPS);
            const int sq = t & (SEQ - 1), pos = half ? (sq & 63) : (sq >> 6);
            const LAS float* tp = tabl + (pos * 32 + i0) * 2;
            float o[8];
#pragma unroll
            for (int i = 0; i < 8; ++i) { const float y = x[i] * rstd * (grp < 2 ? gq[i] : gk[i]); const float yp = __shfl_xor(y, 4);
                const float cs = tp[2 * i], sn = tp[2 * i + 1]; o[i] = isx2 ? (y * cs + yp * sn) : (y * cs - yp * sn); }
            u32x4 r; r.x = pk_bf16(o[0], o[1]); r.y = pk_bf16(o[2], o[3]); r.z = pk_bf16(o[4], o[5]); r.w = pk_bf16(o[6], o[7]);
            bf16_t* dst;
            if (grp < 2) dst = QC + (size_t)t * 1024 + (grp * 4 + hd4) * 128 + c * 8;
            else if (hd4 < 2) dst = KC + (size_t)t * 256 + hd4 * 128 + c * 8;
            else { dst = VC + (size_t)t * 256 + (hd4 - 2) * 128 + c * 8; r = w; }
            *(u32x4*)dst = r;
        }
    }
}

namespace na {
constexpr int KROW = 272, VROW = 144, VOFF = 64 * KROW, BUF = 36864, RPB_OFF = 2 * BUF, NA_LDS_END = RPB_OFF + 16384;
__device__ __forceinline__ void na_phase(const bf16_t* PROJ, const bf16_t* VT, const float* rpb, bf16_t* OUT, int opitch, int vcu, int G, LAS unsigned char* lds) {
    const int NU = NBATCH * 8 * 16, per = (NU + G - 1) / G;
    const bool xmap = (G == 256);
    const int ub = vcu * per, nun = xmap ? 6 : max(min(ub + per, NU) - ub, 0);
#define NA_UNIT(i) (xmap ? ((((vcu >> 5) * 12 + 2 * (i) + ((vcu & 31) >> 4)) << 4) + (vcu & 15)) : (ub + (i)))
    int tid_l = threadIdx.x; asm volatile("" : "+v"(tid_l));
    const int tid = tid_l, w = __builtin_amdgcn_readfirstlane(tid >> 6), lane = tid & 63, l15 = lane & 15, g = lane >> 4;
    const int qr = w >> 1, ch = w & 1;
    LAS float* rp = (LAS float*)(lds + RPB_OFF);
    for (int i = tid; i < 8 * 15 * 32; i += NTHREADS) { const int c31 = i & 31, hr = i >> 5; rp[i] = (c31 < 31) ? rpb[hr * 31 + c31] * 1.4426950408889634f : -1e30f; }
    if (nun <= 0) return;
    unsigned boff[2][8];
#pragma unroll
    for (int c2 = 0; c2 < 2; ++c2) { const int qc0 = 16 * (2 * ch + c2), cb = min(max(qc0 - 8, 0), 32), qcol = qc0 + l15, cs = min(max(qcol - 8, 0), 48);
#pragma unroll
        for (int e = 0; e < 8; ++e) { const int kc = cb + (e >> 2) * 16 + 4 * g + (e & 3); boff[c2][e] = ((kc >= cs) && (kc < cs + 16)) ? (unsigned)(kc - qcol + 15) * 4u : 124u; } }
    u32x4 st[3][4];
    unsigned koff[2], klds[2], vlds[2];
#pragma unroll
    for (int i_ = 0; i_ < 2; ++i_) { const int c_ = tid + 512 * i_;
        koff[i_] = (unsigned)((c_ >> 4) * PP + (c_ & 15) * 8) * 2u; klds[i_] = (unsigned)((c_ >> 4) * KROW + (c_ & 15) * 16);
        vlds[i_] = (unsigned)(VOFF + (c_ >> 3) * VROW + (c_ & 7) * 16); }
#define NA_DEC(uu) const int pr_ = (uu) >> 4, r0_ = 4 * ((uu) & 15), b_ = pr_ >> 3, hd_ = pr_ & 7, kr0_ = min(max(r0_ - 4, 0), 56), n_ = min(max(r0_ - 1, 0), 56) - kr0_ + 8
#define NA_LOADT(set, uu, t) do { NA_DEC(uu); { const int kr_ = min(kr0_ + (t), 63); (void)n_;     \
        const char* kb_ = (const char*)(PROJ + ((size_t)b_ * SEQ + (size_t)kr_ * 64) * PP + C_NAK + hd_ * 128); \
        const char* vb_ = (const char*)(VT + ((((size_t)b_ * 64 + kr_) * 8 + hd_) * 128) * 64); \
        st[set][0] = *(const u32x4*)(kb_ + koff[0]); st[set][1] = *(const u32x4*)(kb_ + koff[1]); \
        st[set][2] = *(const u32x4*)(vb_ + (unsigned)tid * 16u); st[set][3] = *(const u32x4*)(vb_ + (unsigned)(tid + 512) * 16u); } } while (0)
#define NA_WRITET(set, t) do { LAS unsigned char* bp_ = lds + ((t) & 1) * BUF; \
        *(LAS u32x4*)(bp_ + klds[0]) = st[set][0]; *(LAS u32x4*)(bp_ + klds[1]) = st[set][1]; *(LAS u32x4*)(bp_ + vlds[0]) = st[set][2]; *(LAS u32x4*)(bp_ + vlds[1]) = st[set][3]; } while (0)
    { const int u0 = NA_UNIT(0); NA_LOADT(0, u0, 0); NA_LOADT(1, u0, 1); NA_LOADT(2, u0, 2); }
    const float scale = 0.088388347648318440f, L2E = 1.4426950408889634f;
    for (int ui = 0; ui < nun; ++ui) {
        const bool has_next = (ui + 1 < nun);
        const int u = NA_UNIT(ui), un = has_next ? NA_UNIT(ui + 1) : u;
        const int pr = u >> 4, r0 = 4 * (u & 15), b = pr >> 3, head = pr & 7, kr0 = min(max(r0 - 4, 0), 56), n = min(max(r0 - 1, 0), 56) - kr0 + 8;
        const int r = r0 + qr, rsw = min(max(r - 4, 0), 56);
        const size_t tokq = (size_t)b * SEQ + r * 64;
        bf16x8 qf[2][4];
#pragma unroll
        for (int c2 = 0; c2 < 2; ++c2) { const bf16_t* qp = PROJ + (tokq + 16 * (2 * ch + c2) + l15) * PP + C_NAQ + head * 128 + 8 * g;
#pragma unroll
            for (int dc = 0; dc < 4; ++dc) qf[c2][dc] = *(const bf16x8*)(qp + dc * 32); }
#pragma unroll
        for (int c2 = 0; c2 < 2; ++c2)
#pragma unroll
            for (int dc = 0; dc < 4; ++dc) asm volatile("" : "+v"(qf[c2][dc]));
        float mrun[2] = {-1e30f, -1e30f}, lrun[2] = {0.f, 0.f};
        f32x4 O[2][8];
#pragma unroll
        for (int c2 = 0; c2 < 2; ++c2)
#pragma unroll
            for (int db = 0; db < 8; ++db) O[c2][db] = (f32x4){0.f, 0.f, 0.f, 0.f};
        const LAS unsigned char* rph = (const LAS unsigned char*)(rp + head * 480);
#pragma unroll
        for (int t = 0; t < 12; ++t) {
            NA_WRITET(t % 3, t);
            if (t + 3 < 12) NA_LOADT(t % 3, u, t + 3); else NA_LOADT(t % 3, un, t + 3 - 12);
            __syncthreads();
            const int kr = kr0 + t;
            if (kr >= rsw && kr < rsw + 8) {
                const LAS unsigned char* bp = lds + (t & 1) * BUF;
                const LAS unsigned char* brow = rph + (kr - r + 7) * 128;
#pragma unroll
                for (int c2 = 0; c2 < 2; ++c2) {
                    const int qc0 = 16 * (2 * ch + c2), cb = min(max(qc0 - 8, 0), 32);
                    const LAS unsigned char* kp = bp + (cb + l15) * KROW + 16 * g;
                    float bias[8];
#pragma unroll
                    for (int e = 0; e < 8; ++e) bias[e] = *(const LAS float*)(brow + boff[c2][e]);
                    f32x4 S[2];
#pragma unroll
                    for (int kb = 0; kb < 2; ++kb) { bf16x8 ka[4]; S[kb] = (f32x4){0.f, 0.f, 0.f, 0.f};
#pragma unroll
                        for (int dc = 0; dc < 4; ++dc) ka[dc] = *(const LAS bf16x8*)(kp + kb * 16 * KROW + dc * 64);
#pragma unroll
                        for (int dc = 0; dc < 4; ++dc) S[kb] = __builtin_amdgcn_mfma_f32_16x16x32_bf16(ka[dc], qf[c2][dc], S[kb], 0, 0, 0); }
                    float sv[8]; float tm = -1e30f;
#pragma unroll
                    for (int e = 0; e < 8; ++e) { sv[e] = fmaf(S[e >> 2][e & 3], scale * L2E, bias[e]); tm = fmaxf(tm, sv[e]); }
                    tm = fmaxf(tm, __shfl_xor(tm, 16)); tm = fmaxf(tm, __shfl_xor(tm, 32));
                    const float mn = fmaxf(mrun[c2], tm), alpha = __builtin_amdgcn_exp2f(mrun[c2] - mn);
                    mrun[c2] = mn;
                    float ps = 0.f;
#pragma unroll
                    for (int e = 0; e < 8; ++e) { const float p = __builtin_amdgcn_exp2f(sv[e] - mn); sv[e] = p; ps += p; }
                    lrun[c2] = lrun[c2] * alpha + ps;
                    if (__any(alpha != 1.f)) {
#pragma unroll
                        for (int db = 0; db < 8; ++db) O[c2][db] = O[c2][db] * alpha; }
                    u32x4 pw; pw.x = pk_bf16(sv[0], sv[1]); pw.y = pk_bf16(sv[2], sv[3]); pw.z = pk_bf16(sv[4], sv[5]); pw.w = pk_bf16(sv[6], sv[7]);
                    const bf16x8 pj = __builtin_bit_cast(bf16x8, pw);
                    const LAS unsigned char* vp = bp + VOFF + l15 * VROW + (cb + 4 * g) * 2;
#pragma unroll
                    for (int dh = 0; dh < 2; ++dh) { u32x2 vlo[4], vhi[4];
#pragma unroll
                        for (int d4 = 0; d4 < 4; ++d4) { vlo[d4] = *(const LAS u32x2*)(vp + (dh * 4 + d4) * 16 * VROW); vhi[d4] = *(const LAS u32x2*)(vp + (dh * 4 + d4) * 16 * VROW + 32); }
#pragma unroll
                        for (int d4 = 0; d4 < 4; ++d4) { const u32x4 aw = {vlo[d4].x, vlo[d4].y, vhi[d4].x, vhi[d4].y};
                            O[c2][dh * 4 + d4] = __builtin_amdgcn_mfma_f32_16x16x32_bf16(__builtin_bit_cast(bf16x8, aw), pj, O[c2][dh * 4 + d4], 0, 0, 0); } }
                }
            }
        }
#pragma unroll
        for (int c2 = 0; c2 < 2; ++c2) {
            float lt = lrun[c2]; lt += __shfl_xor(lt, 16); lt += __shfl_xor(lt, 32);
            const float inv = 1.f / lt;
            bf16_t* op = OUT + (tokq + 16 * (2 * ch + c2) + l15) * opitch + head * 128 + 4 * g;
#pragma unroll
            for (int db = 0; db < 8; ++db) { u32x2 o; o.x = pk_bf16(O[c2][db][0] * inv, O[c2][db][1] * inv); o.y = pk_bf16(O[c2][db][2] * inv, O[c2][db][3] * inv); *(u32x2*)(op + db * 16) = o; }
        }
    }
#undef NA_LOADT
#undef NA_WRITET
#undef NA_DEC
#undef NA_UNIT
}
}

#define XB_TMO      128
#define XB_XCNT(j)  (256  + 64 * (j))
#define XB_XSUB(j)  (1280 + 64 * (j))
#define XB_XGEN(j)  (2304 + 64 * (j))
#define XB_TOP      3328
#define XB_TOPGEN   3392
#define XCD_BAR_WORDS 3456
#define XB_SPIN_CAP (1u << 18)

__device__ __forceinline__ unsigned xb_ld(unsigned* p)              { return __hip_atomic_load(p, __ATOMIC_RELAXED, __HIP_MEMORY_SCOPE_AGENT); }
__device__ __forceinline__ unsigned xb_add(unsigned* p, unsigned v) { return __hip_atomic_fetch_add(p, v, __ATOMIC_RELAXED, __HIP_MEMORY_SCOPE_AGENT); }
__device__ __forceinline__ unsigned xb_xcc_id() { return (unsigned)__builtin_amdgcn_s_getreg((3 << 11) | 20) & 0xFu; }
#define XB_SPIN(cond, bar) do { unsigned _sp = 0; while (cond) { __builtin_amdgcn_s_sleep(1); \
    if ((++_sp & 255u) == 0u) { if (xb_ld(&(bar)[XB_TMO])) break; if (_sp > XB_SPIN_CAP) { atomicAdd(&(bar)[XB_TMO], 1u); break; } } } } while (0)

struct XcdBarrier {
    unsigned* bar; unsigned x;
    volatile LAS unsigned* st;
};

__device__ __forceinline__ XcdBarrier xcd_barrier_post(unsigned* bar, volatile LAS unsigned* st) {
    XcdBarrier b; b.bar = bar; b.x = xb_xcc_id(); b.st = st;
    if (threadIdx.x == 0) (void)xb_add(&bar[XB_XCNT(b.x)], 1u);
    return b;
}
__device__ __forceinline__ void xcd_barrier_complete(unsigned* bar, unsigned x, unsigned& nloc, unsigned& nx) {
    const unsigned G = gridDim.x * gridDim.y * gridDim.z;
    unsigned sum, cnt, mine, sp = 0u;
    for (;;) {
        sum = 0u; cnt = 0u; mine = 0u;
#pragma unroll
        for (unsigned j = 0; j < 16; ++j) { const unsigned c = xb_ld(&bar[XB_XCNT(j)]); sum += c; cnt += (c > 0u) ? 1u : 0u; mine = (j == x) ? c : mine; }
        if (sum == G) break;
        __builtin_amdgcn_s_sleep(1);
        if ((++sp & 255u) == 0u) { if (xb_ld(&bar[XB_TMO])) break; if (sp > XB_SPIN_CAP) { atomicAdd(&bar[XB_TMO], 1u); break; } }
    }
    nloc = mine > 0u ? mine : 1u; nx = cnt > 0u ? cnt : 1u;
}

__device__ __forceinline__ void xcd_barrier(const XcdBarrier& b) {
    asm volatile("s_waitcnt vmcnt(0)" ::: "memory");
    __syncthreads();
    if (threadIdx.x == 0) {
        unsigned* bar = b.bar;
        __builtin_amdgcn_s_waitcnt(0);
        unsigned nloc = b.st[0], nx = b.st[1];
        if (nloc == 0u) { xcd_barrier_complete(bar, b.x, nloc, nx); b.st[0] = nloc; b.st[1] = nx; }
        const unsigned old = xb_add(&bar[XB_XSUB(b.x)], 1u);
        const unsigned gen = old / nloc;
        if (old + 1u == (gen + 1u) * nloc) {
            __builtin_amdgcn_fence(__ATOMIC_RELEASE, "agent");
            asm volatile("s_waitcnt vmcnt(0)" ::: "memory");
            const unsigned og = xb_add(&bar[XB_TOP], 1u);
            const unsigned tg = og / nx;
            if (og + 1u == (tg + 1u) * nx) xb_add(&bar[XB_TOPGEN], 1u);
            else XB_SPIN(xb_ld(&bar[XB_TOPGEN]) == tg, bar);
            __builtin_amdgcn_fence(__ATOMIC_ACQUIRE, "agent");
            xb_add(&bar[XB_XGEN(b.x)], 1u);
            asm volatile("s_waitcnt vmcnt(0)" ::: "memory");
        } else {
            XB_SPIN(xb_ld(&bar[XB_XGEN(b.x)]) == gen, bar);
            __builtin_amdgcn_fence(__ATOMIC_ACQUIRE, "agent");
            asm volatile("s_waitcnt vmcnt(0)" ::: "memory");
        }
    }
    __syncthreads();
}

#ifndef MK_PHASES
#define MK_PHASES 0xffff
#endif
#define PH(k) (((MK_PHASES) >> (k)) & 1)
#ifndef MK_SKELETON
#define MK_SKELETON 0
#endif
__global__ void __launch_bounds__(NTHREADS, 2) fwd_megakernel(Params P) {
    extern __shared__ __attribute__((aligned(16))) unsigned char lds_raw[];
    cg::grid_group grid = cg::this_grid();
    LAS unsigned char* lds = (LAS unsigned char*)lds_raw;
    const int wave = __builtin_amdgcn_readfirstlane((int)threadIdx.x >> 6);
#define tid ((int)threadIdx.x)
#define lane ((int)threadIdx.x & 63)
    const int G = gridDim.x, bid = blockIdx.x;
    const int vcu = (G % 8 == 0) ? (bid % 8) * (G / 8) + bid / 8 : bid;
    const int gw = vcu * 8 + wave, ngw = G * 8;
    unsigned char* ws = P.ws;
    if (tid < 16) ((LAS unsigned*)(lds + LDS_BYTES - 64))[tid] = 0u;
    __syncthreads();
    unsigned* BARW = (unsigned*)(ws + 512 * 1024);
    if (bid == 0) for (int i = tid; i < XCD_BAR_WORDS; i += NTHREADS) __hip_atomic_store(BARW + i, 0u, __ATOMIC_RELAXED, __HIP_MEMORY_SCOPE_AGENT);
    float* TAB = (float*)(ws + WS_TAB);
    bf16_t* WIN = (bf16_t*)(ws + WS_WIN); bf16_t* WNA = (bf16_t*)(ws + WS_WNA); bf16_t* WGQA = (bf16_t*)(ws + WS_WGQA); bf16_t* WMIX = (bf16_t*)(ws + WS_WMIX);
    bf16_t* WFF1 = (bf16_t*)(ws + WS_WFF1); bf16_t* WFF2 = (bf16_t*)(ws + WS_WFF2); bf16_t* WPG = (bf16_t*)(ws + WS_WPG); bf16_t* WPPJ = (bf16_t*)(ws + WS_WPP);
    bf16_t* PB = (bf16_t*)(ws + WS_PB); bf16_t* VT = (bf16_t*)(ws + WS_VT); bf16_t* PROJ = (bf16_t*)(ws + WS_PROJ);
    bf16_t* YB = (bf16_t*)(ws + WS_Y); bf16_t* HB = (bf16_t*)(ws + WS_H); bf16_t* HID = (bf16_t*)(ws + WS_HID); bf16_t* EP = (bf16_t*)(ws + WS_EP);
    bf16_t* XN = (bf16_t*)P.out;
    bf16_t* MG = (bf16_t*)P.out;
    bf16_t* AB = (bf16_t*)((unsigned char*)P.out + 192 * MiB);
    bf16_t* X1B = (bf16_t*)P.out;
    float* RS2 = (float*)(ws + 64 * 1024); float* RS3 = (float*)(ws + 256 * 1024);
    bf16_t* KC = (bf16_t*)(ws + 964 * MiB); bf16_t* VC = (bf16_t*)(ws + 988 * MiB); bf16_t* QC = nullptr;

    if (PH(0)) {
        for (int idx = bid * NTHREADS + tid; idx < 64 * 32; idx += G * NTHREADS) {
            const int pos = idx >> 5, i = idx & 31;
            const float freq = __builtin_amdgcn_exp2f(-(float)i * (13.287712379549449f / 32.f));
            const float rev = (float)pos * freq * 0.15915494309189535f; const float fr = rev - floorf(rev);
            TAB[idx * 2] = __builtin_amdgcn_cosf(fr); TAB[idx * 2 + 1] = __builtin_amdgcn_sinf(fr);
        }
        LAS float* scr = (LAS float*)(lds + wave * 16384);
        constexpr int NITEMS = (2048 / 64) * (8704 / 32) + 2 * (1024 / 64) * (2048 / 32) + 2 * (2048 / 64) * (2048 / 32) + (2048 / 64) * (8192 / 32) + (8192 / 64) * (2048 / 32) + (256 / 64) * (2048 / 32);
        for (int it = gw; it < NITEMS; it += ngw) {
            int r = it;
            if (transpose_mat(r, P.w_in, 2048, 8704, WIN, scr, lane, true)) continue;
            if (transpose_mat(r, P.w_na, 1024, 2048, WNA, scr, lane, false)) continue;
            if (transpose_mat(r, P.w_gqa, 1024, 2048, WGQA, scr, lane, false)) continue;
            if (transpose_mat(r, P.w_mix, 2048, 2048, WMIX, scr, lane, false)) continue;
            if (transpose_mat(r, P.w_ple_gate, 2048, 2048, WPG, scr, lane, false, P.ln_ple_pre)) continue;
            if (transpose_mat(r, P.w_ff1, 2048, 8192, WFF1, scr, lane, false, P.ln_mlp_pre)) continue;
            if (transpose_mat(r, P.w_ff2, 8192, 2048, WFF2, scr, lane, false)) continue;
            transpose_mat(r, P.w_ple_proj, 256, 2048, WPPJ, scr, lane, false);
        }
        for (size_t i = (size_t)bid * NTHREADS + tid; i < (size_t)T * PLE / 8; i += (size_t)G * NTHREADS) {
            const size_t e = i * 8; const float* src = e < (size_t)TP * PLE ? P.p_p + e : P.p_s + (e - (size_t)TP * PLE);
            const f32x4 a = *(const f32x4*)src, b = *(const f32x4*)(src + 4);
            u32x4 w; w.x = pk_bf16(a[0], a[1]); w.y = pk_bf16(a[2], a[3]); w.z = pk_bf16(b[0], b[1]); w.w = pk_bf16(b[2], b[3]);
            *(u32x4*)(PB + e) = w;
        }
        row_pass<0>(P, nullptr, nullptr, XN, nullptr, P.ln_mix_pre, gw, ngw);
    }
    grid.sync();
    XcdBarrier xbar = xcd_barrier_post(BARW, (volatile LAS unsigned*)(lds + LDS_BYTES - 64));
#if !MK_SKELETON
    if (PH(1)) {
        pg8::Gemm g{XN, WIN, T, 7680, 2048, 2048, 2048}; pg8::StaticOrder S; S.init(T, 7680, G, bid);
        pg8::EpiX<0> E{PROJ, PP, nullptr, 0};
        pg8::gemm_phase<pg8::EpiX<0>, pg8::StaticOrder, true, true>(lds, g, S, E);
        pg8::Gemm g2{WIN + (size_t)7680 * 2048, XN, 1024, T, 2048, 2048, 2048}; pg8::StaticOrder S2; S2.init(1024, T, G, bid);
        pg8::EpiX<5> E2{VT, T, nullptr, 0};
        pg8::gemm_phase<pg8::EpiX<5>, pg8::StaticOrder, true, true>(lds, g2, S2, E2);
    }
    xcd_barrier(xbar);
    if (PH(2)) {
        LAS float* tabl = (LAS float*)(lds + 98304);
        for (int i = tid; i < 64 * 32 * 2; i += NTHREADS) tabl[i] = TAB[i];
        __syncthreads();
        qk_norm_rope(P, PROJ, QC, KC, VC, tabl, gw, ngw, lane);
        na::na_phase(PROJ, VT, P.na_rpb, AB, 1024, vcu, G, lds);
        __syncthreads();
    }
    xcd_barrier(xbar);
    if (PH(3)) {
        const int NU = NBATCH * 2 * 64;
        for (int i = 0;; ++i) {
            int u;
            if (G == 256) { if (i >= 6) break; const int x = vcu >> 5, c = vcu & 31; u = (x * 3 + (i >> 1)) * 64 + (i & 1) * 32 + c; }
            else { u = bid + i * G; if (u >= NU) break; }
            const int pair = u >> 6, uu = u & 63, b = pair >> 1, kvh = pair & 1, h = kvh * 4 + (uu >> 4), qb = uu & 15;
            const gqa::bf16* Q = (const gqa::bf16*)(PROJ + ((size_t)b * SEQ + qb * 256) * PP + C_GQ + h * 128);
            const gqa::bf16* Kp = (const gqa::bf16*)(KC + (size_t)b * SEQ * 256 + kvh * 128);
            const gqa::bf16* Vp = (const gqa::bf16*)(VC + (size_t)b * SEQ * 256 + kvh * 128);
            gqa::attn_dense_body<gqa::bf16>(Q, Kp, Vp, (gqa::bf16*)(AB + (size_t)T * 1024 + ((size_t)b * SEQ + qb * 256) * 1024 + h * 128), SEQ, (char*)lds_raw, P.q_norm, TAB, qb * 256);
            __syncthreads();
        }
    }
    xcd_barrier(xbar);
    if (PH(4)) {
        pg8::SegOrder S; S.base.init(T, DM, G, bid);
        pg8::Gemm g{AB, WNA, T, DM, 1024, 1024, 1024, (size_t)T * 1024 * 2, (size_t)DM * 1024 * 2};
        pg8::EpiGate E{MG, DM, PROJ + C_GA, PROJ + C_GB, PP};
        pg8::gemm_phase<pg8::EpiGate, pg8::SegOrder, true, true>(lds, g, S, E);
    }
    xcd_barrier(xbar);
    if (PH(5)) {
        pg8::StaticOrder S; S.init(T, DM, G, bid);
        pg8::Gemm g{MG, WMIX, T, DM, DM, DM, DM}; pg8::EpiX<0> E{YB, DM, nullptr, 0};
        pg8::gemm_phase<pg8::EpiX<0>, pg8::StaticOrder, true, true>(lds, g, S, E);
    }
    xcd_barrier(xbar);
    if (PH(6)) row_pass<1>(P, YB, nullptr, X1B, RS2, P.ln_mix_post, gw, ngw);
    xcd_barrier(xbar);
    if (PH(7))
#pragma unroll
    for (int half = 0; half < 2; ++half) {
        const size_t r0 = (size_t)half * (T / 2);
        {
            pg8::StaticOrder S; S.init(T / 2, DFF, G, bid);
            pg8::Gemm g{X1B + r0 * DM, WFF1, T / 2, DFF, DM, DM, DM}; pg8::EpiX<1> E{HID, DFF, nullptr, 0, RS2 + r0};
            pg8::gemm_phase<pg8::EpiX<1>, pg8::StaticOrder, true, true>(lds, g, S, E);
        }
        xcd_barrier(xbar);
        {
            pg8::StaticOrder S; S.init(T / 2, DM, G, bid);
            pg8::Gemm g{HID, WFF2, T / 2, DM, DFF, DFF, DFF}; pg8::EpiX<0> E{YB + r0 * DM, DM, nullptr, 0};
            pg8::gemm_phase<pg8::EpiX<0>, pg8::StaticOrder, true, true>(lds, g, S, E);
        }
        xcd_barrier(xbar);
    }
    if (PH(8)) row_pass<3>(P, YB, X1B, YB, RS3, P.ln_mlp_post, gw, ngw);
    xcd_barrier(xbar);
    if (PH(9)) {
        pg8::StaticOrder S; S.init(T, DM, G, bid);
        pg8::Gemm g1{PB, WPPJ, T, DM, PLE, PLE, PLE}; pg8::EpiX<0> E1{EP, DM, nullptr, 0};
        pg8::gemm_phase<pg8::EpiX<0>, pg8::StaticOrder, true, true>(lds, g1, S, E1);
        pg8::Gemm g2{YB, WPG, T, DM, DM, DM, DM}; pg8::EpiX<4> E2{EP, DM, nullptr, 0, RS3};
        pg8::gemm_phase<pg8::EpiX<4>, pg8::StaticOrder, true, true>(lds, g2, S, E2);
    }
    xcd_barrier(xbar);
    if (PH(10)) row_pass<2>(P, EP, YB, nullptr, nullptr, P.ln_ple_post, gw, ngw);
#else
    for (int k = 0; k < 12; ++k) {
        for (size_t i = (size_t)bid * NTHREADS + tid; i < (size_t)T * DM / 64; i += (size_t)G * NTHREADS) P.out[i * 64 + k] = (float)k;
        xcd_barrier(xbar);
    }
#endif
}

#undef tid
#undef lane
extern "C" void kernel_launch(void* const* d_in, const int* in_sizes, int n_in, void* d_out, int out_size, void* d_ws, size_t ws_size, hipStream_t stream) {
    static int grid = 0;
    if (grid == 0) {
        if (n_in != 21 || out_size != T * DM || ws_size < WS_END) { fprintf(stderr, "kernel_launch: unexpected shapes: n_in %d out %d ws %zu (need >= %zu)\n", n_in, out_size, ws_size, (size_t)WS_END); grid = -1; return; }
        int dev = 0, cus = 0, per_cu = 0;
        if (hipGetDevice(&dev) != hipSuccess || hipDeviceGetAttribute(&cus, hipDeviceAttributeMultiprocessorCount, dev) != hipSuccess) { fprintf(stderr, "kernel_launch: device query failed\n"); grid = -1; return; }
        if (hipFuncSetAttribute((const void*)fwd_megakernel, hipFuncAttributeMaxDynamicSharedMemorySize, LDS_BYTES) != hipSuccess) { fprintf(stderr, "kernel_launch: hipFuncSetAttribute failed\n"); grid = -1; return; }
        if (hipOccupancyMaxActiveBlocksPerMultiprocessor(&per_cu, (const void*)fwd_megakernel, NTHREADS, LDS_BYTES) != hipSuccess || per_cu < 1) { fprintf(stderr, "kernel_launch: occupancy query says %d\n", per_cu); per_cu = 1; }
        (void)hipGetLastError();
        grid = cus * per_cu;
    }
    if (grid < 0) return;
    Params p{};
    p.x_p = (const float*)d_in[0]; p.x_s = (const float*)d_in[1]; p.p_p = (const float*)d_in[2]; p.p_s = (const float*)d_in[3];
    p.ln_mix_pre = (const float*)d_in[4]; p.w_in = (const float*)d_in[5]; p.q_norm = (const float*)d_in[6]; p.k_norm = (const float*)d_in[7]; p.na_rpb = (const float*)d_in[8];
    p.w_na = (const float*)d_in[9]; p.w_gqa = (const float*)d_in[10]; p.w_mix = (const float*)d_in[11]; p.ln_mix_post = (const float*)d_in[12]; p.ln_mlp_pre = (const float*)d_in[13];
    p.w_ff1 = (const float*)d_in[14]; p.w_ff2 = (const float*)d_in[15]; p.ln_mlp_post = (const float*)d_in[16]; p.ln_ple_pre = (const float*)d_in[17];
    p.w_ple_gate = (const float*)d_in[18]; p.w_ple_proj = (const float*)d_in[19]; p.ln_ple_post = (const float*)d_in[20];
    p.out = (float*)d_out; p.ws = (unsigned char*)d_ws;
    void* args[] = {&p};
    const hipError_t e = hipLaunchCooperativeKernel((const void*)fwd_megakernel, dim3(grid), dim3(NTHREADS), args, LDS_BYTES, stream);
    if (e != hipSuccess) fprintf(stderr, "kernel_launch: cooperative launch failed: %s (grid %d)\n", hipGetErrorString(e), grid);
}
```

```cpp
#include <hip/hip_runtime.h>
#include <hip/hip_cooperative_groups.h>
#include <hip/hip_bf16.h>
#include <cstdio>
#include <cstdint>
namespace cg = cooperative_groups;
namespace pg8 {
#define PG8_LAS __attribute__((address_space(3)))
typedef unsigned short bf16_t;
typedef short bf16x8 __attribute__((ext_vector_type(8)));
typedef float f32x4 __attribute__((ext_vector_type(4)));
typedef unsigned u32x4 __attribute__((ext_vector_type(4)));
constexpr int BM = 256, BK = 64, HALF = 128, HTB = HALF * BK * 2  , STAGE_BYTES = 8 * HTB, NXCD = 8, WGM = 8;

__host__ __device__ __forceinline__ int lds_byte(int r, int c) { const int st = (r >> 4) * 2 + (c >> 5), rr = r & 15, cc = c & 31, ob = rr * 64 + cc * 2; return st * 1024 + (ob ^ (((ob >> 9) & 1) << 5)); }
__host__ __device__ __forceinline__ void stage_rc(int b, int& R, int& C) { const int st = b / 1024, sb = b % 1024, swz = sb ^ (((sb >> 9) & 1) << 5); R = (st >> 1) * 16 + swz / 64; C = (st & 1) * 32 + (swz % 64) / 2; }
__host__ __device__ __forceinline__ int perm32(int rho) { const int n = rho >> 4, i = rho & 15; return 8 * (i >> 2) + 4 * n + (i & 3); }

struct Unit { int pm, pn, seg; };
struct Gemm { const bf16_t* A; const bf16_t* Bt; int M, N, K, lda, ldb; size_t segA = 0, segB = 0; };

struct StaticOrder {
    int nM, nN, nwg, G, c;
    __host__ __device__ void init(int M, int N, int G_, int c_) { nM = M / BM; nN = N / BM; nwg = nM * nN; G = G_; c = c_; }
    __host__ __device__ bool next(int i, Unit& u) const {
        const long L = (long)i * G + c; if (L >= nwg) return false;
        int wgid = (int)L; { const int q = nwg / NXCD, r = nwg % NXCD, xcd = wgid % NXCD, off = wgid / NXCD; wgid = (xcd < r ? xcd * (q + 1) : r * (q + 1) + (xcd - r) * q) + off; }
        const int nig = WGM * nN, gid = wgid / nig, fm = gid * WGM, gsz = (nM - fm) < WGM ? (nM - fm) : WGM;
        u.pm = fm + ((wgid % nig) % gsz); u.pn = (wgid % nig) / gsz; u.seg = 0; return true;
    }
    __device__ __forceinline__ void a_ready(const Unit&) const {}
    __device__ __forceinline__ void done(const Unit&) const {}
};

__device__ __forceinline__ unsigned cvt_pk_bf16(float lo, float hi) { unsigned r; asm volatile("v_cvt_pk_bf16_f32 %0, %1, %2" : "=v"(r) : "v"(lo), "v"(hi)); return r; }
typedef float f32x2 __attribute__((ext_vector_type(2)));
__device__ __forceinline__ f32x2 gelu_pk(f32x2 v) {
    const f32x2 av = __builtin_elementwise_abs(v), d = av * 0.2316418882f + 1.0f;
    f32x2 t; t.x = __builtin_amdgcn_rcpf(d.x); t.y = __builtin_amdgcn_rcpf(d.y);
    f32x2 q = t * 0.5307027145f + (-0.7265760135f); q = q * t + 0.7107068705f; q = q * t + (-0.142248368f); q = q * t + 0.127414796f; q = q * t;
    const f32x2 s = (v * v) * (-0.72134752044f);
    f32x2 e; e.x = __builtin_amdgcn_exp2f(s.x); e.y = __builtin_amdgcn_exp2f(s.y);
    const f32x2 m = v * (q * e), r = v - m;
    f32x2 o; o.x = v.x < 0.f ? m.x : r.x; o.y = v.y < 0.f ? m.y : r.y; return o;
}

template <int ACT  > struct EpiBf16 {
    static constexpr bool PERM = true, AFTER_DRAIN = false; static_assert(ACT == 0 || ACT == 1, "EpiBf16: ACT is 0 (none) or 1 (gelu_pk)");
    bf16_t* O; int ldc; const float* bias; int split_cols; size_t split_stride; float scale0;
    __device__ __forceinline__ void operator()(const f32x4 (&acc)[2][2][4][2], const Unit& u, int wr, int wc, int fr, int fq) const {
        const int row0 = u.pm * BM + wr * 64 + fr; int colt = u.pn * BM; bf16_t* base = O;
        float sc = 1.f; if (split_cols) { const int t = colt / split_cols; base += (size_t)t * split_stride; colt -= t * split_cols; if (t == 0) sc = scale0; }
        const int col0 = colt + wc * 32 + 8 * fq, bcol0 = u.pn * BM + wc * 32 + 8 * fq;
        f32x4 bv[2][2];
#pragma unroll
        for (int bj = 0; bj < 2; ++bj)
#pragma unroll
            for (int n = 0; n < 2; ++n) bv[bj][n] = bias ? *(const f32x4*)(bias + bcol0 + bj * HALF + 4 * n) : (f32x4){0.f, 0.f, 0.f, 0.f};
#pragma unroll
        for (int ai = 0; ai < 2; ++ai)
#pragma unroll
            for (int m = 0; m < 4; ++m) { bf16_t* rowp = base + (size_t)(row0 + ai * HALF + m * 16) * ldc + col0;
#pragma unroll
                for (int bj = 0; bj < 2; ++bj) { f32x4 v0 = acc[ai][bj][m][0] + bv[bj][0], v1 = acc[ai][bj][m][1] + bv[bj][1];
                    if (ACT == 1) { f32x2 a = gelu_pk((f32x2){v0[0], v0[1]}), b = gelu_pk((f32x2){v0[2], v0[3]}), c = gelu_pk((f32x2){v1[0], v1[1]}), d = gelu_pk((f32x2){v1[2], v1[3]});
                        v0 = (f32x4){a.x, a.y, b.x, b.y}; v1 = (f32x4){c.x, c.y, d.x, d.y}; }
                    v0 = v0 * sc; v1 = v1 * sc; u32x4 w; w.x = cvt_pk_bf16(v0[0], v0[1]); w.y = cvt_pk_bf16(v0[2], v0[3]); w.z = cvt_pk_bf16(v1[0], v1[1]); w.w = cvt_pk_bf16(v1[2], v1[3]);
                    *(u32x4*)(rowp + bj * HALF) = w; } }
    }
};
template <class Epi, class Sched, bool ALIGN_EPI = false, bool SP2 = false>
__device__ __forceinline__ void gemm_phase(PG8_LAS unsigned char* lds, const Gemm g, const Sched& S, const Epi& E) {
    int tid_l = threadIdx.x; asm volatile("" : "+v"(tid_l));
    const int tid = tid_l, wid = __builtin_amdgcn_readfirstlane(tid >> 6), lane = tid & 63, wr = wid >> 2, wc = wid & 3, fr = lane & 15, fq = lane >> 4;
    const int K = g.K, nt = K / BK;
    unsigned voffA[2], voffB[2];
#pragma unroll
    for (int i = 0; i < 2; ++i) { int R, C; stage_rc(tid * 16 + i * 8192, R, C); const int Rb = Epi::PERM ? ((R & ~31) + perm32(R & 31)) : R;
        voffA[i] = (unsigned)(R * g.lda + C) * 2u; voffB[i] = (unsigned)(Rb * g.ldb + C) * 2u; }
    const size_t kstep = (size_t)(BK * 2);
    const size_t hstepA = (size_t)HALF * g.lda * 2, hstepB = (size_t)HALF * g.ldb * 2;
    const size_t tstepA = 2 * hstepA, tstepB = 2 * hstepB;
    const unsigned ldsw = (unsigned)wid * 1024u;
    const int aoff = lds_byte(wr * 64 + fr, fq * 8), boff = lds_byte(wc * 32 + fr, fq * 8);
#define PG8_SA(b, h) (((b) * 2 + (h)) * HTB)
#define PG8_SB(b, h) ((4 + (b) * 2 + (h)) * HTB)
#define PG8_STAGE(bufoff, gbase, voff) do { _Pragma("unroll") for (int _i = 0; _i < 2; ++_i) \
        __builtin_amdgcn_global_load_lds((const unsigned*)((const char*)(gbase) + (voff)[_i]), (PG8_LAS unsigned*)(lds + (bufoff) + ldsw + _i * 8192), 16, 0, 0); } while (0)
#define PG8_LDA(dst, b, h) do { _Pragma("unroll") for (int m = 0; m < 4; ++m) _Pragma("unroll") for (int k = 0; k < 2; ++k) dst[m][k] = *(const PG8_LAS bf16x8*)(lds + PG8_SA(b, h) + aoff + m * 2048 + k * 1024); } while (0)
#define PG8_LDB(dst, b, h) do { _Pragma("unroll") for (int n = 0; n < 2; ++n) _Pragma("unroll") for (int k = 0; k < 2; ++k) dst[n][k] = *(const PG8_LAS bf16x8*)(lds + PG8_SB(b, h) + boff + n * 2048 + k * 1024); } while (0)
#define PG8_MMA(ai, bj, At, Bt) do { __builtin_amdgcn_s_setprio(1); _Pragma("unroll") for (int m = 0; m < 4; ++m) _Pragma("unroll") for (int n = 0; n < 2; ++n) _Pragma("unroll") for (int k = 0; k < 2; ++k) \
        acc[ai][bj][m][n] = __builtin_amdgcn_mfma_f32_16x16x32_bf16(Bt[n][k], At[m][k], acc[ai][bj][m][n], 0, 0, 0); __builtin_amdgcn_s_setprio(0); } while (0)
#define PG8_WAIT_V(n) asm volatile("s_waitcnt vmcnt(" #n ")" ::: "memory")
#define PG8_WAIT_L(n) asm volatile("s_waitcnt lgkmcnt(" #n ")" ::: "memory")
#define PG8_BAR __builtin_amdgcn_s_barrier()
#define PG8_SCHED __builtin_amdgcn_sched_barrier(0)
    Unit cur, nxt; int ui = 0;
    if (!S.next(0, cur)) return;
    f32x4 acc[2][2][4][2];
#pragma unroll
    for (int a = 0; a < 2; ++a)
#pragma unroll
        for (int b = 0; b < 2; ++b)
#pragma unroll
            for (int m = 0; m < 4; ++m)
#pragma unroll
                for (int n = 0; n < 2; ++n) acc[a][b][m][n] = (f32x4){0.f, 0.f, 0.f, 0.f};
    bf16x8 At[4][2], B0[2][2], B1[2][2];
    const char* cA = (const char*)g.A + (size_t)cur.seg * g.segA + (size_t)cur.pm * tstepA; const char* cB = (const char*)g.Bt + (size_t)cur.seg * g.segB + (size_t)cur.pn * tstepB;
    S.a_ready(cur);
    if constexpr (SP2) {
        PG8_STAGE(PG8_SB(0, 0), cB, voffB); PG8_STAGE(PG8_SB(0, 1), cB + hstepB, voffB); PG8_STAGE(PG8_SA(0, 0), cA, voffA); PG8_STAGE(PG8_SA(0, 1), cA + hstepA, voffA);
        if (wr == 1) PG8_BAR;
        PG8_WAIT_V(2); PG8_BAR;
        PG8_STAGE(PG8_SB(1, 0), cB + kstep, voffB); PG8_STAGE(PG8_SA(1, 0), cA + kstep, voffA); PG8_STAGE(PG8_SB(1, 1), cB + hstepB + kstep, voffB);
        PG8_WAIT_V(6); PG8_BAR;
    } else {
        PG8_STAGE(PG8_SB(0, 0), cB, voffB); PG8_STAGE(PG8_SA(0, 0), cA, voffA); PG8_STAGE(PG8_SB(0, 1), cB + hstepB, voffB); PG8_STAGE(PG8_SA(0, 1), cA + hstepA, voffA);
        if (wr == 1) PG8_BAR;
        PG8_WAIT_V(4); PG8_BAR;
        PG8_STAGE(PG8_SB(1, 0), cB + kstep, voffB); PG8_STAGE(PG8_SA(1, 0), cA + kstep, voffA); PG8_STAGE(PG8_SB(1, 1), cB + hstepB + kstep, voffB);
        PG8_WAIT_V(6); PG8_BAR;
    }
    for (;;) {
        const bool has_next = S.next(ui + 1, nxt);
        const char* nA = has_next ? (const char*)g.A + (size_t)nxt.seg * g.segA + (size_t)nxt.pm * tstepA : cA; const char* nB = has_next ? (const char*)g.Bt + (size_t)nxt.seg * g.segB + (size_t)nxt.pn * tstepB : cB;
        for (int t = 0; t < nt; t += 2) {
            const bool last = (t == nt - 2);
            const char* a1 = cA + (size_t)(t + 1) * kstep;
            const char* a2 = last ? nA : cA + (size_t)(t + 2) * kstep; const char* b2 = last ? nB : cB + (size_t)(t + 2) * kstep;
            const char* a3 = a2 + kstep; const char* b3 = b2 + kstep;
            if (last && has_next) S.a_ready(nxt);
            if constexpr (SP2) {
            PG8_LDB(B0, 0, 0); PG8_LDB(B1, 0, 1); PG8_SCHED; PG8_LDA(At, 0, 0); PG8_STAGE(PG8_SA(1, 1), a1 + hstepA, voffA);
            PG8_WAIT_V(8); PG8_WAIT_L(0); PG8_BAR; PG8_MMA(0, 0, At, B0); PG8_MMA(0, 1, At, B1); PG8_BAR; PG8_SCHED;
            PG8_LDA(At, 0, 1); PG8_STAGE(PG8_SB(0, 0), b2, voffB); PG8_STAGE(PG8_SB(0, 1), b2 + hstepB, voffB); PG8_STAGE(PG8_SA(0, 0), a2, voffA);
            PG8_WAIT_V(8); PG8_WAIT_L(0); PG8_BAR; PG8_MMA(1, 0, At, B0); PG8_MMA(1, 1, At, B1); PG8_BAR; PG8_SCHED;
            PG8_LDB(B0, 1, 0); PG8_LDB(B1, 1, 1); PG8_SCHED; PG8_LDA(At, 1, 0); PG8_STAGE(PG8_SA(0, 1), a2 + hstepA, voffA);
            PG8_WAIT_V(8); PG8_WAIT_L(0); PG8_BAR; PG8_MMA(0, 0, At, B0); PG8_MMA(0, 1, At, B1); PG8_BAR; PG8_SCHED;
            PG8_LDA(At, 1, 1); PG8_STAGE(PG8_SB(1, 0), b3, voffB); PG8_STAGE(PG8_SB(1, 1), b3 + hstepB, voffB); PG8_STAGE(PG8_SA(1, 0), a3, voffA);
            PG8_WAIT_V(8); PG8_WAIT_L(0); PG8_BAR; PG8_MMA(1, 0, At, B0); PG8_MMA(1, 1, At, B1); PG8_BAR; PG8_SCHED;
            } else {
            PG8_LDB(B0, 0, 0); PG8_SCHED; PG8_LDA(At, 0, 0); PG8_STAGE(PG8_SA(1, 1), a1 + hstepA, voffA);
            PG8_WAIT_L(8); PG8_BAR; PG8_WAIT_L(0); PG8_MMA(0, 0, At, B0); PG8_BAR; PG8_SCHED;
            PG8_LDB(B1, 0, 1); PG8_STAGE(PG8_SB(0, 0), b2, voffB);
            PG8_BAR; PG8_WAIT_L(0); PG8_MMA(0, 1, At, B1); PG8_BAR;
            PG8_LDA(At, 0, 1); PG8_STAGE(PG8_SA(0, 0), a2, voffA);
            PG8_BAR; PG8_WAIT_L(0); PG8_MMA(1, 0, At, B0); PG8_BAR; PG8_SCHED;
            PG8_STAGE(PG8_SB(0, 1), b2 + hstepB, voffB);
            PG8_WAIT_V(6); PG8_BAR; PG8_MMA(1, 1, At, B1); PG8_BAR;
            PG8_LDB(B0, 1, 0); PG8_SCHED; PG8_LDA(At, 1, 0); PG8_STAGE(PG8_SA(0, 1), a2 + hstepA, voffA);
            PG8_WAIT_L(8); PG8_BAR; PG8_WAIT_L(0); PG8_MMA(0, 0, At, B0); PG8_BAR; PG8_SCHED;
            PG8_LDB(B1, 1, 1); PG8_STAGE(PG8_SB(1, 0), b3, voffB);
            PG8_BAR; PG8_WAIT_L(0); PG8_MMA(0, 1, At, B1); PG8_BAR;
            PG8_LDA(At, 1, 1); PG8_STAGE(PG8_SA(1, 0), a3, voffA);
            PG8_BAR; PG8_WAIT_L(0); PG8_MMA(1, 0, At, B0); PG8_BAR; PG8_SCHED;
            PG8_STAGE(PG8_SB(1, 1), b3 + hstepB, voffB);
            PG8_WAIT_V(6); PG8_BAR; PG8_MMA(1, 1, At, B1); PG8_BAR;
            }
        }
        if constexpr (ALIGN_EPI) { if (wr == 0) PG8_BAR; }
        bool keep_acc = false;
        if constexpr (!Epi::AFTER_DRAIN) { if constexpr (Epi::SEG) { if (cur.seg == 0) { E.mid(acc, cur, wr, wc, fr, fq); keep_acc = true; } else E(acc, cur, wr, wc, fr, fq); } else E(acc, cur, wr, wc, fr, fq); S.done(cur); }
        if (!has_next) break;
        if (!keep_acc)
#pragma unroll
        for (int a = 0; a < 2; ++a)
#pragma unroll
            for (int b = 0; b < 2; ++b)
#pragma unroll
                for (int m = 0; m < 4; ++m)
#pragma unroll
                    for (int n = 0; n < 2; ++n) acc[a][b][m][n] = (f32x4){0.f, 0.f, 0.f, 0.f};
        cur = nxt; cA = nA; cB = nB; ++ui;
        if constexpr (ALIGN_EPI) { if (wr == 1) PG8_BAR; }
    }
    PG8_WAIT_V(0);
    if constexpr (!ALIGN_EPI) { if (wr == 0) PG8_BAR; }
    PG8_BAR;
    if constexpr (Epi::AFTER_DRAIN) { E.fused(acc, cur, wr, wc, fr, fq, lds, wid, lane); S.done(cur); }
#undef PG8_SA
#undef PG8_SB
#undef PG8_STAGE
#undef PG8_LDA
#undef PG8_LDB
#undef PG8_MMA
#undef PG8_WAIT_V
#undef PG8_WAIT_L
#undef PG8_BAR
#undef PG8_SCHED
}
}
namespace pg8 {
__device__ __forceinline__ float bf_lo(unsigned u) { return __uint_as_float(u << 16); }
__device__ __forceinline__ float bf_hi(unsigned u) { return __uint_as_float(u & 0xffff0000u); }
__device__ __forceinline__ float sigm(float x) { return __builtin_amdgcn_rcpf(1.f + __builtin_amdgcn_exp2f(-1.4426950408889634f * x)); }
template <int MODE> struct EpiX {
    static constexpr bool PERM = true, AFTER_DRAIN = false, SEG = false;
    bf16_t* O; int ldc; const bf16_t* G; int ldg; const float* RS = nullptr;
    __device__ __forceinline__ void operator()(const f32x4 (&acc)[2][2][4][2], const Unit& u, int wr, int wc, int fr, int fq) const {
        const int row0 = u.pm * BM + wr * 64 + fr; const int col0 = u.pn * BM + wc * 32 + 8 * fq;
#pragma unroll
        for (int ai = 0; ai < 2; ++ai)
#pragma unroll
            for (int m = 0; m < 4; ++m) { const size_t row = (size_t)(row0 + ai * HALF + m * 16);
#pragma unroll
                for (int bj = 0; bj < 2; ++bj) { const int col = col0 + bj * HALF;
                    const f32x4 a0 = acc[ai][bj][m][0], a1 = acc[ai][bj][m][1];
                    float v[8] = {a0[0], a0[1], a0[2], a0[3], a1[0], a1[1], a1[2], a1[3]};
                    bf16_t* op = O + row * ldc + col;
                    if (MODE == 5) op = O + ((((size_t)(col >> 12) * 64 + ((col >> 6) & 63)) * 8 + (row >> 7)) * 128 + (row & 127)) * 64 + (col & 63);
                    if (MODE == 1) {
                        const float rs = RS[row], rs2 = rs * rs;
#pragma unroll
                        for (int i = 0; i < 8; ++i) { const float r = fmaxf(v[i], 0.f); v[i] = r * r * rs2; } }
                    if (MODE == 2 || MODE == 3) { const u32x4 gw = *(const u32x4*)(G + row * ldg + col);
                        const float gf[8] = {bf_lo(gw.x), bf_hi(gw.x), bf_lo(gw.y), bf_hi(gw.y), bf_lo(gw.z), bf_hi(gw.z), bf_lo(gw.w), bf_hi(gw.w)};
#pragma unroll
                        for (int i = 0; i < 8; ++i) v[i] = sigm(gf[i]) * v[i]; }
                    if (MODE == 3) { const u32x4 ow = *(const u32x4*)op;
                        const float of[8] = {bf_lo(ow.x), bf_hi(ow.x), bf_lo(ow.y), bf_hi(ow.y), bf_lo(ow.z), bf_hi(ow.z), bf_lo(ow.w), bf_hi(ow.w)};
#pragma unroll
                        for (int i = 0; i < 8; ++i) v[i] += of[i]; }
                    if (MODE == 4) { const u32x4 ow = *(const u32x4*)op;
                        const float of[8] = {bf_lo(ow.x), bf_hi(ow.x), bf_lo(ow.y), bf_hi(ow.y), bf_lo(ow.z), bf_hi(ow.z), bf_lo(ow.w), bf_hi(ow.w)};
                        const float rs = RS[row];
#pragma unroll
                        for (int i = 0; i < 8; ++i) v[i] = of[i] * sigm(v[i] * rs); }
                    u32x4 w; w.x = cvt_pk_bf16(v[0], v[1]); w.y = cvt_pk_bf16(v[2], v[3]); w.z = cvt_pk_bf16(v[4], v[5]); w.w = cvt_pk_bf16(v[6], v[7]);
                    *(u32x4*)op = w; }
                if (MODE >= 2) asm volatile("" ::: "memory"); }
    }
};

struct SegOrder { StaticOrder base;
    __device__ bool next(int i, Unit& u) const { if (!base.next(i >> 1, u)) return false; u.seg = i & 1; return true; }
    __device__ __forceinline__ void a_ready(const Unit&) const {}
    __device__ __forceinline__ void done(const Unit&) const {} };
struct EpiGate {
    static constexpr bool PERM = true, AFTER_DRAIN = false, SEG = true;
    bf16_t* O; int ldc; const bf16_t* GA; const bf16_t* GB; int ldg;
    static __device__ __forceinline__ float eneg(float x) { return __builtin_amdgcn_exp2f(-1.4426950408889634f * fminf(fmaxf(x, -30.f), 30.f)); }
    __device__ __forceinline__ void mid(f32x4 (&acc)[2][2][4][2], const Unit& u, int wr, int wc, int fr, int fq) const {
        const int row0 = u.pm * BM + wr * 64 + fr; const int col0 = u.pn * BM + wc * 32 + 8 * fq;
#pragma unroll
        for (int ai = 0; ai < 2; ++ai)
#pragma unroll
            for (int m = 0; m < 4; ++m) { const size_t row = (size_t)(row0 + ai * HALF + m * 16);
#pragma unroll
                for (int bj = 0; bj < 2; ++bj) { const int col = col0 + bj * HALF;
                    const u32x4 aw = *(const u32x4*)(GA + row * ldg + col), bw = *(const u32x4*)(GB + row * ldg + col);
                    const float ga[8] = {bf_lo(aw.x), bf_hi(aw.x), bf_lo(aw.y), bf_hi(aw.y), bf_lo(aw.z), bf_hi(aw.z), bf_lo(aw.w), bf_hi(aw.w)};
                    const float gb[8] = {bf_lo(bw.x), bf_hi(bw.x), bf_lo(bw.y), bf_hi(bw.y), bf_lo(bw.z), bf_hi(bw.z), bf_lo(bw.w), bf_hi(bw.w)};
                    float r[8];
#pragma unroll
                    for (int i = 0; i < 8; ++i) r[i] = (1.f + eneg(gb[i])) * __builtin_amdgcn_rcpf(1.f + eneg(ga[i]));
                    acc[ai][bj][m][0] = acc[ai][bj][m][0] * (f32x4){r[0], r[1], r[2], r[3]}; acc[ai][bj][m][1] = acc[ai][bj][m][1] * (f32x4){r[4], r[5], r[6], r[7]}; }
                asm volatile("" ::: "memory"); }
    }
    __device__ __forceinline__ void operator()(const f32x4 (&acc)[2][2][4][2], const Unit& u, int wr, int wc, int fr, int fq) const {
        const int row0 = u.pm * BM + wr * 64 + fr; const int col0 = u.pn * BM + wc * 32 + 8 * fq;
#pragma unroll
        for (int ai = 0; ai < 2; ++ai)
#pragma unroll
            for (int m = 0; m < 4; ++m) { const size_t row = (size_t)(row0 + ai * HALF + m * 16);
#pragma unroll
                for (int bj = 0; bj < 2; ++bj) { const int col = col0 + bj * HALF;
                    const u32x4 bw = *(const u32x4*)(GB + row * ldg + col);
                    const float gb[8] = {bf_lo(bw.x), bf_hi(bw.x), bf_lo(bw.y), bf_hi(bw.y), bf_lo(bw.z), bf_hi(bw.z), bf_lo(bw.w), bf_hi(bw.w)};
                    const f32x4 a0 = acc[ai][bj][m][0], a1 = acc[ai][bj][m][1];
                    float v[8] = {a0[0], a0[1], a0[2], a0[3], a1[0], a1[1], a1[2], a1[3]};
#pragma unroll
                    for (int i = 0; i < 8; ++i) v[i] *= __builtin_amdgcn_rcpf(1.f + eneg(gb[i]));
                    u32x4 w; w.x = cvt_pk_bf16(v[0], v[1]); w.y = cvt_pk_bf16(v[2], v[3]); w.z = cvt_pk_bf16(v[4], v[5]); w.w = cvt_pk_bf16(v[6], v[7]);
                    *(u32x4*)(O + row * ldc + col) = w; }
                asm volatile("" ::: "memory"); }
    }
};
}
namespace gqa {
using bf16 = __hip_bfloat16;
constexpr int   D = 128, NW = 8, QBLK = 32, KVBLK = 64;
constexpr float SCALE = 0.088388347648318440f;
constexpr float THR = 8.f;
using f32x4 = __attribute__((ext_vector_type(4))) float;
constexpr int SDEPTH = 1;
constexpr int LDQ = 7680, LDK = 256, LDO = 1024;
constexpr size_t SHM_V = KVBLK * D * 2, SHM_K = KVBLK * D * 2, SHM_ATTN = 2 * SHM_V + 2 * SHM_K + NW * 64 * 4;
using bf16x8 = __attribute__((ext_vector_type(8))) short;
using s16x4  = __attribute__((ext_vector_type(4))) short;
using f32x16 = __attribute__((ext_vector_type(16))) float;
using f32x8  = __attribute__((ext_vector_type(8))) float;
using u32x4  = __attribute__((ext_vector_type(4))) unsigned;
#define KSWZ(row, colB) ((row) * 256 + ((colB) ^ (((row) & 7) << 4)))
#define SBAR() __builtin_amdgcn_sched_barrier(0)
__device__ __forceinline__ int crow(int r, int hi) { return (r & 3) + 8 * (r >> 2) + 4 * hi; }
__device__ __forceinline__ unsigned cvtpk(float lo, float hi) {
  unsigned r; asm volatile("v_cvt_pk_bf16_f32 %0, %1, %2" : "=v"(r) : "v"(lo), "v"(hi)); return r;
}
template <typename TIn> struct Stage;
template <> struct Stage<bf16>  { using T = bf16x8;
  __device__ static __forceinline__ T ld8(const bf16* p) { return *reinterpret_cast<const bf16x8*>(p); }
  __device__ static __forceinline__ bf16x8 tobf(T x) { return x; } };
template <> struct Stage<float> { using T = f32x8;
  __device__ static __forceinline__ T ld8(const float* p) { return *reinterpret_cast<const f32x8*>(p); }
  __device__ static __forceinline__ bf16x8 tobf(T x) {
    u32x4 w = {cvtpk(x[0], x[1]), cvtpk(x[2], x[3]), cvtpk(x[4], x[5]), cvtpk(x[6], x[7])}; return *reinterpret_cast<bf16x8*>(&w); } };

__device__ __forceinline__ void partialSM(f32x16& p0, f32x16& p1, float& m_reg, float& mn, float& alpha) {
  constexpr float C = SCALE * 1.4426950408889634f;
  float pmax = p0[0]; for (int r = 1; r < 16; ++r) pmax = fmaxf(pmax, p0[r]); for (int r = 0; r < 16; ++r) pmax = fmaxf(pmax, p1[r]);
  { auto rr = __builtin_amdgcn_permlane32_swap(__float_as_uint(pmax), __float_as_uint(pmax), false, false);
    pmax = fmaxf(__uint_as_float(rr[0]), __uint_as_float(rr[1])); }
  if (__builtin_expect(__all(pmax - m_reg <= THR / SCALE), 1)) { mn = m_reg; alpha = 1.f; }
  else { mn = fmaxf(m_reg, pmax); alpha = __builtin_amdgcn_exp2f((m_reg - mn) * C); m_reg = mn; }
  float mnC = -mn * C;
  for (int r = 0; r < 16; ++r) p0[r] = fmaf(p0[r], C, mnC); for (int r = 0; r < 16; ++r) p1[r] = fmaf(p1[r], C, mnC);
  for (int r = 0; r < 16; ++r) p0[r] = __builtin_amdgcn_exp2f(p0[r]);
}
__device__ __forceinline__ void finishSM(f32x16& p0, f32x16& p1, float alpha, float& l_reg, bf16x8& pa0, bf16x8& pa1, bf16x8& pa2, bf16x8& pa3) {
  for (int r = 0; r < 16; ++r) p1[r] = __builtin_amdgcn_exp2f(p1[r]);
  float ps = 0; for (int r = 0; r < 16; ++r) ps += p0[r]; for (int r = 0; r < 16; ++r) ps += p1[r];
  { auto rr = __builtin_amdgcn_permlane32_swap(__float_as_uint(ps), __float_as_uint(ps), false, false);
    ps = __uint_as_float(rr[0]) + __uint_as_float(rr[1]); }
  l_reg = l_reg * alpha + ps;
#define PK4(P, BASE, OUT) do { unsigned a0 = cvtpk(P[BASE + 0], P[BASE + 1]), a1 = cvtpk(P[BASE + 2], P[BASE + 3]);   \
    unsigned b0 = cvtpk(P[BASE + 4], P[BASE + 5]), b1 = cvtpk(P[BASE + 6], P[BASE + 7]);                              \
    auto r0 = __builtin_amdgcn_permlane32_swap(a0, b0, false, false); auto r1 = __builtin_amdgcn_permlane32_swap(a1, b1, false, false); \
    u32x4 w = {r0[0], r1[0], r0[1], r1[1]}; OUT = *reinterpret_cast<bf16x8*>(&w); } while (0)
  PK4(p0, 0, pa0); PK4(p0, 8, pa1); PK4(p1, 0, pa2); PK4(p1, 8, pa3);
#undef PK4
}
__device__ __forceinline__ void qkt(f32x16& p0, f32x16& p1, const bf16* Ks, const bf16x8* qr, int r32, int hi) {
  p0 = f32x16{}; p1 = f32x16{};
  for (int d0 = 0; d0 < 8; ++d0) { int cb = (d0 * 16 + hi * 8) * 2;
    bf16x8 b0 = *reinterpret_cast<const bf16x8*>((const char*)Ks + KSWZ(r32, cb));
    bf16x8 b1 = *reinterpret_cast<const bf16x8*>((const char*)Ks + KSWZ(32 + r32, cb));
    p0 = __builtin_amdgcn_mfma_f32_32x32x16_bf16(b0, qr[d0], p0, 0, 0, 0);
    p1 = __builtin_amdgcn_mfma_f32_32x32x16_bf16(b1, qr[d0], p1, 0, 0, 0); }
}
__device__ __forceinline__ int v_st(int k, int c) { const int kk = (k & ~0xC) | ((k & 4) << 1) | ((k & 8) >> 1); return ((kk >> 3) * 4 + (c >> 5)) * 512 + ((kk & 7) * 32 + (c & 31)) * 2; }
__device__ __forceinline__ int v_rd_base(int lane) { return ((lane & 3) << 3) | (((lane >> 2) & 3) << 6) | (((lane >> 4) & 1) << 5) | (((lane >> 5) & 1) << 8); }
constexpr int v_rd_off(int d0, int ks, int half) { return d0 * 512 + ks * 4096 + half * 2048; }
template <int OFF> __device__ __forceinline__ s16x4 tr_read(int vb) {
  s16x4 r; asm volatile("ds_read_b64_tr_b16 %0, %1 offset:%2" : "=&v"(r) : "v"(vb), "i"(OFF) : "memory"); return r;
}
template <int D0> __device__ __forceinline__ void pv_one(f32x16& od, int vb, bf16x8 pa0, bf16x8 pa1, bf16x8 pa2, bf16x8 pa3) {
  const s16x4 l0 = tr_read<v_rd_off(D0, 0, 0)>(vb), h0 = tr_read<v_rd_off(D0, 0, 1)>(vb), l1 = tr_read<v_rd_off(D0, 1, 0)>(vb), h1 = tr_read<v_rd_off(D0, 1, 1)>(vb);
  const s16x4 l2 = tr_read<v_rd_off(D0, 2, 0)>(vb), h2 = tr_read<v_rd_off(D0, 2, 1)>(vb), l3 = tr_read<v_rd_off(D0, 3, 0)>(vb), h3 = tr_read<v_rd_off(D0, 3, 1)>(vb);
  asm volatile("s_waitcnt lgkmcnt(0)" ::: "memory"); SBAR();
#define PK(L, H) (bf16x8){L[0], L[1], L[2], L[3], H[0], H[1], H[2], H[3]}
  od = __builtin_amdgcn_mfma_f32_32x32x16_bf16(pa0, PK(l0, h0), od, 0, 0, 0);
  od = __builtin_amdgcn_mfma_f32_32x32x16_bf16(pa1, PK(l1, h1), od, 0, 0, 0);
  od = __builtin_amdgcn_mfma_f32_32x32x16_bf16(pa2, PK(l2, h2), od, 0, 0, 0);
  od = __builtin_amdgcn_mfma_f32_32x32x16_bf16(pa3, PK(l3, h3), od, 0, 0, 0);
#undef PK
}
__device__ __forceinline__ void pv_d0(f32x16* o, int vb, bf16x8 pa0, bf16x8 pa1, bf16x8 pa2, bf16x8 pa3) {
  pv_one<0>(o[0], vb, pa0, pa1, pa2, pa3); pv_one<1>(o[1], vb, pa0, pa1, pa2, pa3); pv_one<2>(o[2], vb, pa0, pa1, pa2, pa3); pv_one<3>(o[3], vb, pa0, pa1, pa2, pa3);
}

template <typename TQ>
__device__ __forceinline__ void attn_dense_body(const TQ* Qb, const bf16* __restrict__ Kh, const bf16* __restrict__ Vh,
                                                bf16* Ob, int seq, char* lds, const float* __restrict__ qgain, const float* __restrict__ tab, int tok0) {
  using St = Stage<bf16>; using SQ = Stage<TQ>;
  int tid_l = threadIdx.x; asm volatile("" : "+v"(tid_l));
  const int tid = tid_l, wid = tid >> 6, lane = tid & 63, r32 = lane & 31, hi = lane >> 5;
  bf16* V_lds = (bf16*)lds; bf16* K_lds = (bf16*)(lds + 2 * SHM_V);
  float* ws = (float*)(lds + 2 * SHM_V + 2 * SHM_K) + wid * 64; float* li_l = ws; float* al_l = ws + 32;
  float m_reg = -1e30f, l_reg = 0; f32x16 o[4] = {}; bf16x8 qr[8];
  const TQ* Qw = Qb + (long)(wid * QBLK + r32) * LDQ + hi * 8;
  {
    float y[8][8]; float ss = 0.f;
#pragma unroll
    for (int d0 = 0; d0 < 8; ++d0) { const u32x4 w = *reinterpret_cast<const u32x4*>(Qw + d0 * 16);
      y[d0][0] = __uint_as_float(w.x << 16); y[d0][1] = __uint_as_float(w.x & 0xffff0000u); y[d0][2] = __uint_as_float(w.y << 16); y[d0][3] = __uint_as_float(w.y & 0xffff0000u);
      y[d0][4] = __uint_as_float(w.z << 16); y[d0][5] = __uint_as_float(w.z & 0xffff0000u); y[d0][6] = __uint_as_float(w.w << 16); y[d0][7] = __uint_as_float(w.w & 0xffff0000u);
#pragma unroll
      for (int j = 0; j < 8; ++j) ss += y[d0][j] * y[d0][j]; }
    { auto rr = __builtin_amdgcn_permlane32_swap(__float_as_uint(ss), __float_as_uint(ss), false, false); ss = __uint_as_float(rr[0]) + __uint_as_float(rr[1]); }
    const float rstd = __builtin_amdgcn_rsqf(ss * (1.f / 128.f) + 1e-6f);
#pragma unroll
    for (int d0 = 0; d0 < 8; ++d0) { const f32x4 ga = *reinterpret_cast<const f32x4*>(qgain + d0 * 16 + hi * 8), gb = *reinterpret_cast<const f32x4*>(qgain + d0 * 16 + hi * 8 + 4);
      y[d0][0] *= rstd * ga[0]; y[d0][1] *= rstd * ga[1]; y[d0][2] *= rstd * ga[2]; y[d0][3] *= rstd * ga[3]; y[d0][4] *= rstd * gb[0]; y[d0][5] *= rstd * gb[1]; y[d0][6] *= rstd * gb[2]; y[d0][7] *= rstd * gb[3]; }
    const int tok = tok0 + wid * QBLK + r32, prow = (tok >> 6) & 63, pcol = tok & 63;
#pragma unroll
    for (int hf = 0; hf < 2; ++hf) { const int pos = hf ? pcol : prow;
#pragma unroll
      for (int db = 0; db < 2; ++db) { const float* tp = tab + (pos * 32 + db * 16 + hi * 8) * 2;
        const f32x4 t0 = *reinterpret_cast<const f32x4*>(tp), t1 = *reinterpret_cast<const f32x4*>(tp + 4), t2 = *reinterpret_cast<const f32x4*>(tp + 8), t3 = *reinterpret_cast<const f32x4*>(tp + 12);
        const float cs[8] = {t0[0], t0[2], t1[0], t1[2], t2[0], t2[2], t3[0], t3[2]}, sn[8] = {t0[1], t0[3], t1[1], t1[3], t2[1], t2[3], t3[1], t3[3]};
#pragma unroll
        for (int j = 0; j < 8; ++j) { const float x1 = y[hf * 4 + db][j], x2 = y[hf * 4 + db + 2][j]; y[hf * 4 + db][j] = x1 * cs[j] - x2 * sn[j]; y[hf * 4 + db + 2][j] = x2 * cs[j] + x1 * sn[j]; } } }
#pragma unroll
    for (int d0 = 0; d0 < 8; ++d0) { u32x4 w = {cvtpk(y[d0][0], y[d0][1]), cvtpk(y[d0][2], y[d0][3]), cvtpk(y[d0][4], y[d0][5]), cvtpk(y[d0][6], y[d0][7])}; qr[d0] = *reinterpret_cast<bf16x8*>(&w); }
  }
  const int sr = tid >> 4, sc = (tid & 15) * 8, vst0 = v_st(sr, sc), vst1 = v_st(32 + sr, sc);
  const int vb0 = (int)(uintptr_t)V_lds + v_rd_base(lane);
  struct { typename St::T vs0, vs1, ks0, ks1; } sr_[SDEPTH];
  const unsigned voff0 = (unsigned)(sr * LDK + sc) * 2u, voff1 = voff0 + 32u * LDK * 2u;
#define SLOAD(i, k0) do { const char* vb_ = (const char*)Vh + (size_t)(k0) * (LDK * 2); const char* kb_ = (const char*)Kh + (size_t)(k0) * (LDK * 2); \
    sr_[i].vs0 = *(const bf16x8*)(vb_ + voff0); sr_[i].vs1 = *(const bf16x8*)(vb_ + voff1); \
    sr_[i].ks0 = *(const bf16x8*)(kb_ + voff0); sr_[i].ks1 = *(const bf16x8*)(kb_ + voff1); } while (0)
#define SWRITE(b, i) do { *(bf16x8*)((char*)V_lds + (b) * SHM_V + vst0) = St::tobf(sr_[i].vs0);          \
    *(bf16x8*)((char*)V_lds + (b) * SHM_V + vst1) = St::tobf(sr_[i].vs1); int kc = sc * 2;               \
    *(bf16x8*)((char*)K_lds + (b) * SHM_K + KSWZ(sr, kc)) = St::tobf(sr_[i].ks0);                       \
    *(bf16x8*)((char*)K_lds + (b) * SHM_K + KSWZ(32 + sr, kc)) = St::tobf(sr_[i].ks1); } while (0)
#define SWAIT() do { if constexpr (SDEPTH == 2) asm volatile("s_waitcnt vmcnt(4)" ::: "memory"); else asm volatile("s_waitcnt vmcnt(0)" ::: "memory"); } while (0)
#define RESC(a) do { if (__any((a) < 1.f)) { if (hi == 0) al_l[r32] = (a); asm volatile("s_waitcnt lgkmcnt(0)" ::: "memory"); \
    for (int d = 0; d < 4; ++d) for (int r = 0; r < 16; ++r) o[d][r] *= al_l[crow(r, hi)]; } } while (0)
  f32x16 pA0, pA1, pB0, pB1; float mnA, mnB, alA, alB; bf16x8 pa0, pa1, pa2, pa3; const int NT = seq / KVBLK;
  constexpr int SE = 0, SO = SDEPTH - 1;
  SLOAD(SE, 0); asm volatile("s_waitcnt vmcnt(0)" ::: "memory"); SWRITE(0, SE); __syncthreads();
  qkt(pA0, pA1, K_lds, qr, r32, hi); partialSM(pA0, pA1, m_reg, mnA, alA);
  SLOAD(SO, KVBLK); if constexpr (SDEPTH == 2) { if (2 < NT) SLOAD(SE, 2 * KVBLK); }
  SWAIT(); SWRITE(1, SO); __syncthreads();
  for (int j = 1; j + 1 < NT; j += 2) {
    SBAR(); qkt(pB0, pB1, (bf16*)((char*)K_lds + SHM_K), qr, r32, hi);
    finishSM(pA0, pA1, alA, l_reg, pa0, pa1, pa2, pa3); SBAR();
    SLOAD(SO, (j + SDEPTH) * KVBLK); SBAR();
    pv_d0(o, vb0, pa0, pa1, pa2, pa3); partialSM(pB0, pB1, m_reg, mnB, alB);
    __syncthreads(); SWAIT(); SWRITE(0, SE);
    RESC(alB); __syncthreads();
    SBAR(); qkt(pA0, pA1, K_lds, qr, r32, hi);
    finishSM(pB0, pB1, alB, l_reg, pa0, pa1, pa2, pa3); SBAR();
    if (SDEPTH == 1 || j + 3 < NT) SLOAD(SE, (j + 1 + SDEPTH) * KVBLK); SBAR();
    pv_d0(o, vb0 + (int)SHM_V, pa0, pa1, pa2, pa3); partialSM(pA0, pA1, m_reg, mnA, alA);
    __syncthreads(); SWAIT(); SWRITE(1, SO);
    RESC(alA); __syncthreads();
  }
  SBAR(); qkt(pB0, pB1, (bf16*)((char*)K_lds + SHM_K), qr, r32, hi);
  finishSM(pA0, pA1, alA, l_reg, pa0, pa1, pa2, pa3); SBAR();
  pv_d0(o, vb0, pa0, pa1, pa2, pa3); partialSM(pB0, pB1, m_reg, mnB, alB);
  __syncthreads(); RESC(alB);
  finishSM(pB0, pB1, alB, l_reg, pa0, pa1, pa2, pa3); SBAR();
  pv_d0(o, vb0 + (int)SHM_V, pa0, pa1, pa2, pa3);
  if (hi == 0) li_l[r32] = l_reg; asm volatile("s_waitcnt lgkmcnt(0)" ::: "memory");
  float rli[16];
#pragma unroll
  for (int r = 0; r < 16; ++r) rli[r] = __builtin_amdgcn_rcpf(li_l[crow(r, hi)]);
  bf16* Ow = Ob + (long)(wid * QBLK) * LDO;
#pragma unroll
  for (int r = 0; r < 16; ++r) { int orow = crow(r, hi);
    for (int d0 = 0; d0 < 4; ++d0) Ow[(long)orow * LDO + d0 * 32 + r32] = __builtin_bit_cast(bf16, (unsigned short)(cvtpk(o[d0][r] * rli[r], 0.f) & 0xffffu)); }
#undef SLOAD
#undef SWRITE
#undef SWAIT
#undef RESC
}
#undef KSWZ
#undef SBAR
}
#define LAS __attribute__((address_space(3)))
typedef unsigned short bf16_t;
typedef float f32x4 __attribute__((ext_vector_type(4)));
typedef unsigned u32x4 __attribute__((ext_vector_type(4)));
typedef unsigned u32x2 __attribute__((ext_vector_type(2)));
typedef short bf16x8 __attribute__((ext_vector_type(8)));

constexpr int T = 49152, TP = 32768, DM = 2048, SEQ = 4096, NBATCH = 12, DFF = 8192, PLE = 256;
constexpr int PP = 7680;
constexpr int C_NAQ = 0, C_NAK = 1024, C_GQ = 2048, C_GK = 3072, C_GV = 3328, C_GA = 3584, C_GB = 5632;
constexpr float EPS = 1e-6f;
constexpr size_t MiB = 1u << 20;
constexpr size_t WS_TAB = 0, WS_WIN = 1 * MiB, WS_WNA = 35 * MiB, WS_WGQA = 39 * MiB, WS_WMIX = 43 * MiB, WS_WFF1 = 51 * MiB, WS_WFF2 = 83 * MiB,
                 WS_WPG = 115 * MiB, WS_WPP = 123 * MiB, WS_PB = 124 * MiB, WS_VT = 148 * MiB, WS_PROJ = 244 * MiB, WS_END0 = 964 * MiB;
constexpr size_t WS_Y = 244 * MiB, WS_H = 436 * MiB, WS_HID = 628 * MiB, WS_EP = 628 * MiB, WS_END = 1012 * MiB;
constexpr int LDS_BYTES = 147456;
constexpr int NTHREADS = 512;

struct Params {
    const float* x_p; const float* x_s; const float* p_p; const float* p_s;
    const float* ln_mix_pre; const float* w_in; const float* q_norm; const float* k_norm; const float* na_rpb;
    const float* w_na; const float* w_gqa; const float* w_mix; const float* ln_mix_post; const float* ln_mlp_pre;
    const float* w_ff1; const float* w_ff2; const float* ln_mlp_post; const float* ln_ple_pre; const float* w_ple_gate; const float* w_ple_proj; const float* ln_ple_post;
    float* out; unsigned char* ws;
};

__device__ __forceinline__ unsigned pk_bf16(float lo, float hi) { unsigned r; asm volatile("v_cvt_pk_bf16_f32 %0, %1, %2" : "=v"(r) : "v"(lo), "v"(hi)); return r; }
__device__ __forceinline__ float bflo(unsigned u) { return __uint_as_float(u << 16); }
__device__ __forceinline__ float bfhi(unsigned u) { return __uint_as_float(u & 0xffff0000u); }
__device__ __forceinline__ float wave_sum(float v) {
#pragma unroll
    for (int o = 1; o < 64; o <<= 1) v += __shfl_xor(v, o);
    return v;
}

__device__ __forceinline__ void transpose_item(const float* W, int K, int N, bf16_t* WT, int k0, int n0, int drow0, LAS float* scr, int lane, const float* gk) {
#pragma unroll 8
    for (int i = 0; i < 32; ++i) { const int kk = 2 * i + (lane >> 5); scr[kk * 33 + (lane & 31)] = W[(size_t)(k0 + kk) * N + n0 + (lane & 31)] * (gk ? gk[k0 + kk] : 1.f); }
    asm volatile("s_waitcnt lgkmcnt(0)" ::: "memory");
    const int c = lane & 7;
#pragma unroll
    for (int j = 0; j < 4; ++j) { const int n = (lane >> 3) + 8 * j; const LAS float* s = scr + (8 * c) * 33 + n;
        u32x4 o; o.x = pk_bf16(s[0 * 33], s[1 * 33]); o.y = pk_bf16(s[2 * 33], s[3 * 33]); o.z = pk_bf16(s[4 * 33], s[5 * 33]); o.w = pk_bf16(s[6 * 33], s[7 * 33]);
        *(u32x4*)(WT + (size_t)(drow0 + n) * K + k0 + 8 * c) = o; }
    asm volatile("s_waitcnt lgkmcnt(0)" ::: "memory");
}
__device__ __forceinline__ bool transpose_mat(int& r, const float* W, int K, int N, bf16_t* WT, LAS float* scr, int lane, bool remap_in, const float* gk = nullptr) {
    const int nblk = N / 32, items = (K / 64) * nblk;
    if (r >= items) { r -= items; return false; }
    const int kb = r / nblk, nb = r % nblk, n0 = nb * 32;
    int d0 = n0;
    if (remap_in) d0 = (n0 < 2048) ? n0 : (n0 < 3072 ? n0 - 2048 + 7680 : n0 - 1024);
    transpose_item(W, K, N, WT, kb * 64, n0, d0, scr, lane, gk);
    return true;
}

__device__ __forceinline__ const float* xrow_in(const Params& P, int m) { return m < TP ? P.x_p + (size_t)m * DM : P.x_s + (size_t)(m - TP) * DM; }

template <int MODE>
__device__ __forceinline__ void row_pass(const Params& P, const bf16_t* Y, const bf16_t* XS, bf16_t* XB, float* RS, const float* g1, int gw, int ngw) {
    int tid_l = threadIdx.x; asm volatile("" : "+v"(tid_l)); const int lane = tid_l & 63;
    for (int m0 = gw; m0 < T; m0 += 2 * ngw) {
        const int mr[2] = {m0, min(m0 + ngw, T - 1)}; const bool ok1 = (m0 + ngw < T);
        float x[2][4][8], y[2][4][8];
#pragma unroll
        for (int r = 0; r < 2; ++r) { const int mm = mr[r];
            if (MODE == 0 || MODE == 1) { const float* base = xrow_in(P, mm);
#pragma unroll
                for (int j = 0; j < 4; ++j) { const f32x4 a = *(const f32x4*)(base + j * 512 + lane * 8), b = *(const f32x4*)(base + j * 512 + lane * 8 + 4);
                    x[r][j][0] = a[0]; x[r][j][1] = a[1]; x[r][j][2] = a[2]; x[r][j][3] = a[3]; x[r][j][4] = b[0]; x[r][j][5] = b[1]; x[r][j][6] = b[2]; x[r][j][7] = b[3]; }
            } else {
#pragma unroll
                for (int j = 0; j < 4; ++j) { const u32x4 w = *(const u32x4*)(XS + (size_t)mm * DM + j * 512 + lane * 8);
                    x[r][j][0] = bflo(w.x); x[r][j][1] = bfhi(w.x); x[r][j][2] = bflo(w.y); x[r][j][3] = bfhi(w.y); x[r][j][4] = bflo(w.z); x[r][j][5] = bfhi(w.z); x[r][j][6] = bflo(w.w); x[r][j][7] = bfhi(w.w); }
            }
            if (MODE != 0) {
#pragma unroll
                for (int j = 0; j < 4; ++j) { const u32x4 w = *(const u32x4*)(Y + (size_t)mm * DM + j * 512 + lane * 8);
                    y[r][j][0] = bflo(w.x); y[r][j][1] = bfhi(w.x); y[r][j][2] = bflo(w.y); y[r][j][3] = bfhi(w.y); y[r][j][4] = bflo(w.z); y[r][j][5] = bfhi(w.z); y[r][j][6] = bflo(w.w); y[r][j][7] = bfhi(w.w); }
            }
        }
#pragma unroll
        for (int r = 0; r < 2; ++r) { const int mm = mr[r]; const bool ok = (r == 0) || ok1;
            if (MODE != 0) {
                float ss = 0.f;
#pragma unroll
                for (int j = 0; j < 4; ++j)
#pragma unroll
                    for (int i = 0; i < 8; ++i) ss += y[r][j][i] * y[r][j][i];
                const float rstd = __builtin_amdgcn_rsqf(wave_sum(ss) * (1.f / DM) + EPS);
#pragma unroll
                for (int j = 0; j < 4; ++j) { const f32x4 ga = *(const f32x4*)(g1 + j * 512 + lane * 8), gb = *(const f32x4*)(g1 + j * 512 + lane * 8 + 4);
                    const float gg[8] = {ga[0], ga[1], ga[2], ga[3], gb[0], gb[1], gb[2], gb[3]};
#pragma unroll
                    for (int i = 0; i < 8; ++i) x[r][j][i] += y[r][j][i] * rstd * gg[i]; }
            }
            if (MODE == 2) {
                if (ok) {
#pragma unroll
                    for (int j = 0; j < 4; ++j) { float* o = P.out + (size_t)mm * DM + j * 512 + lane * 8;
                        *(f32x4*)o = (f32x4){x[r][j][0], x[r][j][1], x[r][j][2], x[r][j][3]}; *(f32x4*)(o + 4) = (f32x4){x[r][j][4], x[r][j][5], x[r][j][6], x[r][j][7]}; } }
            } else {
                float ss = 0.f;
#pragma unroll
                for (int j = 0; j < 4; ++j)
#pragma unroll
                    for (int i = 0; i < 8; ++i) ss += x[r][j][i] * x[r][j][i];
                const float rstd = __builtin_amdgcn_rsqf(wave_sum(ss) * (1.f / DM) + EPS);
                if (ok) {
                    if (MODE == 0) {
#pragma unroll
                        for (int j = 0; j < 4; ++j) { const f32x4 ga = *(const f32x4*)(g1 + j * 512 + lane * 8), gb = *(const f32x4*)(g1 + j * 512 + lane * 8 + 4);
                            u32x4 w; w.x = pk_bf16(x[r][j][0] * rstd * ga[0], x[r][j][1] * rstd * ga[1]); w.y = pk_bf16(x[r][j][2] * rstd * ga[2], x[r][j][3] * rstd * ga[3]);
                            w.z = pk_bf16(x[r][j][4] * rstd * gb[0], x[r][j][5] * rstd * gb[1]); w.w = pk_bf16(x[r][j][6] * rstd * gb[2], x[r][j][7] * rstd * gb[3]);
                            *(u32x4*)(XB + (size_t)mm * DM + j * 512 + lane * 8) = w; }
                    } else {
                        if (lane == 0) RS[mm] = rstd;
#pragma unroll
                        for (int j = 0; j < 4; ++j) { u32x4 w; w.x = pk_bf16(x[r][j][0], x[r][j][1]); w.y = pk_bf16(x[r][j][2], x[r][j][3]); w.z = pk_bf16(x[r][j][4], x[r][j][5]); w.w = pk_bf16(x[r][j][6], x[r][j][7]);
                            *(u32x4*)(XB + (size_t)mm * DM + j * 512 + lane * 8) = w; }
                    }
                }
            }
        }
    }
}

__device__ __forceinline__ void qk_norm_rope(const Params& P, const bf16_t* PROJ, bf16_t* QC, bf16_t* KC, bf16_t* VC, const LAS float* tabl, int gw, int ngw, int lane_in) {
    (void)lane_in; int tid_l = threadIdx.x; asm volatile("" : "+v"(tid_l)); const int lane = tid_l & 63;
    const int hd4 = lane >> 4, c = lane & 15, half = c >> 3, isx2 = (c >> 2) & 1, i0 = (c & 3) * 8;
    float gq[8], gk[8];
#pragma unroll
    for (int i = 0; i < 8; ++i) { gq[i] = P.q_norm[c * 8 + i]; gk[i] = P.k_norm[c * 8 + i]; }
    for (int it0 = gw * 4; it0 < T; it0 += ngw * 4) {
        u32x4 wv[4];
#pragma unroll
        for (int k = 0; k < 4; ++k) { const int t = it0 + k, grp = 2;
            wv[k] = *(const u32x4*)(PROJ + (size_t)t * PP + C_GQ + (grp * 4 + hd4) * 128 + c * 8); }
#pragma unroll
        for (int k = 0; k < 4; ++k) {
            const int t = it0 + k, grp = 2;
            const u32x4 w = wv[k];
            float x[8] = {bflo(w.x), bfhi(w.x), bflo(w.y), bfhi(w.y), bflo(w.z), bfhi(w.z), bflo(w.w), bfhi(w.w)};
            float ss = 0.f;
#pragma unroll
            for (int i = 0; i < 8; ++i) ss += x[i] * x[i];
            ss += __shfl_xor(ss, 1); ss += __shfl_xor(ss, 2); ss += __shfl_xor(ss, 4); ss += __shfl_xor(ss, 8);
            const float rstd = __builtin_amdgcn_rsqf(ss * (1.f / 128.f) + EPS);
            const int sq = t & (SEQ - 1), pos = half ? (sq & 63) : (sq >> 6);
            const LAS float* tp = tabl + (pos * 32 + i0) * 2;
            float o[8];
#pragma unroll
            for (int i = 0; i < 8; ++i) { const float y = x[i] * rstd * (grp < 2 ? gq[i] : gk[i]); const float yp = __shfl_xor(y, 4);
                const float cs = tp[2 * i], sn = tp[2 * i + 1]; o[i] = isx2 ? (y * cs + yp * sn) : (y * cs - yp * sn); }
            u32x4 r; r.x = pk_bf16(o[0], o[1]); r.y = pk_bf16(o[2], o[3]); r.z = pk_bf16(o[4], o[5]); r.w = pk_bf16(o[6], o[7]);
            bf16_t* dst;
            if (grp < 2) dst = QC + (size_t)t * 1024 + (grp * 4 + hd4) * 128 + c * 8;
            else if (hd4 < 2) dst = KC + (size_t)t * 256 + hd4 * 128 + c * 8;
            else { dst = VC + (size_t)t * 256 + (hd4 - 2) * 128 + c * 8; r = w; }
            *(u32x4*)dst = r;
        }
    }
}

namespace na {
constexpr int KROW = 272, VROW = 144, VOFF = 64 * KROW, BUF = 36864, RPB_OFF = 2 * BUF, NA_LDS_END = RPB_OFF + 16384;
__device__ __forceinline__ void na_phase(const bf16_t* PROJ, const bf16_t* VT, const float* rpb, bf16_t* OUT, int opitch, int vcu, int G, LAS unsigned char* lds) {
    const int NU = NBATCH * 8 * 16, per = (NU + G - 1) / G;
    const bool xmap = (G == 256);
    const int ub = vcu * per, nun = xmap ? 6 : max(min(ub + per, NU) - ub, 0);
#define NA_UNIT(i) (xmap ? ((((vcu >> 5) * 12 + 2 * (i) + ((vcu & 31) >> 4)) << 4) + (vcu & 15)) : (ub + (i)))
    int tid_l = threadIdx.x; asm volatile("" : "+v"(tid_l));
    const int tid = tid_l, w = __builtin_amdgcn_readfirstlane(tid >> 6), lane = tid & 63, l15 = lane & 15, g = lane >> 4;
    const int qr = w >> 1, ch = w & 1;
    LAS float* rp = (LAS float*)(lds + RPB_OFF);
    for (int i = tid; i < 8 * 15 * 32; i += NTHREADS) { const int c31 = i & 31, hr = i >> 5; rp[i] = (c31 < 31) ? rpb[hr * 31 + c31] * 1.4426950408889634f : -1e30f; }
    if (nun <= 0) return;
    unsigned boff[2][8];
#pragma unroll
    for (int c2 = 0; c2 < 2; ++c2) { const int qc0 = 16 * (2 * ch + c2), cb = min(max(qc0 - 8, 0), 32), qcol = qc0 + l15, cs = min(max(qcol - 8, 0), 48);
#pragma unroll
        for (int e = 0; e < 8; ++e) { const int kc = cb + (e >> 2) * 16 + 4 * g + (e & 3); boff[c2][e] = ((kc >= cs) && (kc < cs + 16)) ? (unsigned)(kc - qcol + 15) * 4u : 124u; } }
    u32x4 st[3][4];
    unsigned koff[2], klds[2], vlds[2];
#pragma unroll
    for (int i_ = 0; i_ < 2; ++i_) { const int c_ = tid + 512 * i_;
        koff[i_] = (unsigned)((c_ >> 4) * PP + (c_ & 15) * 8) * 2u; klds[i_] = (unsigned)((c_ >> 4) * KROW + (c_ & 15) * 16);
        vlds[i_] = (unsigned)(VOFF + (c_ >> 3) * VROW + (c_ & 7) * 16); }
#define NA_DEC(uu) const int pr_ = (uu) >> 4, r0_ = 4 * ((uu) & 15), b_ = pr_ >> 3, hd_ = pr_ & 7, kr0_ = min(max(r0_ - 4, 0), 56), n_ = min(max(r0_ - 1, 0), 56) - kr0_ + 8
#define NA_LOADT(set, uu, t) do { NA_DEC(uu); { const int kr_ = min(kr0_ + (t), 63); (void)n_;     \
        const char* kb_ = (const char*)(PROJ + ((size_t)b_ * SEQ + (size_t)kr_ * 64) * PP + C_NAK + hd_ * 128); \
        const char* vb_ = (const char*)(VT + ((((size_t)b_ * 64 + kr_) * 8 + hd_) * 128) * 64); \
        st[set][0] = *(const u32x4*)(kb_ + koff[0]); st[set][1] = *(const u32x4*)(kb_ + koff[1]); \
        st[set][2] = *(const u32x4*)(vb_ + (unsigned)tid * 16u); st[set][3] = *(const u32x4*)(vb_ + (unsigned)(tid + 512) * 16u); } } while (0)
#define NA_WRITET(set, t) do { LAS unsigned char* bp_ = lds + ((t) & 1) * BUF; \
        *(LAS u32x4*)(bp_ + klds[0]) = st[set][0]; *(LAS u32x4*)(bp_ + klds[1]) = st[set][1]; *(LAS u32x4*)(bp_ + vlds[0]) = st[set][2]; *(LAS u32x4*)(bp_ + vlds[1]) = st[set][3]; } while (0)
    { const int u0 = NA_UNIT(0); NA_LOADT(0, u0, 0); NA_LOADT(1, u0, 1); NA_LOADT(2, u0, 2); }
    const float scale = 0.088388347648318440f, L2E = 1.4426950408889634f;
    for (int ui = 0; ui < nun; ++ui) {
        const bool has_next = (ui + 1 < nun);
        const int u = NA_UNIT(ui), un = has_next ? NA_UNIT(ui + 1) : u;
        const int pr = u >> 4, r0 = 4 * (u & 15), b = pr >> 3, head = pr & 7, kr0 = min(max(r0 - 4, 0), 56), n = min(max(r0 - 1, 0), 56) - kr0 + 8;
        const int r = r0 + qr, rsw = min(max(r - 4, 0), 56);
        const size_t tokq = (size_t)b * SEQ + r * 64;
        bf16x8 qf[2][4];
#pragma unroll
        for (int c2 = 0; c2 < 2; ++c2) { const bf16_t* qp = PROJ + (tokq + 16 * (2 * ch + c2) + l15) * PP + C_NAQ + head * 128 + 8 * g;
#pragma unroll
            for (int dc = 0; dc < 4; ++dc) qf[c2][dc] = *(const bf16x8*)(qp + dc * 32); }
#pragma unroll
        for (int c2 = 0; c2 < 2; ++c2)
#pragma unroll
            for (int dc = 0; dc < 4; ++dc) asm volatile("" : "+v"(qf[c2][dc]));
        float mrun[2] = {-1e30f, -1e30f}, lrun[2] = {0.f, 0.f};
        f32x4 O[2][8];
#pragma unroll
        for (int c2 = 0; c2 < 2; ++c2)
#pragma unroll
            for (int db = 0; db < 8; ++db) O[c2][db] = (f32x4){0.f, 0.f, 0.f, 0.f};
        const LAS unsigned char* rph = (const LAS unsigned char*)(rp + head * 480);
#pragma unroll
        for (int t = 0; t < 12; ++t) {
            NA_WRITET(t % 3, t);
            if (t + 3 < 12) NA_LOADT(t % 3, u, t + 3); else NA_LOADT(t % 3, un, t + 3 - 12);
            __syncthreads();
            const int kr = kr0 + t;
            if (kr >= rsw && kr < rsw + 8) {
                const LAS unsigned char* bp = lds + (t & 1) * BUF;
                const LAS unsigned char* brow = rph + (kr - r + 7) * 128;
#pragma unroll
                for (int c2 = 0; c2 < 2; ++c2) {
                    const int qc0 = 16 * (2 * ch + c2), cb = min(max(qc0 - 8, 0), 32);
                    const LAS unsigned char* kp = bp + (cb + l15) * KROW + 16 * g;
                    float bias[8];
#pragma unroll
                    for (int e = 0; e < 8; ++e) bias[e] = *(const LAS float*)(brow + boff[c2][e]);
                    f32x4 S[2];
#pragma unroll
                    for (int kb = 0; kb < 2; ++kb) { bf16x8 ka[4]; S[kb] = (f32x4){0.f, 0.f, 0.f, 0.f};
#pragma unroll
                        for (int dc = 0; dc < 4; ++dc) ka[dc] = *(const LAS bf16x8*)(kp + kb * 16 * KROW + dc * 64);
#pragma unroll
                        for (int dc = 0; dc < 4; ++dc) S[kb] = __builtin_amdgcn_mfma_f32_16x16x32_bf16(ka[dc], qf[c2][dc], S[kb], 0, 0, 0); }
                    float sv[8]; float tm = -1e30f;
#pragma unroll
                    for (int e = 0; e < 8; ++e) { sv[e] = fmaf(S[e >> 2][e & 3], scale * L2E, bias[e]); tm = fmaxf(tm, sv[e]); }
                    tm = fmaxf(tm, __shfl_xor(tm, 16)); tm = fmaxf(tm, __shfl_xor(tm, 32));
                    const float mn = fmaxf(mrun[c2], tm), alpha = __builtin_amdgcn_exp2f(mrun[c2] - mn);
                    mrun[c2] = mn;
                    float ps = 0.f;
#pragma unroll
                    for (int e = 0; e < 8; ++e) { const float p = __builtin_amdgcn_exp2f(sv[e] - mn); sv[e] = p; ps += p; }
                    lrun[c2] = lrun[c2] * alpha + ps;
                    if (__any(alpha != 1.f)) {
#pragma unroll
                        for (int db = 0; db < 8; ++db) O[c2][db] = O[c2][db] * alpha; }
                    u32x4 pw; pw.x = pk_bf16(sv[0], sv[1]); pw.y = pk_bf16(sv[2], sv[3]); pw.z = pk_bf16(sv[4], sv[5]); pw.w = pk_bf16(sv[6], sv[7]);
                    const bf16x8 pj = __builtin_bit_cast(bf16x8, pw);
                    const LAS unsigned char* vp = bp + VOFF + l15 * VROW + (cb + 4 * g) * 2;
#pragma unroll
                    for (int dh = 0; dh < 2; ++dh) { u32x2 vlo[4], vhi[4];
#pragma unroll
                        for (int d4 = 0; d4 < 4; ++d4) { vlo[d4] = *(const LAS u32x2*)(vp + (dh * 4 + d4) * 16 * VROW); vhi[d4] = *(const LAS u32x2*)(vp + (dh * 4 + d4) * 16 * VROW + 32); }
#pragma unroll
                        for (int d4 = 0; d4 < 4; ++d4) { const u32x4 aw = {vlo[d4].x, vlo[d4].y, vhi[d4].x, vhi[d4].y};
                            O[c2][dh * 4 + d4] = __builtin_amdgcn_mfma_f32_16x16x32_bf16(__builtin_bit_cast(bf16x8, aw), pj, O[c2][dh * 4 + d4], 0, 0, 0); } }
                }
            }
        }
#pragma unroll
        for (int c2 = 0; c2 < 2; ++c2) {
            float lt = lrun[c2]; lt += __shfl_xor(lt, 16); lt += __shfl_xor(lt, 32);
            const float inv = 1.f / lt;
            bf16_t* op = OUT + (tokq + 16 * (2 * ch + c2) + l15) * opitch + head * 128 + 4 * g;
#pragma unroll
            for (int db = 0; db < 8; ++db) { u32x2 o; o.x = pk_bf16(O[c2][db][0] * inv, O[c2][db][1] * inv); o.y = pk_bf16(O[c2][db][2] * inv, O[c2][db][3] * inv); *(u32x2*)(op + db * 16) = o; }
        }
    }
#undef NA_LOADT
#undef NA_WRITET
#undef NA_DEC
#undef NA_UNIT
}
}

#define XB_TMO      128
#define XB_XCNT(j)  (256  + 64 * (j))
#define XB_XSUB(j)  (1280 + 64 * (j))
#define XB_XGEN(j)  (2304 + 64 * (j))
#define XB_TOP      3328
#define XB_TOPGEN   3392
#define XCD_BAR_WORDS 3456
#define XB_SPIN_CAP (1u << 18)

__device__ __forceinline__ unsigned xb_ld(unsigned* p)              { return __hip_atomic_load(p, __ATOMIC_RELAXED, __HIP_MEMORY_SCOPE_AGENT); }
__device__ __forceinline__ unsigned xb_add(unsigned* p, unsigned v) { return __hip_atomic_fetch_add(p, v, __ATOMIC_RELAXED, __HIP_MEMORY_SCOPE_AGENT); }
__device__ __forceinline__ unsigned xb_xcc_id() { return (unsigned)__builtin_amdgcn_s_getreg((3 << 11) | 20) & 0xFu; }
#define XB_SPIN(cond, bar) do { unsigned _sp = 0; while (cond) { __builtin_amdgcn_s_sleep(1); \
    if ((++_sp & 255u) == 0u) { if (xb_ld(&(bar)[XB_TMO])) break; if (_sp > XB_SPIN_CAP) { atomicAdd(&(bar)[XB_TMO], 1u); break; } } } } while (0)

struct XcdBarrier {
    unsigned* bar; unsigned x;
    volatile LAS unsigned* st;
};

__device__ __forceinline__ XcdBarrier xcd_barrier_post(unsigned* bar, volatile LAS unsigned* st) {
    XcdBarrier b; b.bar = bar; b.x = xb_xcc_id(); b.st = st;
    if (threadIdx.x == 0) (void)xb_add(&bar[XB_XCNT(b.x)], 1u);
    return b;
}
__device__ __forceinline__ void xcd_barrier_complete(unsigned* bar, unsigned x, unsigned& nloc, unsigned& nx) {
    const unsigned G = gridDim.x * gridDim.y * gridDim.z;
    unsigned sum, cnt, mine, sp = 0u;
    for (;;) {
        sum = 0u; cnt = 0u; mine = 0u;
#pragma unroll
        for (unsigned j = 0; j < 16; ++j) { const unsigned c = xb_ld(&bar[XB_XCNT(j)]); sum += c; cnt += (c > 0u) ? 1u : 0u; mine = (j == x) ? c : mine; }
        if (sum == G) break;
        __builtin_amdgcn_s_sleep(1);
        if ((++sp & 255u) == 0u) { if (xb_ld(&bar[XB_TMO])) break; if (sp > XB_SPIN_CAP) { atomicAdd(&bar[XB_TMO], 1u); break; } }
    }
    nloc = mine > 0u ? mine : 1u; nx = cnt > 0u ? cnt : 1u;
}

__device__ __forceinline__ void xcd_barrier(const XcdBarrier& b) {
    asm volatile("s_waitcnt vmcnt(0)" ::: "memory");
    __syncthreads();
    if (threadIdx.x == 0) {
        unsigned* bar = b.bar;
        __builtin_amdgcn_s_waitcnt(0);
        unsigned nloc = b.st[0], nx = b.st[1];
        if (nloc == 0u) { xcd_barrier_complete(bar, b.x, nloc, nx); b.st[0] = nloc; b.st[1] = nx; }
        const unsigned old = xb_add(&bar[XB_XSUB(b.x)], 1u);
        const unsigned gen = old / nloc;
        if (old + 1u == (gen + 1u) * nloc) {
            __builtin_amdgcn_fence(__ATOMIC_RELEASE, "agent");
            asm volatile("s_waitcnt vmcnt(0)" ::: "memory");
            const unsigned og = xb_add(&bar[XB_TOP], 1u);
            const unsigned tg = og / nx;
            if (og + 1u == (tg + 1u) * nx) xb_add(&bar[XB_TOPGEN], 1u);
            else XB_SPIN(xb_ld(&bar[XB_TOPGEN]) == tg, bar);
            __builtin_amdgcn_fence(__ATOMIC_ACQUIRE, "agent");
            xb_add(&bar[XB_XGEN(b.x)], 1u);
            asm volatile("s_waitcnt vmcnt(0)" ::: "memory");
        } else {
            XB_SPIN(xb_ld(&bar[XB_XGEN(b.x)]) == gen, bar);
            __builtin_amdgcn_fence(__ATOMIC_ACQUIRE, "agent");
            asm volatile("s_waitcnt vmcnt(0)" ::: "memory");
        }
    }
    __syncthreads();
}

#ifndef MK_PHASES
#define MK_PHASES 0xffff
#endif
#define PH(k) (((MK_PHASES) >> (k)) & 1)
#ifndef MK_SKELETON
#define MK_SKELETON 0
#endif
__global__ void __launch_bounds__(NTHREADS, 2) fwd_megakernel(Params P) {
    extern __shared__ __attribute__((aligned(16))) unsigned char lds_raw[];
    cg::grid_group grid = cg::this_grid();
    LAS unsigned char* lds = (LAS unsigned char*)lds_raw;
    const int wave = __builtin_amdgcn_readfirstlane((int)threadIdx.x >> 6);
#define tid ((int)threadIdx.x)
#define lane ((int)threadIdx.x & 63)
    const int G = gridDim.x, bid = blockIdx.x;
    const int vcu = (G % 8 == 0) ? (bid % 8) * (G / 8) + bid / 8 : bid;
    const int gw = vcu * 8 + wave, ngw = G * 8;
    unsigned char* ws = P.ws;
    if (tid < 16) ((LAS unsigned*)(lds + LDS_BYTES - 64))[tid] = 0u;
    __syncthreads();
    unsigned* BARW = (unsigned*)(ws + 512 * 1024);
    if (bid == 0) for (int i = tid; i < XCD_BAR_WORDS; i += NTHREADS) __hip_atomic_store(BARW + i, 0u, __ATOMIC_RELAXED, __HIP_MEMORY_SCOPE_AGENT);
    float* TAB = (float*)(ws + WS_TAB);
    bf16_t* WIN = (bf16_t*)(ws + WS_WIN); bf16_t* WNA = (bf16_t*)(ws + WS_WNA); bf16_t* WGQA = (bf16_t*)(ws + WS_WGQA); bf16_t* WMIX = (bf16_t*)(ws + WS_WMIX);
    bf16_t* WFF1 = (bf16_t*)(ws + WS_WFF1); bf16_t* WFF2 = (bf16_t*)(ws + WS_WFF2); bf16_t* WPG = (bf16_t*)(ws + WS_WPG); bf16_t* WPPJ = (bf16_t*)(ws + WS_WPP);
    bf16_t* PB = (bf16_t*)(ws + WS_PB); bf16_t* VT = (bf16_t*)(ws + WS_VT); bf16_t* PROJ = (bf16_t*)(ws + WS_PROJ);
    bf16_t* YB = (bf16_t*)(ws + WS_Y); bf16_t* HB = (bf16_t*)(ws + WS_H); bf16_t* HID = (bf16_t*)(ws + WS_HID); bf16_t* EP = (bf16_t*)(ws + WS_EP);
    bf16_t* XN = (bf16_t*)P.out;
    bf16_t* MG = (bf16_t*)P.out;
    bf16_t* AB = (bf16_t*)((unsigned char*)P.out + 192 * MiB);
    bf16_t* X1B = (bf16_t*)P.out;
    float* RS2 = (float*)(ws + 64 * 1024); float* RS3 = (float*)(ws + 256 * 1024);
    bf16_t* KC = (bf16_t*)(ws + 964 * MiB); bf16_t* VC = (bf16_t*)(ws + 988 * MiB); bf16_t* QC = nullptr;

    if (PH(0)) {
        for (int idx = bid * NTHREADS + tid; idx < 64 * 32; idx += G * NTHREADS) {
            const int pos = idx >> 5, i = idx & 31;
            const float freq = __builtin_amdgcn_exp2f(-(float)i * (13.287712379549449f / 32.f));
            const float rev = (float)pos * freq * 0.15915494309189535f; const float fr = rev - floorf(rev);
            TAB[idx * 2] = __builtin_amdgcn_cosf(fr); TAB[idx * 2 + 1] = __builtin_amdgcn_sinf(fr);
        }
        LAS float* scr = (LAS float*)(lds + wave * 16384);
        constexpr int NITEMS = (2048 / 64) * (8704 / 32) + 2 * (1024 / 64) * (2048 / 32) + 2 * (2048 / 64) * (2048 / 32) + (2048 / 64) * (8192 / 32) + (8192 / 64) * (2048 / 32) + (256 / 64) * (2048 / 32);
        for (int it = gw; it < NITEMS; it += ngw) {
            int r = it;
            if (transpose_mat(r, P.w_in, 2048, 8704, WIN, scr, lane, true)) continue;
            if (transpose_mat(r, P.w_na, 1024, 2048, WNA, scr, lane, false)) continue;
            if (transpose_mat(r, P.w_gqa, 1024, 2048, WGQA, scr, lane, false)) continue;
            if (transpose_mat(r, P.w_mix, 2048, 2048, WMIX, scr, lane, false)) continue;
            if (transpose_mat(r, P.w_ple_gate, 2048, 2048, WPG, scr, lane, false, P.ln_ple_pre)) continue;
            if (transpose_mat(r, P.w_ff1, 2048, 8192, WFF1, scr, lane, false, P.ln_mlp_pre)) continue;
            if (transpose_mat(r, P.w_ff2, 8192, 2048, WFF2, scr, lane, false)) continue;
            transpose_mat(r, P.w_ple_proj, 256, 2048, WPPJ, scr, lane, false);
        }
        for (size_t i = (size_t)bid * NTHREADS + tid; i < (size_t)T * PLE / 8; i += (size_t)G * NTHREADS) {
            const size_t e = i * 8; const float* src = e < (size_t)TP * PLE ? P.p_p + e : P.p_s + (e - (size_t)TP * PLE);
            const f32x4 a = *(const f32x4*)src, b = *(const f32x4*)(src + 4);
            u32x4 w; w.x = pk_bf16(a[0], a[1]); w.y = pk_bf16(a[2], a[3]); w.z = pk_bf16(b[0], b[1]); w.w = pk_bf16(b[2], b[3]);
            *(u32x4*)(PB + e) = w;
        }
        row_pass<0>(P, nullptr, nullptr, XN, nullptr, P.ln_mix_pre, gw, ngw);
    }
    grid.sync();
    XcdBarrier xbar = xcd_barrier_post(BARW, (volatile LAS unsigned*)(lds + LDS_BYTES - 64));
#if !MK_SKELETON
    if (PH(1)) {
        pg8::Gemm g{XN, WIN, T, 7680, 2048, 2048, 2048}; pg8::StaticOrder S; S.init(T, 7680, G, bid);
        pg8::EpiX<0> E{PROJ, PP, nullptr, 0};
        pg8::gemm_phase<pg8::EpiX<0>, pg8::StaticOrder, true, true>(lds, g, S, E);
        pg8::Gemm g2{WIN + (size_t)7680 * 2048, XN, 1024, T, 2048, 2048, 2048}; pg8::StaticOrder S2; S2.init(1024, T, G, bid);
        pg8::EpiX<5> E2{VT, T, nullptr, 0};
        pg8::gemm_phase<pg8::EpiX<5>, pg8::StaticOrder, true, true>(lds, g2, S2, E2);
    }
    xcd_barrier(xbar);
    if (PH(2)) {
        LAS float* tabl = (LAS float*)(lds + 98304);
        for (int i = tid; i < 64 * 32 * 2; i += NTHREADS) tabl[i] = TAB[i];
        __syncthreads();
        qk_norm_rope(P, PROJ, QC, KC, VC, tabl, gw, ngw, lane);
        na::na_phase(PROJ, VT, P.na_rpb, AB, 1024, vcu, G, lds);
        __syncthreads();
    }
    xcd_barrier(xbar);
    if (PH(3)) {
        const int NU = NBATCH * 2 * 64;
        for (int i = 0;; ++i) {
            int u;
            if (G == 256) { if (i >= 6) break; const int x = vcu >> 5, c = vcu & 31; u = (x * 3 + (i >> 1)) * 64 + (i & 1) * 32 + c; }
            else { u = bid + i * G; if (u >= NU) break; }
            const int pair = u >> 6, uu = u & 63, b = pair >> 1, kvh = pair & 1, h = kvh * 4 + (uu >> 4), qb = uu & 15;
            const gqa::bf16* Q = (const gqa::bf16*)(PROJ + ((size_t)b * SEQ + qb * 256) * PP + C_GQ + h * 128);
            const gqa::bf16* Kp = (const gqa::bf16*)(KC + (size_t)b * SEQ * 256 + kvh * 128);
            const gqa::bf16* Vp = (const gqa::bf16*)(VC + (size_t)b * SEQ * 256 + kvh * 128);
            gqa::attn_dense_body<gqa::bf16>(Q, Kp, Vp, (gqa::bf16*)(AB + (size_t)T * 1024 + ((size_t)b * SEQ + qb * 256) * 1024 + h * 128), SEQ, (char*)lds_raw, P.q_norm, TAB, qb * 256);
            __syncthreads();
        }
    }
    xcd_barrier(xbar);
    if (PH(4)) {
        pg8::SegOrder S; S.base.init(T, DM, G, bid);
        pg8::Gemm g{AB, WNA, T, DM, 1024, 1024, 1024, (size_t)T * 1024 * 2, (size_t)DM * 1024 * 2};
        pg8::EpiGate E{MG, DM, PROJ + C_GA, PROJ + C_GB, PP};
        pg8::gemm_phase<pg8::EpiGate, pg8::SegOrder, true, true>(lds, g, S, E);
    }
    xcd_barrier(xbar);
    if (PH(5)) {
        pg8::StaticOrder S; S.init(T, DM, G, bid);
        pg8::Gemm g{MG, WMIX, T, DM, DM, DM, DM}; pg8::EpiX<0> E{YB, DM, nullptr, 0};
        pg8::gemm_phase<pg8::EpiX<0>, pg8::StaticOrder, true, true>(lds, g, S, E);
    }
    xcd_barrier(xbar);
    if (PH(6)) row_pass<1>(P, YB, nullptr, X1B, RS2, P.ln_mix_post, gw, ngw);
    xcd_barrier(xbar);
    if (PH(7))
#pragma unroll
    for (int half = 0; half < 2; ++half) {
        const size_t r0 = (size_t)half * (T / 2);
        {
            pg8::StaticOrder S; S.init(T / 2, DFF, G, bid);
            pg8::Gemm g{X1B + r0 * DM, WFF1, T / 2, DFF, DM, DM, DM}; pg8::EpiX<1> E{HID, DFF, nullptr, 0, RS2 + r0};
            pg8::gemm_phase<pg8::EpiX<1>, pg8::StaticOrder, true, true>(lds, g, S, E);
        }
        xcd_barrier(xbar);
        {
            pg8::StaticOrder S; S.init(T / 2, DM, G, bid);
            pg8::Gemm g{HID, WFF2, T / 2, DM, DFF, DFF, DFF}; pg8::EpiX<0> E{YB + r0 * DM, DM, nullptr, 0};
            pg8::gemm_phase<pg8::EpiX<0>, pg8::StaticOrder, true, true>(lds, g, S, E);
        }
        xcd_barrier(xbar);
    }
    if (PH(8)) row_pass<3>(P, YB, X1B, YB, RS3, P.ln_mlp_post, gw, ngw);
    xcd_barrier(xbar);
    if (PH(9)) {
        pg8::StaticOrder S; S.init(T, DM, G, bid);
        pg8::Gemm g1{PB, WPPJ, T, DM, PLE, PLE, PLE}; pg8::EpiX<0> E1{EP, DM, nullptr, 0};
        pg8::gemm_phase<pg8::EpiX<0>, pg8::StaticOrder, true, true>(lds, g1, S, E1);
        pg8::Gemm g2{YB, WPG, T, DM, DM, DM, DM}; pg8::EpiX<4> E2{EP, DM, nullptr, 0, RS3};
        pg8::gemm_phase<pg8::EpiX<4>, pg8::StaticOrder, true, true>(lds, g2, S, E2);
    }
    xcd_barrier(xbar);
    if (PH(10)) row_pass<2>(P, EP, YB, nullptr, nullptr, P.ln_ple_post, gw, ngw);
#else
    for (int k = 0; k < 12; ++k) {
        for (size_t i = (size_t)bid * NTHREADS + tid; i < (size_t)T * DM / 64; i += (size_t)G * NTHREADS) P.out[i * 64 + k] = (float)k;
        xcd_barrier(xbar);
    }
#endif
}

#undef tid
#undef lane
extern "C" void kernel_launch(void* const* d_in, const int* in_sizes, int n_in, void* d_out, int out_size, void* d_ws, size_t ws_size, hipStream_t stream) {
    static int grid = 0;
    if (grid == 0) {
        if (n_in != 21 || out_size != T * DM || ws_size < WS_END) { fprintf(stderr, "kernel_launch: unexpected shapes: n_in %d out %d ws %zu (need >= %zu)\n", n_in, out_size, ws_size, (size_t)WS_END); grid = -1; return; }
        int dev = 0, cus = 0, per_cu = 0;
        if (hipGetDevice(&dev) != hipSuccess || hipDeviceGetAttribute(&cus, hipDeviceAttributeMultiprocessorCount, dev) != hipSuccess) { fprintf(stderr, "kernel_launch: device query failed\n"); grid = -1; return; }
        if (hipFuncSetAttribute((const void*)fwd_megakernel, hipFuncAttributeMaxDynamicSharedMemorySize, LDS_BYTES) != hipSuccess) { fprintf(stderr, "kernel_launch: hipFuncSetAttribute failed\n"); grid = -1; return; }
        if (hipOccupancyMaxActiveBlocksPerMultiprocessor(&per_cu, (const void*)fwd_megakernel, NTHREADS, LDS_BYTES) != hipSuccess || per_cu < 1) { fprintf(stderr, "kernel_launch: occupancy query says %d\n", per_cu); per_cu = 1; }
        (void)hipGetLastError();
        grid = cus * per_cu;
    }
    if (grid < 0) return;
    Params p{};
    p.x_p = (const float*)d_in[0]; p.x_s = (const float*)d_in[1]; p.p_p = (const float*)d_in[2]; p.p_s = (const float*)d_in[3];
    p.ln_mix_pre = (const float*)d_in[4]; p.w_in = (const float*)d_in[5]; p.q_norm = (const float*)d_in[6]; p.k_norm = (const float*)d_in[7]; p.na_rpb = (const float*)d_in[8];
    p.w_na = (const float*)d_in[9]; p.w_gqa = (const float*)d_in[10]; p.w_mix = (const float*)d_in[11]; p.ln_mix_post = (const float*)d_in[12]; p.ln_mlp_pre = (const float*)d_in[13];
    p.w_ff1 = (const float*)d_in[14]; p.w_ff2 = (const float*)d_in[15]; p.ln_mlp_post = (const float*)d_in[16]; p.ln_ple_pre = (const float*)d_in[17];
    p.w_ple_gate = (const float*)d_in[18]; p.w_ple_proj = (const float*)d_in[19]; p.ln_ple_post = (const float*)d_in[20];
    p.out = (float*)d_out; p.ws = (unsigned char*)d_ws;
    void* args[] = {&p};
    const hipError_t e = hipLaunchCooperativeKernel((const void*)fwd_megakernel, dim3(grid), dim3(NTHREADS), args, LDS_BYTES, stream);
    if (e != hipSuccess) fprintf(stderr, "kernel_launch: cooperative launch failed: %s (grid %d)\n", hipGetErrorString(e), grid);
}
```

```cpp
#include <hip/hip_runtime.h>
#include <hip/hip_cooperative_groups.h>
#include <hip/hip_bf16.h>
#include <cstdio>
#include <cstdint>
namespace cg = cooperative_groups;
namespace pg8 {
#define PG8_LAS __attribute__((address_space(3)))
typedef unsigned short bf16_t;
typedef short bf16x8 __attribute__((ext_vector_type(8)));
typedef float f32x4 __attribute__((ext_vector_type(4)));
typedef unsigned u32x4 __attribute__((ext_vector_type(4)));
constexpr int BM = 256, BK = 64, HALF = 128, HTB = HALF * BK * 2  , STAGE_BYTES = 8 * HTB, NXCD = 8, WGM = 8;

__host__ __device__ __forceinline__ int lds_byte(int r, int c) { const int st = (r >> 4) * 2 + (c >> 5), rr = r & 15, cc = c & 31, ob = rr * 64 + cc * 2; return st * 1024 + (ob ^ (((ob >> 9) & 1) << 5)); }
__host__ __device__ __forceinline__ void stage_rc(int b, int& R, int& C) { const int st = b / 1024, sb = b % 1024, swz = sb ^ (((sb >> 9) & 1) << 5); R = (st >> 1) * 16 + swz / 64; C = (st & 1) * 32 + (swz % 64) / 2; }
__host__ __device__ __forceinline__ int perm32(int rho) { const int n = rho >> 4, i = rho & 15; return 8 * (i >> 2) + 4 * n + (i & 3); }

struct Unit { int pm, pn, seg; };
struct Gemm { const bf16_t* A; const bf16_t* Bt; int M, N, K, lda, ldb; size_t segA = 0, segB = 0; };

struct StaticOrder {
    int nM, nN, nwg, G, c;
    __host__ __device__ void init(int M, int N, int G_, int c_) { nM = M / BM; nN = N / BM; nwg = nM * nN; G = G_; c = c_; }
    __host__ __device__ bool next(int i, Unit& u) const {
        const long L = (long)i * G + c; if (L >= nwg) return false;
        int wgid = (int)L; { const int q = nwg / NXCD, r = nwg % NXCD, xcd = wgid % NXCD, off = wgid / NXCD; wgid = (xcd < r ? xcd * (q + 1) : r * (q + 1) + (xcd - r) * q) + off; }
        const int nig = WGM * nN, gid = wgid / nig, fm = gid * WGM, gsz = (nM - fm) < WGM ? (nM - fm) : WGM;
        u.pm = fm + ((wgid % nig) % gsz); u.pn = (wgid % nig) / gsz; u.seg = 0; return true;
    }
    __device__ __forceinline__ void a_ready(const Unit&) const {}
    __device__ __forceinline__ void done(const Unit&) const {}
};

__device__ __forceinline__ unsigned cvt_pk_bf16(float lo, float hi) { unsigned r; asm volatile("v_cvt_pk_bf16_f32 %0, %1, %2" : "=v"(r) : "v"(lo), "v"(hi)); return r; }
typedef float f32x2 __attribute__((ext_vector_type(2)));
__device__ __forceinline__ f32x2 gelu_pk(f32x2 v) {
    const f32x2 av = __builtin_elementwise_abs(v), d = av * 0.2316418882f + 1.0f;
    f32x2 t; t.x = __builtin_amdgcn_rcpf(d.x); t.y = __builtin_amdgcn_rcpf(d.y);
    f32x2 q = t * 0.5307027145f + (-0.7265760135f); q = q * t + 0.7107068705f; q = q * t + (-0.142248368f); q = q * t + 0.127414796f; q = q * t;
    const f32x2 s = (v * v) * (-0.72134752044f);
    f32x2 e; e.x = __builtin_amdgcn_exp2f(s.x); e.y = __builtin_amdgcn_exp2f(s.y);
    const f32x2 m = v * (q * e), r = v - m;
    f32x2 o; o.x = v.x < 0.f ? m.x : r.x; o.y = v.y < 0.f ? m.y : r.y; return o;
}

template <int ACT  > struct EpiBf16 {
    static constexpr bool PERM = true, AFTER_DRAIN = false; static_assert(ACT == 0 || ACT == 1, "EpiBf16: ACT is 0 (none) or 1 (gelu_pk)");
    bf16_t* O; int ldc; const float* bias; int split_cols; size_t split_stride; float scale0;
    __device__ __forceinline__ void operator()(const f32x4 (&acc)[2][2][4][2], const Unit& u, int wr, int wc, int fr, int fq) const {
        const int row0 = u.pm * BM + wr * 64 + fr; int colt = u.pn * BM; bf16_t* base = O;
        float sc = 1.f; if (split_cols) { const int t = colt / split_cols; base += (size_t)t * split_stride; colt -= t * split_cols; if (t == 0) sc = scale0; }
        const int col0 = colt + wc * 32 + 8 * fq, bcol0 = u.pn * BM + wc * 32 + 8 * fq;
        f32x4 bv[2][2];
#pragma unroll
        for (int bj = 0; bj < 2; ++bj)
#pragma unroll
            for (int n = 0; n < 2; ++n) bv[bj][n] = bias ? *(const f32x4*)(bias + bcol0 + bj * HALF + 4 * n) : (f32x4){0.f, 0.f, 0.f, 0.f};
#pragma unroll
        for (int ai = 0; ai < 2; ++ai)
#pragma unroll
            for (int m = 0; m < 4; ++m) { bf16_t* rowp = base + (size_t)(row0 + ai * HALF + m * 16) * ldc + col0;
#pragma unroll
                for (int bj = 0; bj < 2; ++bj) { f32x4 v0 = acc[ai][bj][m][0] + bv[bj][0], v1 = acc[ai][bj][m][1] + bv[bj][1];
                    if (ACT == 1) { f32x2 a = gelu_pk((f32x2){v0[0], v0[1]}), b = gelu_pk((f32x2){v0[2], v0[3]}), c = gelu_pk((f32x2){v1[0], v1[1]}), d = gelu_pk((f32x2){v1[2], v1[3]});
                        v0 = (f32x4){a.x, a.y, b.x, b.y}; v1 = (f32x4){c.x, c.y, d.x, d.y}; }
                    v0 = v0 * sc; v1 = v1 * sc; u32x4 w; w.x = cvt_pk_bf16(v0[0], v0[1]); w.y = cvt_pk_bf16(v0[2], v0[3]); w.z = cvt_pk_bf16(v1[0], v1[1]); w.w = cvt_pk_bf16(v1[2], v1[3]);
                    *(u32x4*)(rowp + bj * HALF) = w; } }
    }
};
template <class Epi, class Sched, bool ALIGN_EPI = false, bool SP2 = false>
__device__ __forceinline__ void gemm_phase(PG8_LAS unsigned char* lds, const Gemm g, const Sched& S, const Epi& E) {
    int tid_l = threadIdx.x; asm volatile("" : "+v"(tid_l));
    const int tid = tid_l, wid = __builtin_amdgcn_readfirstlane(tid >> 6), lane = tid & 63, wr = wid >> 2, wc = wid & 3, fr = lane & 15, fq = lane >> 4;
    const int K = g.K, nt = K / BK;
    unsigned voffA[2], voffB[2];
#pragma unroll
    for (int i = 0; i < 2; ++i) { int R, C; stage_rc(tid * 16 + i * 8192, R, C); const int Rb = Epi::PERM ? ((R & ~31) + perm32(R & 31)) : R;
        voffA[i] = (unsigned)(R * g.lda + C) * 2u; voffB[i] = (unsigned)(Rb * g.ldb + C) * 2u; }
    const size_t kstep = (size_t)(BK * 2);
    const size_t hstepA = (size_t)HALF * g.lda * 2, hstepB = (size_t)HALF * g.ldb * 2;
    const size_t tstepA = 2 * hstepA, tstepB = 2 * hstepB;
    const unsigned ldsw = (unsigned)wid * 1024u;
    const int aoff = lds_byte(wr * 64 + fr, fq * 8), boff = lds_byte(wc * 32 + fr, fq * 8);
#define PG8_SA(b, h) (((b) * 2 + (h)) * HTB)
#define PG8_SB(b, h) ((4 + (b) * 2 + (h)) * HTB)
#define PG8_STAGE(bufoff, gbase, voff) do { _Pragma("unroll") for (int _i = 0; _i < 2; ++_i) \
        __builtin_amdgcn_global_load_lds((const unsigned*)((const char*)(gbase) + (voff)[_i]), (PG8_LAS unsigned*)(lds + (bufoff) + ldsw + _i * 8192), 16, 0, 0); } while (0)
#define PG8_LDA(dst, b, h) do { _Pragma("unroll") for (int m = 0; m < 4; ++m) _Pragma("unroll") for (int k = 0; k < 2; ++k) dst[m][k] = *(const PG8_LAS bf16x8*)(lds + PG8_SA(b, h) + aoff + m * 2048 + k * 1024); } while (0)
#define PG8_LDB(dst, b, h) do { _Pragma("unroll") for (int n = 0; n < 2; ++n) _Pragma("unroll") for (int k = 0; k < 2; ++k) dst[n][k] = *(const PG8_LAS bf16x8*)(lds + PG8_SB(b, h) + boff + n * 2048 + k * 1024); } while (0)
#define PG8_MMA(ai, bj, At, Bt) do { __builtin_amdgcn_s_setprio(1); _Pragma("unroll") for (int m = 0; m < 4; ++m) _Pragma("unroll") for (int n = 0; n < 2; ++n) _Pragma("unroll") for (int k = 0; k < 2; ++k) \
        acc[ai][bj][m][n] = __builtin_amdgcn_mfma_f32_16x16x32_bf16(Bt[n][k], At[m][k], acc[ai][bj][m][n], 0, 0, 0); __builtin_amdgcn_s_setprio(0); } while (0)
#define PG8_WAIT_V(n) asm volatile("s_waitcnt vmcnt(" #n ")" ::: "memory")
#define PG8_WAIT_L(n) asm volatile("s_waitcnt lgkmcnt(" #n ")" ::: "memory")
#define PG8_BAR __builtin_amdgcn_s_barrier()
#define PG8_SCHED __builtin_amdgcn_sched_barrier(0)
    Unit cur, nxt; int ui = 0;
    if (!S.next(0, cur)) return;
    f32x4 acc[2][2][4][2];
#pragma unroll
    for (int a = 0; a < 2; ++a)
#pragma unroll
        for (int b = 0; b < 2; ++b)
#pragma unroll
            for (int m = 0; m < 4; ++m)
#pragma unroll
                for (int n = 0; n < 2; ++n) acc[a][b][m][n] = (f32x4){0.f, 0.f, 0.f, 0.f};
    bf16x8 At[4][2], B0[2][2], B1[2][2];
    const char* cA = (const char*)g.A + (size_t)cur.seg * g.segA + (size_t)cur.pm * tstepA; const char* cB = (const char*)g.Bt + (size_t)cur.seg * g.segB + (size_t)cur.pn * tstepB;
    S.a_ready(cur);
    if constexpr (SP2) {
        PG8_STAGE(PG8_SB(0, 0), cB, voffB); PG8_STAGE(PG8_SB(0, 1), cB + hstepB, voffB); PG8_STAGE(PG8_SA(0, 0), cA, voffA); PG8_STAGE(PG8_SA(0, 1), cA + hstepA, voffA);
        if (wr == 1) PG8_BAR;
        PG8_WAIT_V(2); PG8_BAR;
        PG8_STAGE(PG8_SB(1, 0), cB + kstep, voffB); PG8_STAGE(PG8_SA(1, 0), cA + kstep, voffA); PG8_STAGE(PG8_SB(1, 1), cB + hstepB + kstep, voffB);
        PG8_WAIT_V(6); PG8_BAR;
    } else {
        PG8_STAGE(PG8_SB(0, 0), cB, voffB); PG8_STAGE(PG8_SA(0, 0), cA, voffA); PG8_STAGE(PG8_SB(0, 1), cB + hstepB, voffB); PG8_STAGE(PG8_SA(0, 1), cA + hstepA, voffA);
        if (wr == 1) PG8_BAR;
        PG8_WAIT_V(4); PG8_BAR;
        PG8_STAGE(PG8_SB(1, 0), cB + kstep, voffB); PG8_STAGE(PG8_SA(1, 0), cA + kstep, voffA); PG8_STAGE(PG8_SB(1, 1), cB + hstepB + kstep, voffB);
        PG8_WAIT_V(6); PG8_BAR;
    }
    for (;;) {
        const bool has_next = S.next(ui + 1, nxt);
        const char* nA = has_next ? (const char*)g.A + (size_t)nxt.seg * g.segA + (size_t)nxt.pm * tstepA : cA; const char* nB = has_next ? (const char*)g.Bt + (size_t)nxt.seg * g.segB + (size_t)nxt.pn * tstepB : cB;
        for (int t = 0; t < nt; t += 2) {
            const bool last = (t == nt - 2);
            const char* a1 = cA + (size_t)(t + 1) * kstep;
            const char* a2 = last ? nA : cA + (size_t)(t + 2) * kstep; const char* b2 = last ? nB : cB + (size_t)(t + 2) * kstep;
            const char* a3 = a2 + kstep; const char* b3 = b2 + kstep;
            if (last && has_next) S.a_ready(nxt);
            if constexpr (SP2) {
            PG8_LDB(B0, 0, 0); PG8_LDB(B1, 0, 1); PG8_SCHED; PG8_LDA(At, 0, 0); PG8_STAGE(PG8_SA(1, 1), a1 + hstepA, voffA);
            PG8_WAIT_V(8); PG8_WAIT_L(0); PG8_BAR; PG8_MMA(0, 0, At, B0); PG8_MMA(0, 1, At, B1); PG8_BAR; PG8_SCHED;
            PG8_LDA(At, 0, 1); PG8_STAGE(PG8_SB(0, 0), b2, voffB); PG8_STAGE(PG8_SB(0, 1), b2 + hstepB, voffB); PG8_STAGE(PG8_SA(0, 0), a2, voffA);
            PG8_WAIT_V(8); PG8_WAIT_L(0); PG8_BAR; PG8_MMA(1, 0, At, B0); PG8_MMA(1, 1, At, B1); PG8_BAR; PG8_SCHED;
            PG8_LDB(B0, 1, 0); PG8_LDB(B1, 1, 1); PG8_SCHED; PG8_LDA(At, 1, 0); PG8_STAGE(PG8_SA(0, 1), a2 + hstepA, voffA);
            PG8_WAIT_V(8); PG8_WAIT_L(0); PG8_BAR; PG8_MMA(0, 0, At, B0); PG8_MMA(0, 1, At, B1); PG8_BAR; PG8_SCHED;
            PG8_LDA(At, 1, 1); PG8_STAGE(PG8_SB(1, 0), b3, voffB); PG8_STAGE(PG8_SB(1, 1), b3 + hstepB, voffB); PG8_STAGE(PG8_SA(1, 0), a3, voffA);
            PG8_WAIT_V(8); PG8_WAIT_L(0); PG8_BAR; PG8_MMA(1, 0, At, B0); PG8_MMA(1, 1, At, B1); PG8_BAR; PG8_SCHED;
            } else {
            PG8_LDB(B0, 0, 0); PG8_SCHED; PG8_LDA(At, 0, 0); PG8_STAGE(PG8_SA(1, 1), a1 + hstepA, voffA);
            PG8_WAIT_L(8); PG8_BAR; PG8_WAIT_L(0); PG8_MMA(0, 0, At, B0); PG8_BAR; PG8_SCHED;
            PG8_LDB(B1, 0, 1); PG8_STAGE(PG8_SB(0, 0), b2, voffB);
            PG8_BAR; PG8_WAIT_L(0); PG8_MMA(0, 1, At, B1); PG8_BAR;
            PG8_LDA(At, 0, 1); PG8_STAGE(PG8_SA(0, 0), a2, voffA);
            PG8_BAR; PG8_WAIT_L(0); PG8_MMA(1, 0, At, B0); PG8_BAR; PG8_SCHED;
            PG8_STAGE(PG8_SB(0, 1), b2 + hstepB, voffB);
            PG8_WAIT_V(6); PG8_BAR; PG8_MMA(1, 1, At, B1); PG8_BAR;
            PG8_LDB(B0, 1, 0); PG8_SCHED; PG8_LDA(At, 1, 0); PG8_STAGE(PG8_SA(0, 1), a2 + hstepA, voffA);
            PG8_WAIT_L(8); PG8_BAR; PG8_WAIT_L(0); PG8_MMA(0, 0, At, B0); PG8_BAR; PG8_SCHED;
            PG8_LDB(B1, 1, 1); PG8_STAGE(PG8_SB(1, 0), b3, voffB);
            PG8_BAR; PG8_WAIT_L(0); PG8_MMA(0, 1, At, B1); PG8_BAR;
            PG8_LDA(At, 1, 1); PG8_STAGE(PG8_SA(1, 0), a3, voffA);
            PG8_BAR; PG8_WAIT_L(0); PG8_MMA(1, 0, At, B0); PG8_BAR; PG8_SCHED;
            PG8_STAGE(PG8_SB(1, 1), b3 + hstepB, voffB);
            PG8_WAIT_V(6); PG8_BAR; PG8_MMA(1, 1, At, B1); PG8_BAR;
            }
        }
        if constexpr (ALIGN_EPI) { if (wr == 0) PG8_BAR; }
        bool keep_acc = false;
        if constexpr (!Epi::AFTER_DRAIN) { if constexpr (Epi::SEG) { if (cur.seg == 0) { E.mid(acc, cur, wr, wc, fr, fq); keep_acc = true; } else E(acc, cur, wr, wc, fr, fq); } else E(acc, cur, wr, wc, fr, fq); S.done(cur); }
        if (!has_next) break;
        if (!keep_acc)
#pragma unroll
        for (int a = 0; a < 2; ++a)
#pragma unroll
            for (int b = 0; b < 2; ++b)
#pragma unroll
                for (int m = 0; m < 4; ++m)
#pragma unroll
                    for (int n = 0; n < 2; ++n) acc[a][b][m][n] = (f32x4){0.f, 0.f, 0.f, 0.f};
        cur = nxt; cA = nA; cB = nB; ++ui;
        if constexpr (ALIGN_EPI) { if (wr == 1) PG8_BAR; }
    }
    PG8_WAIT_V(0);
    if constexpr (!ALIGN_EPI) { if (wr == 0) PG8_BAR; }
    PG8_BAR;
    if constexpr (Epi::AFTER_DRAIN) { E.fused(acc, cur, wr, wc, fr, fq, lds, wid, lane); S.done(cur); }
#undef PG8_SA
#undef PG8_SB
#undef PG8_STAGE
#undef PG8_LDA
#undef PG8_LDB
#undef PG8_MMA
#undef PG8_WAIT_V
#undef PG8_WAIT_L
#undef PG8_BAR
#undef PG8_SCHED
}
}
namespace pg8 {
__device__ __forceinline__ float bf_lo(unsigned u) { return __uint_as_float(u << 16); }
__device__ __forceinline__ float bf_hi(unsigned u) { return __uint_as_float(u & 0xffff0000u); }
__device__ __forceinline__ float sigm(float x) { return __builtin_amdgcn_rcpf(1.f + __builtin_amdgcn_exp2f(-1.4426950408889634f * x)); }
template <int MODE> struct EpiX {
    static constexpr bool PERM = true, AFTER_DRAIN = false, SEG = false;
    bf16_t* O; int ldc; const bf16_t* G; int ldg; const float* RS = nullptr;
    __device__ __forceinline__ void operator()(const f32x4 (&acc)[2][2][4][2], const Unit& u, int wr, int wc, int fr, int fq) const {
        const int row0 = u.pm * BM + wr * 64 + fr; const int col0 = u.pn * BM + wc * 32 + 8 * fq;
#pragma unroll
        for (int ai = 0; ai < 2; ++ai)
#pragma unroll
            for (int m = 0; m < 4; ++m) { const size_t row = (size_t)(row0 + ai * HALF + m * 16);
#pragma unroll
                for (int bj = 0; bj < 2; ++bj) { const int col = col0 + bj * HALF;
                    const f32x4 a0 = acc[ai][bj][m][0], a1 = acc[ai][bj][m][1];
                    float v[8] = {a0[0], a0[1], a0[2], a0[3], a1[0], a1[1], a1[2], a1[3]};
                    bf16_t* op = O + row * ldc + col;
                    if (MODE == 5) op = O + ((((size_t)(col >> 12) * 64 + ((col >> 6) & 63)) * 8 + (row >> 7)) * 128 + (row & 127)) * 64 + (col & 63);
                    if (MODE == 1) {
                        const float rs = RS[row], rs2 = rs * rs;
#pragma unroll
                        for (int i = 0; i < 8; ++i) { const float r = fmaxf(v[i], 0.f); v[i] = r * r * rs2; } }
                    if (MODE == 2 || MODE == 3) { const u32x4 gw = *(const u32x4*)(G + row * ldg + col);
                        const float gf[8] = {bf_lo(gw.x), bf_hi(gw.x), bf_lo(gw.y), bf_hi(gw.y), bf_lo(gw.z), bf_hi(gw.z), bf_lo(gw.w), bf_hi(gw.w)};
#pragma unroll
                        for (int i = 0; i < 8; ++i) v[i] = sigm(gf[i]) * v[i]; }
                    if (MODE == 3) { const u32x4 ow = *(const u32x4*)op;
                        const float of[8] = {bf_lo(ow.x), bf_hi(ow.x), bf_lo(ow.y), bf_hi(ow.y), bf_lo(ow.z), bf_hi(ow.z), bf_lo(ow.w), bf_hi(ow.w)};
#pragma unroll
                        for (int i = 0; i < 8; ++i) v[i] += of[i]; }
                    if (MODE == 4) { const u32x4 ow = *(const u32x4*)op;
                        const float of[8] = {bf_lo(ow.x), bf_hi(ow.x), bf_lo(ow.y), bf_hi(ow.y), bf_lo(ow.z), bf_hi(ow.z), bf_lo(ow.w), bf_hi(ow.w)};
                        const float rs = RS[row];
#pragma unroll
                        for (int i = 0; i < 8; ++i) v[i] = of[i] * sigm(v[i] * rs); }
                    u32x4 w; w.x = cvt_pk_bf16(v[0], v[1]); w.y = cvt_pk_bf16(v[2], v[3]); w.z = cvt_pk_bf16(v[4], v[5]); w.w = cvt_pk_bf16(v[6], v[7]);
                    *(u32x4*)op = w; }
                if (MODE >= 2) asm volatile("" ::: "memory"); }
    }
};

struct SegOrder { StaticOrder base;
    __device__ bool next(int i, Unit& u) const { if (!base.next(i >> 1, u)) return false; u.seg = i & 1; return true; }
    __device__ __forceinline__ void a_ready(const Unit&) const {}
    __device__ __forceinline__ void done(const Unit&) const {} };
struct EpiGate {
    static constexpr bool PERM = true, AFTER_DRAIN = false, SEG = true;
    bf16_t* O; int ldc; const bf16_t* GA; const bf16_t* GB; int ldg;
    static __device__ __forceinline__ float eneg(float x) { return __builtin_amdgcn_exp2f(-1.4426950408889634f * fminf(fmaxf(x, -30.f), 30.f)); }
    __device__ __forceinline__ void mid(f32x4 (&acc)[2][2][4][2], const Unit& u, int wr, int wc, int fr, int fq) const {
        const int row0 = u.pm * BM + wr * 64 + fr; const int col0 = u.pn * BM + wc * 32 + 8 * fq;
#pragma unroll
        for (int ai = 0; ai < 2; ++ai)
#pragma unroll
            for (int m = 0; m < 4; ++m) { const size_t row = (size_t)(row0 + ai * HALF + m * 16);
#pragma unroll
                for (int bj = 0; bj < 2; ++bj) { const int col = col0 + bj * HALF;
                    const u32x4 aw = *(const u32x4*)(GA + row * ldg + col), bw = *(const u32x4*)(GB + row * ldg + col);
                    const float ga[8] = {bf_lo(aw.x), bf_hi(aw.x), bf_lo(aw.y), bf_hi(aw.y), bf_lo(aw.z), bf_hi(aw.z), bf_lo(aw.w), bf_hi(aw.w)};
                    const float gb[8] = {bf_lo(bw.x), bf_hi(bw.x), bf_lo(bw.y), bf_hi(bw.y), bf_lo(bw.z), bf_hi(bw.z), bf_lo(bw.w), bf_hi(bw.w)};
                    float r[8];
#pragma unroll
                    for (int i = 0; i < 8; ++i) r[i] = (1.f + eneg(gb[i])) * __builtin_amdgcn_rcpf(1.f + eneg(ga[i]));
                    acc[ai][bj][m][0] = acc[ai][bj][m][0] * (f32x4){r[0], r[1], r[2], r[3]}; acc[ai][bj][m][1] = acc[ai][bj][m][1] * (f32x4){r[4], r[5], r[6], r[7]}; }
                asm volatile("" ::: "memory"); }
    }
    __device__ __forceinline__ void operator()(const f32x4 (&acc)[2][2][4][2], const Unit& u, int wr, int wc, int fr, int fq) const {
        const int row0 = u.pm * BM + wr * 64 + fr; const int col0 = u.pn * BM + wc * 32 + 8 * fq;
#pragma unroll
        for (int ai = 0; ai < 2; ++ai)
#pragma unroll
            for (int m = 0; m < 4; ++m) { const size_t row = (size_t)(row0 + ai * HALF + m * 16);
#pragma unroll
                for (int bj = 0; bj < 2; ++bj) { const int col = col0 + bj * HALF;
                    const u32x4 bw = *(const u32x4*)(GB + row * ldg + col);
                    const float gb[8] = {bf_lo(bw.x), bf_hi(bw.x), bf_lo(bw.y), bf_hi(bw.y), bf_lo(bw.z), bf_hi(bw.z), bf_lo(bw.w), bf_hi(bw.w)};
                    const f32x4 a0 = acc[ai][bj][m][0], a1 = acc[ai][bj][m][1];
                    float v[8] = {a0[0], a0[1], a0[2], a0[3], a1[0], a1[1], a1[2], a1[3]};
#pragma unroll
                    for (int i = 0; i < 8; ++i) v[i] *= __builtin_amdgcn_rcpf(1.f + eneg(gb[i]));
                    u32x4 w; w.x = cvt_pk_bf16(v[0], v[1]); w.y = cvt_pk_bf16(v[2], v[3]); w.z = cvt_pk_bf16(v[4], v[5]); w.w = cvt_pk_bf16(v[6], v[7]);
                    *(u32x4*)(O + row * ldc + col) = w; }
                asm volatile("" ::: "memory"); }
    }
};
}
namespace gqa {
using bf16 = __hip_bfloat16;
constexpr int   D = 128, NW = 8, QBLK = 32, KVBLK = 64;
constexpr float SCALE = 0.088388347648318440f;
constexpr float THR = 8.f;
using f32x4 = __attribute__((ext_vector_type(4))) float;
constexpr int SDEPTH = 1;
constexpr int LDQ = 7680, LDK = 256, LDO = 1024;
constexpr size_t SHM_V = KVBLK * D * 2, SHM_K = KVBLK * D * 2, SHM_ATTN = 2 * SHM_V + 2 * SHM_K + NW * 64 * 4;
using bf16x8 = __attribute__((ext_vector_type(8))) short;
using s16x4  = __attribute__((ext_vector_type(4))) short;
using f32x16 = __attribute__((ext_vector_type(16))) float;
using f32x8  = __attribute__((ext_vector_type(8))) float;
using u32x4  = __attribute__((ext_vector_type(4))) unsigned;
#define KSWZ(row, colB) ((row) * 256 + ((colB) ^ (((row) & 7) << 4)))
#define SBAR() __builtin_amdgcn_sched_barrier(0)
__device__ __forceinline__ int crow(int r, int hi) { return (r & 3) + 8 * (r >> 2) + 4 * hi; }
__device__ __forceinline__ unsigned cvtpk(float lo, float hi) {
  unsigned r; asm volatile("v_cvt_pk_bf16_f32 %0, %1, %2" : "=v"(r) : "v"(lo), "v"(hi)); return r;
}
template <typename TIn> struct Stage;
template <> struct Stage<bf16>  { using T = bf16x8;
  __device__ static __forceinline__ T ld8(const bf16* p) { return *reinterpret_cast<const bf16x8*>(p); }
  __device__ static __forceinline__ bf16x8 tobf(T x) { return x; } };
template <> struct Stage<float> { using T = f32x8;
  __device__ static __forceinline__ T ld8(const float* p) { return *reinterpret_cast<const f32x8*>(p); }
  __device__ static __forceinline__ bf16x8 tobf(T x) {
    u32x4 w = {cvtpk(x[0], x[1]), cvtpk(x[2], x[3]), cvtpk(x[4], x[5]), cvtpk(x[6], x[7])}; return *reinterpret_cast<bf16x8*>(&w); } };

__device__ __forceinline__ void partialSM(f32x16& p0, f32x16& p1, float& m_reg, float& mn, float& alpha) {
  constexpr float C = SCALE * 1.4426950408889634f;
  float pmax = p0[0]; for (int r = 1; r < 16; ++r) pmax = fmaxf(pmax, p0[r]); for (int r = 0; r < 16; ++r) pmax = fmaxf(pmax, p1[r]);
  { auto rr = __builtin_amdgcn_permlane32_swap(__float_as_uint(pmax), __float_as_uint(pmax), false, false);
    pmax = fmaxf(__uint_as_float(rr[0]), __uint_as_float(rr[1])); }
  if (__builtin_expect(__all(pmax - m_reg <= THR / SCALE), 1)) { mn = m_reg; alpha = 1.f; }
  else { mn = fmaxf(m_reg, pmax); alpha = __builtin_amdgcn_exp2f((m_reg - mn) * C); m_reg = mn; }
  float mnC = -mn * C;
  for (int r = 0; r < 16; ++r) p0[r] = fmaf(p0[r], C, mnC); for (int r = 0; r < 16; ++r) p1[r] = fmaf(p1[r], C, mnC);
  for (int r = 0; r < 16; ++r) p0[r] = __builtin_amdgcn_exp2f(p0[r]);
}
__device__ __forceinline__ void finishSM(f32x16& p0, f32x16& p1, float alpha, float& l_reg, bf16x8& pa0, bf16x8& pa1, bf16x8& pa2, bf16x8& pa3) {
  for (int r = 0; r < 16; ++r) p1[r] = __builtin_amdgcn_exp2f(p1[r]);
  float ps = 0; for (int r = 0; r < 16; ++r) ps += p0[r]; for (int r = 0; r < 16; ++r) ps += p1[r];
  { auto rr = __builtin_amdgcn_permlane32_swap(__float_as_uint(ps), __float_as_uint(ps), false, false);
    ps = __uint_as_float(rr[0]) + __uint_as_float(rr[1]); }
  l_reg = l_reg * alpha + ps;
#define PK4(P, BASE, OUT) do { unsigned a0 = cvtpk(P[BASE + 0], P[BASE + 1]), a1 = cvtpk(P[BASE + 2], P[BASE + 3]);   \
    unsigned b0 = cvtpk(P[BASE + 4], P[BASE + 5]), b1 = cvtpk(P[BASE + 6], P[BASE + 7]);                              \
    auto r0 = __builtin_amdgcn_permlane32_swap(a0, b0, false, false); auto r1 = __builtin_amdgcn_permlane32_swap(a1, b1, false, false); \
    u32x4 w = {r0[0], r1[0], r0[1], r1[1]}; OUT = *reinterpret_cast<bf16x8*>(&w); } while (0)
  PK4(p0, 0, pa0); PK4(p0, 8, pa1); PK4(p1, 0, pa2); PK4(p1, 8, pa3);
#undef PK4
}
__device__ __forceinline__ void qkt(f32x16& p0, f32x16& p1, const bf16* Ks, const bf16x8* qr, int r32, int hi) {
  p0 = f32x16{}; p1 = f32x16{};
  for (int d0 = 0; d0 < 8; ++d0) { int cb = (d0 * 16 + hi * 8) * 2;
    bf16x8 b0 = *reinterpret_cast<const bf16x8*>((const char*)Ks + KSWZ(r32, cb));
    bf16x8 b1 = *reinterpret_cast<const bf16x8*>((const char*)Ks + KSWZ(32 + r32, cb));
    p0 = __builtin_amdgcn_mfma_f32_32x32x16_bf16(b0, qr[d0], p0, 0, 0, 0);
    p1 = __builtin_amdgcn_mfma_f32_32x32x16_bf16(b1, qr[d0], p1, 0, 0, 0); }
}
__device__ __forceinline__ int v_st(int k, int c) { const int kk = (k & ~0xC) | ((k & 4) << 1) | ((k & 8) >> 1); return ((kk >> 3) * 4 + (c >> 5)) * 512 + ((kk & 7) * 32 + (c & 31)) * 2; }
__device__ __forceinline__ int v_rd_base(int lane) { return ((lane & 3) << 3) | (((lane >> 2) & 3) << 6) | (((lane >> 4) & 1) << 5) | (((lane >> 5) & 1) << 8); }
constexpr int v_rd_off(int d0, int ks, int half) { return d0 * 512 + ks * 4096 + half * 2048; }
template <int OFF> __device__ __forceinline__ s16x4 tr_read(int vb) {
  s16x4 r; asm volatile("ds_read_b64_tr_b16 %0, %1 offset:%2" : "=&v"(r) : "v"(vb), "i"(OFF) : "memory"); return r;
}
template <int D0> __device__ __forceinline__ void pv_one(f32x16& od, int vb, bf16x8 pa0, bf16x8 pa1, bf16x8 pa2, bf16x8 pa3) {
  const s16x4 l0 = tr_read<v_rd_off(D0, 0, 0)>(vb), h0 = tr_read<v_rd_off(D0, 0, 1)>(vb), l1 = tr_read<v_rd_off(D0, 1, 0)>(vb), h1 = tr_read<v_rd_off(D0, 1, 1)>(vb);
  const s16x4 l2 = tr_read<v_rd_off(D0, 2, 0)>(vb), h2 = tr_read<v_rd_off(D0, 2, 1)>(vb), l3 = tr_read<v_rd_off(D0, 3, 0)>(vb), h3 = tr_read<v_rd_off(D0, 3, 1)>(vb);
  asm volatile("s_waitcnt lgkmcnt(0)" ::: "memory"); SBAR();
#define PK(L, H) (bf16x8){L[0], L[1], L[2], L[3], H[0], H[1], H[2], H[3]}
  od = __builtin_amdgcn_mfma_f32_32x32x16_bf16(pa0, PK(l0, h0), od, 0, 0, 0);
  od = __builtin_amdgcn_mfma_f32_32x32x16_bf16(pa1, PK(l1, h1), od, 0, 0, 0);
  od = __builtin_amdgcn_mfma_f32_32x32x16_bf16(pa2, PK(l2, h2), od, 0, 0, 0);
  od = __builtin_amdgcn_mfma_f32_32x32x16_bf16(pa3, PK(l3, h3), od, 0, 0, 0);
#undef PK
}
__device__ __forceinline__ void pv_d0(f32x16* o, int vb, bf16x8 pa0, bf16x8 pa1, bf16x8 pa2, bf16x8 pa3) {
  pv_one<0>(o[0], vb, pa0, pa1, pa2, pa3); pv_one<1>(o[1], vb, pa0, pa1, pa2, pa3); pv_one<2>(o[2], vb, pa0, pa1, pa2, pa3); pv_one<3>(o[3], vb, pa0, pa1, pa2, pa3);
}

template <typename TQ>
__device__ __forceinline__ void attn_dense_body(const TQ* Qb, const bf16* __restrict__ Kh, const bf16* __restrict__ Vh,
                                                bf16* Ob, int seq, char* lds, const float* __restrict__ qgain, const float* __restrict__ tab, int tok0) {
  using St = Stage<bf16>; using SQ = Stage<TQ>;
  int tid_l = threadIdx.x; asm volatile("" : "+v"(tid_l));
  const int tid = tid_l, wid = tid >> 6, lane = tid & 63, r32 = lane & 31, hi = lane >> 5;
  bf16* V_lds = (bf16*)lds; bf16* K_lds = (bf16*)(lds + 2 * SHM_V);
  float* ws = (float*)(lds + 2 * SHM_V + 2 * SHM_K) + wid * 64; float* li_l = ws; float* al_l = ws + 32;
  float m_reg = -1e30f, l_reg = 0; f32x16 o[4] = {}; bf16x8 qr[8];
  const TQ* Qw = Qb + (long)(wid * QBLK + r32) * LDQ + hi * 8;
  {
    float y[8][8]; float ss = 0.f;
#pragma unroll
    for (int d0 = 0; d0 < 8; ++d0) { const u32x4 w = *reinterpret_cast<const u32x4*>(Qw + d0 * 16);
      y[d0][0] = __uint_as_float(w.x << 16); y[d0][1] = __uint_as_float(w.x & 0xffff0000u); y[d0][2] = __uint_as_float(w.y << 16); y[d0][3] = __uint_as_float(w.y & 0xffff0000u);
      y[d0][4] = __uint_as_float(w.z << 16); y[d0][5] = __uint_as_float(w.z & 0xffff0000u); y[d0][6] = __uint_as_float(w.w << 16); y[d0][7] = __uint_as_float(w.w & 0xffff0000u);
#pragma unroll
      for (int j = 0; j < 8; ++j) ss += y[d0][j] * y[d0][j]; }
    { auto rr = __builtin_amdgcn_permlane32_swap(__float_as_uint(ss), __float_as_uint(ss), false, false); ss = __uint_as_float(rr[0]) + __uint_as_float(rr[1]); }
    const float rstd = __builtin_amdgcn_rsqf(ss * (1.f / 128.f) + 1e-6f);
#pragma unroll
    for (int d0 = 0; d0 < 8; ++d0) { const f32x4 ga = *reinterpret_cast<const f32x4*>(qgain + d0 * 16 + hi * 8), gb = *reinterpret_cast<const f32x4*>(qgain + d0 * 16 + hi * 8 + 4);
      y[d0][0] *= rstd * ga[0]; y[d0][1] *= rstd * ga[1]; y[d0][2] *= rstd * ga[2]; y[d0][3] *= rstd * ga[3]; y[d0][4] *= rstd * gb[0]; y[d0][5] *= rstd * gb[1]; y[d0][6] *= rstd * gb[2]; y[d0][7] *= rstd * gb[3]; }
    const int tok = tok0 + wid * QBLK + r32, prow = (tok >> 6) & 63, pcol = tok & 63;
#pragma unroll
    for (int hf = 0; hf < 2; ++hf) { const int pos = hf ? pcol : prow;
#pragma unroll
      for (int db = 0; db < 2; ++db) { const float* tp = tab + (pos * 32 + db * 16 + hi * 8) * 2;
        const f32x4 t0 = *reinterpret_cast<const f32x4*>(tp), t1 = *reinterpret_cast<const f32x4*>(tp + 4), t2 = *reinterpret_cast<const f32x4*>(tp + 8), t3 = *reinterpret_cast<const f32x4*>(tp + 12);
        const float cs[8] = {t0[0], t0[2], t1[0], t1[2], t2[0], t2[2], t3[0], t3[2]}, sn[8] = {t0[1], t0[3], t1[1], t1[3], t2[1], t2[3], t3[1], t3[3]};
#pragma unroll
        for (int j = 0; j < 8; ++j) { const float x1 = y[hf * 4 + db][j], x2 = y[hf * 4 + db + 2][j]; y[hf * 4 + db][j] = x1 * cs[j] - x2 * sn[j]; y[hf * 4 + db + 2][j] = x2 * cs[j] + x1 * sn[j]; } } }
#pragma unroll
    for (int d0 = 0; d0 < 8; ++d0) { u32x4 w = {cvtpk(y[d0][0], y[d0][1]), cvtpk(y[d0][2], y[d0][3]), cvtpk(y[d0][4], y[d0][5]), cvtpk(y[d0][6], y[d0][7])}; qr[d0] = *reinterpret_cast<bf16x8*>(&w); }
  }
  const int sr = tid >> 4, sc = (tid & 15) * 8, vst0 = v_st(sr, sc), vst1 = v_st(32 + sr, sc);
  const int vb0 = (int)(uintptr_t)V_lds + v_rd_base(lane);
  struct { typename St::T vs0, vs1, ks0, ks1; } sr_[SDEPTH];
  const unsigned voff0 = (unsigned)(sr * LDK + sc) * 2u, voff1 = voff0 + 32u * LDK * 2u;
#define SLOAD(i, k0) do { const char* vb_ = (const char*)Vh + (size_t)(k0) * (LDK * 2); const char* kb_ = (const char*)Kh + (size_t)(k0) * (LDK * 2); \
    sr_[i].vs0 = *(const bf16x8*)(vb_ + voff0); sr_[i].vs1 = *(const bf16x8*)(vb_ + voff1); \
    sr_[i].ks0 = *(const bf16x8*)(kb_ + voff0); sr_[i].ks1 = *(const bf16x8*)(kb_ + voff1); } while (0)
#define SWRITE(b, i) do { *(bf16x8*)((char*)V_lds + (b) * SHM_V + vst0) = St::tobf(sr_[i].vs0);          \
    *(bf16x8*)((char*)V_lds + (b) * SHM_V + vst1) = St::tobf(sr_[i].vs1); int kc = sc * 2;               \
    *(bf16x8*)((char*)K_lds + (b) * SHM_K + KSWZ(sr, kc)) = St::tobf(sr_[i].ks0);                       \
    *(bf16x8*)((char*)K_lds + (b) * SHM_K + KSWZ(32 + sr, kc)) = St::tobf(sr_[i].ks1); } while (0)
#define SWAIT() do { if constexpr (SDEPTH == 2) asm volatile("s_waitcnt vmcnt(4)" ::: "memory"); else asm volatile("s_waitcnt vmcnt(0)" ::: "memory"); } while (0)
#define RESC(a) do { if (__any((a) < 1.f)) { if (hi == 0) al_l[r32] = (a); asm volatile("s_waitcnt lgkmcnt(0)" ::: "memory"); \
    for (int d = 0; d < 4; ++d) for (int r = 0; r < 16; ++r) o[d][r] *= al_l[crow(r, hi)]; } } while (0)
  f32x16 pA0, pA1, pB0, pB1; float mnA, mnB, alA, alB; bf16x8 pa0, pa1, pa2, pa3; const int NT = seq / KVBLK;
  constexpr int SE = 0, SO = SDEPTH - 1;
  SLOAD(SE, 0); asm volatile("s_waitcnt vmcnt(0)" ::: "memory"); SWRITE(0, SE); __syncthreads();
  qkt(pA0, pA1, K_lds, qr, r32, hi); partialSM(pA0, pA1, m_reg, mnA, alA);
  SLOAD(SO, KVBLK); if constexpr (SDEPTH == 2) { if (2 < NT) SLOAD(SE, 2 * KVBLK); }
  SWAIT(); SWRITE(1, SO); __syncthreads();
  for (int j = 1; j + 1 < NT; j += 2) {
    SBAR(); qkt(pB0, pB1, (bf16*)((char*)K_lds + SHM_K), qr, r32, hi);
    finishSM(pA0, pA1, alA, l_reg, pa0, pa1, pa2, pa3); SBAR();
    SLOAD(SO, (j + SDEPTH) * KVBLK); SBAR();
    pv_d0(o, vb0, pa0, pa1, pa2, pa3); partialSM(pB0, pB1, m_reg, mnB, alB);
    __syncthreads(); SWAIT(); SWRITE(0, SE);
    RESC(alB); __syncthreads();
    SBAR(); qkt(pA0, pA1, K_lds, qr, r32, hi);
    finishSM(pB0, pB1, alB, l_reg, pa0, pa1, pa2, pa3); SBAR();
    if (SDEPTH == 1 || j + 3 < NT) SLOAD(SE, (j + 1 + SDEPTH) * KVBLK); SBAR();
    pv_d0(o, vb0 + (int)SHM_V, pa0, pa1, pa2, pa3); partialSM(pA0, pA1, m_reg, mnA, alA);
    __syncthreads(); SWAIT(); SWRITE(1, SO);
    RESC(alA); __syncthreads();
  }
  SBAR(); qkt(pB0, pB1, (bf16*)((char*)K_lds + SHM_K), qr, r32, hi);
  finishSM(pA0, pA1, alA, l_reg, pa0, pa1, pa2, pa3); SBAR();
  pv_d0(o, vb0, pa0, pa1, pa2, pa3); partialSM(pB0, pB1, m_reg, mnB, alB);
  __syncthreads(); RESC(alB);
  finishSM(pB0, pB1, alB, l_reg, pa0, pa1, pa2, pa3); SBAR();
  pv_d0(o, vb0 + (int)SHM_V, pa0, pa1, pa2, pa3);
  if (hi == 0) li_l[r32] = l_reg; asm volatile("s_waitcnt lgkmcnt(0)" ::: "memory");
  float rli[16];
#pragma unroll
  for (int r = 0; r < 16; ++r) rli[r] = __builtin_amdgcn_rcpf(li_l[crow(r, hi)]);
  bf16* Ow = Ob + (long)(wid * QBLK) * LDO;
#pragma unroll
  for (int r = 0; r < 16; ++r) { int orow = crow(r, hi);
    for (int d0 = 0; d0 < 4; ++d0) Ow[(long)orow * LDO + d0 * 32 + r32] = __builtin_bit_cast(bf16, (unsigned short)(cvtpk(o[d0][r] * rli[r], 0.f) & 0xffffu)); }
#undef SLOAD
#undef SWRITE
#undef SWAIT
#undef RESC
}
#undef KSWZ
#undef SBAR
}
#define LAS __attribute__((address_space(3)))
typedef unsigned short bf16_t;
typedef float f32x4 __attribute__((ext_vector_type(4)));
typedef unsigned u32x4 __attribute__((ext_vector_type(4)));
typedef unsigned u32x2 __attribute__((ext_vector_type(2)));
typedef short bf16x8 __attribute__((ext_vector_type(8)));

constexpr int T = 49152, TP = 32768, DM = 2048, SEQ = 4096, NBATCH = 12, DFF = 8192, PLE = 256;
constexpr int PP = 7680;
constexpr int C_NAQ = 0, C_NAK = 1024, C_GQ = 2048, C_GK = 3072, C_GV = 3328, C_GA = 3584, C_GB = 5632;
constexpr float EPS = 1e-6f;
constexpr size_t MiB = 1u << 20;
constexpr size_t WS_TAB = 0, WS_WIN = 1 * MiB, WS_WNA = 35 * MiB, WS_WGQA = 39 * MiB, WS_WMIX = 43 * MiB, WS_WFF1 = 51 * MiB, WS_WFF2 = 83 * MiB,
                 WS_WPG = 115 * MiB, WS_WPP = 123 * MiB, WS_PB = 124 * MiB, WS_VT = 148 * MiB, WS_PROJ = 244 * MiB, WS_END0 = 964 * MiB;
constexpr size_t WS_Y = 244 * MiB, WS_H = 436 * MiB, WS_HID = 628 * MiB, WS_EP = 628 * MiB, WS_END = 1012 * MiB;
constexpr int LDS_BYTES = 147456;
constexpr int NTHREADS = 512;

struct Params {
    const float* x_p; const float* x_s; const float* p_p; const float* p_s;
    const float* ln_mix_pre; const float* w_in; const float* q_norm; const float* k_norm; const float* na_rpb;
    const float* w_na; const float* w_gqa; const float* w_mix; const float* ln_mix_post; const float* ln_mlp_pre;
    const float* w_ff1; const float* w_ff2; const float* ln_mlp_post; const float* ln_ple_pre; const float* w_ple_gate; const float* w_ple_proj; const float* ln_ple_post;
    float* out; unsigned char* ws;
};

__device__ __forceinline__ unsigned pk_bf16(float lo, float hi) { unsigned r; asm volatile("v_cvt_pk_bf16_f32 %0, %1, %2" : "=v"(r) : "v"(lo), "v"(hi)); return r; }
__device__ __forceinline__ float bflo(unsigned u) { return __uint_as_float(u << 16); }
__device__ __forceinline__ float bfhi(unsigned u) { return __uint_as_float(u & 0xffff0000u); }
__device__ __forceinline__ float wave_sum(float v) {
#pragma unroll
    for (int o = 1; o < 64; o <<= 1) v += __shfl_xor(v, o);
    return v;
}

__device__ __forceinline__ void transpose_item(const float* W, int K, int N, bf16_t* WT, int k0, int n0, int drow0, LAS float* scr, int lane, const float* gk) {
#pragma unroll 8
    for (int i = 0; i < 32; ++i) { const int kk = 2 * i + (lane >> 5); scr[kk * 33 + (lane & 31)] = W[(size_t)(k0 + kk) * N + n0 + (lane & 31)] * (gk ? gk[k0 + kk] : 1.f); }
    asm volatile("s_waitcnt lgkmcnt(0)" ::: "memory");
    const int c = lane & 7;
#pragma unroll
    for (int j = 0; j < 4; ++j) { const int n = (lane >> 3) + 8 * j; const LAS float* s = scr + (8 * c) * 33 + n;
        u32x4 o; o.x = pk_bf16(s[0 * 33], s[1 * 33]); o.y = pk_bf16(s[2 * 33], s[3 * 33]); o.z = pk_bf16(s[4 * 33], s[5 * 33]); o.w = pk_bf16(s[6 * 33], s[7 * 33]);
        *(u32x4*)(WT + (size_t)(drow0 + n) * K + k0 + 8 * c) = o; }
    asm volatile("s_waitcnt lgkmcnt(0)" ::: "memory");
}
__device__ __forceinline__ bool transpose_mat(int& r, const float* W, int K, int N, bf16_t* WT, LAS float* scr, int lane, bool remap_in, const float* gk = nullptr) {
    const int nblk = N / 32, items = (K / 64) * nblk;
    if (r >= items) { r -= items; return false; }
    const int kb = r / nblk, nb = r % nblk, n0 = nb * 32;
    int d0 = n0;
    if (remap_in) d0 = (n0 < 2048) ? n0 : (n0 < 3072 ? n0 - 2048 + 7680 : n0 - 1024);
    transpose_item(W, K, N, WT, kb * 64, n0, d0, scr, lane, gk);
    return true;
}

__device__ __forceinline__ const float* xrow_in(const Params& P, int m) { return m < TP ? P.x_p + (size_t)m * DM : P.x_s + (size_t)(m - TP) * DM; }

template <int MODE>
__device__ __forceinline__ void row_pass(const Params& P, const bf16_t* Y, const bf16_t* XS, bf16_t* XB, float* RS, const float* g1, int gw, int ngw) {
    int tid_l = threadIdx.x; asm volatile("" : "+v"(tid_l)); const int lane = tid_l & 63;
    for (int m0 = gw; m0 < T; m0 += 2 * ngw) {
        const int mr[2] = {m0, min(m0 + ngw, T - 1)}; const bool ok1 = (m0 + ngw < T);
        float x[2][4][8], y[2][4][8];
#pragma unroll
        for (int r = 0; r < 2; ++r) { const int mm = mr[r];
            if (MODE == 0 || MODE == 1) { const float* base = xrow_in(P, mm);
#pragma unroll
                for (int j = 0; j < 4; ++j) { const f32x4 a = *(const f32x4*)(base + j * 512 + lane * 8), b = *(const f32x4*)(base + j * 512 + lane * 8 + 4);
                    x[r][j][0] = a[0]; x[r][j][1] = a[1]; x[r][j][2] = a[2]; x[r][j][3] = a[3]; x[r][j][4] = b[0]; x[r][j][5] = b[1]; x[r][j][6] = b[2]; x[r][j][7] = b[3]; }
            } else {
#pragma unroll
                for (int j = 0; j < 4; ++j) { const u32x4 w = *(const u32x4*)(XS + (size_t)mm * DM + j * 512 + lane * 8);
                    x[r][j][0] = bflo(w.x); x[r][j][1] = bfhi(w.x); x[r][j][2] = bflo(w.y); x[r][j][3] = bfhi(w.y); x[r][j][4] = bflo(w.z); x[r][j][5] = bfhi(w.z); x[r][j][6] = bflo(w.w); x[r][j][7] = bfhi(w.w); }
            }
            if (MODE != 0) {
#pragma unroll
                for (int j = 0; j < 4; ++j) { const u32x4 w = *(const u32x4*)(Y + (size_t)mm * DM + j * 512 + lane * 8);
                    y[r][j][0] = bflo(w.x); y[r][j][1] = bfhi(w.x); y[r][j][2] = bflo(w.y); y[r][j][3] = bfhi(w.y); y[r][j][4] = bflo(w.z); y[r][j][5] = bfhi(w.z); y[r][j][6] = bflo(w.w); y[r][j][7] = bfhi(w.w); }
            }
        }
#pragma unroll
        for (int r = 0; r < 2; ++r) { const int mm = mr[r]; const bool ok = (r == 0) || ok1;
            if (MODE != 0) {
                float ss = 0.f;
#pragma unroll
                for (int j = 0; j < 4; ++j)
#pragma unroll
                    for (int i = 0; i < 8; ++i) ss += y[r][j][i] * y[r][j][i];
                const float rstd = __builtin_amdgcn_rsqf(wave_sum(ss) * (1.f / DM) + EPS);
#pragma unroll
                for (int j = 0; j < 4; ++j) { const f32x4 ga = *(const f32x4*)(g1 + j * 512 + lane * 8), gb = *(const f32x4*)(g1 + j * 512 + lane * 8 + 4);
                    const float gg[8] = {ga[0], ga[1], ga[2], ga[3], gb[0], gb[1], gb[2], gb[3]};
#pragma unroll
                    for (int i = 0; i < 8; ++i) x[r][j][i] += y[r][j][i] * rstd * gg[i]; }
            }
            if (MODE == 2) {
                if (ok) {
#pragma unroll
                    for (int j = 0; j < 4; ++j) { float* o = P.out + (size_t)mm * DM + j * 512 + lane * 8;
                        *(f32x4*)o = (f32x4){x[r][j][0], x[r][j][1], x[r][j][2], x[r][j][3]}; *(f32x4*)(o + 4) = (f32x4){x[r][j][4], x[r][j][5], x[r][j][6], x[r][j][7]}; } }
            } else {
                float ss = 0.f;
#pragma unroll
                for (int j = 0; j < 4; ++j)
#pragma unroll
                    for (int i = 0; i < 8; ++i) ss += x[r][j][i] * x[r][j][i];
                const float rstd = __builtin_amdgcn_rsqf(wave_sum(ss) * (1.f / DM) + EPS);
                if (ok) {
                    if (MODE == 0) {
#pragma unroll
                        for (int j = 0; j < 4; ++j) { const f32x4 ga = *(const f32x4*)(g1 + j * 512 + lane * 8), gb = *(const f32x4*)(g1 + j * 512 + lane * 8 + 4);
                            u32x4 w; w.x = pk_bf16(x[r][j][0] * rstd * ga[0], x[r][j][1] * rstd * ga[1]); w.y = pk_bf16(x[r][j][2] * rstd * ga[2], x[r][j][3] * rstd * ga[3]);
                            w.z = pk_bf16(x[r][j][4] * rstd * gb[0], x[r][j][5] * rstd * gb[1]); w.w = pk_bf16(x[r][j][6] * rstd * gb[2], x[r][j][7] * rstd * gb[3]);
                            *(u32x4*)(XB + (size_t)mm * DM + j * 512 + lane * 8) = w; }
                    } else {
                        if (lane == 0) RS[mm] = rstd;
#pragma unroll
                        for (int j = 0; j < 4; ++j) { u32x4 w; w.x = pk_bf16(x[r][j][0], x[r][j][1]); w.y = pk_bf16(x[r][j][2], x[r][j][3]); w.z = pk_bf16(x[r][j][4], x[r][j][5]); w.w = pk_bf16(x[r][j][6], x[r][j][7]);
                            *(u32x4*)(XB + (size_t)mm * DM + j * 512 + lane * 8) = w; }
                    }
                }
            }
        }
    }
}

__device__ __forceinline__ void qk_norm_rope(const Params& P, const bf16_t* PROJ, bf16_t* QC, bf16_t* KC, bf16_t* VC, const LAS float* tabl, int gw, int ngw, int lane_in) {
    (void)lane_in; int tid_l = threadIdx.x; asm volatile("" : "+v"(tid_l)); const int lane = tid_l & 63;
    const int hd4 = lane >> 4, c = lane & 15, half = c >> 3, isx2 = (c >> 2) & 1, i0 = (c & 3) * 8;
    float gq[8], gk[8];
#pragma unroll
    for (int i = 0; i < 8; ++i) { gq[i] = P.q_norm[c * 8 + i]; gk[i] = P.k_norm[c * 8 + i]; }
    for (int it0 = gw * 4; it0 < T; it0 += ngw * 4) {
        u32x4 wv[4];
#pragma unroll
        for (int k = 0; k < 4; ++k) { const int t = it0 + k, grp = 2;
            wv[k] = *(const u32x4*)(PROJ + (size_t)t * PP + C_GQ + (grp * 4 + hd4) * 128 + c * 8); }
#pragma unroll
        for (int k = 0; k < 4; ++k) {
            const int t = it0 + k, grp = 2;
            const u32x4 w = wv[k];
            float x[8] = {bflo(w.x), bfhi(w.x), bflo(w.y), bfhi(w.y), bflo(w.z), bfhi(w.z), bflo(w.w), bfhi(w.w)};
            float ss = 0.f;
#pragma unroll
            for (int i = 0; i < 8; ++i) ss += x[i] * x[i];
            ss += __shfl_xor(ss, 1); ss += __shfl_xor(ss, 2); ss += __shfl_xor(ss, 4); ss += __shfl_xor(ss, 8);
            const float rstd = __builtin_amdgcn_rsqf(ss * (1.f / 128.f) + EPS);
            const int sq = t & (SEQ - 1), pos = half ? (sq & 63) : (sq >> 6);
            const LAS float* tp = tabl + (pos * 32 + i0) * 2;
            float o[8];
#pragma unroll
            for (int i = 0; i < 8; ++i) { const float y = x[i] * rstd * (grp < 2 ? gq[i] : gk[i]); const float yp = __shfl_xor(y, 4);
                const float cs = tp[2 * i], sn = tp[2 * i + 1]; o[i] = isx2 ? (y * cs + yp * sn) : (y * cs - yp * sn); }
            u32x4 r; r.x = pk_bf16(o[0], o[1]); r.y = pk_bf16(o[2], o[3]); r.z = pk_bf16(o[4], o[5]); r.w = pk_bf16(o[6], o[7]);
            bf16_t* dst;
            if (grp < 2) dst = QC + (size_t)t * 1024 + (grp * 4 + hd4) * 128 + c * 8;
            else if (hd4 < 2) dst = KC + (size_t)t * 256 + hd4 * 128 + c * 8;
            else { dst = VC + (size_t)t * 256 + (hd4 - 2) * 128 + c * 8; r = w; }
            *(u32x4*)dst = r;
        }
    }
}

namespace na {
constexpr int KROW = 272, VROW = 144, VOFF = 64 * KROW, BUF = 36864, RPB_OFF = 2 * BUF, NA_LDS_END = RPB_OFF + 16384;
__device__ __forceinline__ void na_phase(const bf16_t* PROJ, const bf16_t* VT, const float* rpb, bf16_t* OUT, int opitch, int vcu, int G, LAS unsigned char* lds) {
    const int NU = NBATCH * 8 * 16, per = (NU + G - 1) / G;
    const bool xmap = (G == 256);
    const int ub = vcu * per, nun = xmap ? 6 : max(min(ub + per, NU) - ub, 0);
#define NA_UNIT(i) (xmap ? ((((vcu >> 5) * 12 + 2 * (i) + ((vcu & 31) >> 4)) << 4) + (vcu & 15)) : (ub + (i)))
    int tid_l = threadIdx.x; asm volatile("" : "+v"(tid_l));
    const int tid = tid_l, w = __builtin_amdgcn_readfirstlane(tid >> 6), lane = tid & 63, l15 = lane & 15, g = lane >> 4;
    const int qr = w >> 1, ch = w & 1;
    LAS float* rp = (LAS float*)(lds + RPB_OFF);
    for (int i = tid; i < 8 * 15 * 32; i += NTHREADS) { const int c31 = i & 31, hr = i >> 5; rp[i] = (c31 < 31) ? rpb[hr * 31 + c31] * 1.4426950408889634f : -1e30f; }
    if (nun <= 0) return;
    unsigned boff[2][8];
#pragma unroll
    for (int c2 = 0; c2 < 2; ++c2) { const int qc0 = 16 * (2 * ch + c2), cb = min(max(qc0 - 8, 0), 32), qcol = qc0 + l15, cs = min(max(qcol - 8, 0), 48);
#pragma unroll
        for (int e = 0; e < 8; ++e) { const int kc = cb + (e >> 2) * 16 + 4 * g + (e & 3); boff[c2][e] = ((kc >= cs) && (kc < cs + 16)) ? (unsigned)(kc - qcol + 15) * 4u : 124u; } }
    u32x4 st[2][4];
    unsigned koff[2], klds[2], vlds[2];
#pragma unroll
    for (int i_ = 0; i_ < 2; ++i_) { const int c_ = tid + 512 * i_;
        koff[i_] = (unsigned)((c_ >> 4) * PP + (c_ & 15) * 8) * 2u; klds[i_] = (unsigned)((c_ >> 4) * KROW + (c_ & 15) * 16);
        vlds[i_] = (unsigned)(VOFF + (c_ >> 3) * VROW + (c_ & 7) * 16); }
#define NA_DEC(uu) const int pr_ = (uu) >> 4, r0_ = 4 * ((uu) & 15), b_ = pr_ >> 3, hd_ = pr_ & 7, kr0_ = min(max(r0_ - 4, 0), 56), n_ = min(max(r0_ - 1, 0), 56) - kr0_ + 8
#define NA_LOADT(set, uu, t) do { NA_DEC(uu); { const int kr_ = min(kr0_ + (t), 63); (void)n_;     \
        const char* kb_ = (const char*)(PROJ + ((size_t)b_ * SEQ + (size_t)kr_ * 64) * PP + C_NAK + hd_ * 128); \
        const char* vb_ = (const char*)(VT + ((((size_t)b_ * 64 + kr_) * 8 + hd_) * 128) * 64); \
        st[set][0] = *(const u32x4*)(kb_ + koff[0]); st[set][1] = *(const u32x4*)(kb_ + koff[1]); \
        st[set][2] = *(const u32x4*)(vb_ + (unsigned)tid * 16u); st[set][3] = *(const u32x4*)(vb_ + (unsigned)(tid + 512) * 16u); } } while (0)
#define NA_WRITET(set, t) do { LAS unsigned char* bp_ = lds + ((t) & 1) * BUF; \
        *(LAS u32x4*)(bp_ + klds[0]) = st[set][0]; *(LAS u32x4*)(bp_ + klds[1]) = st[set][1]; *(LAS u32x4*)(bp_ + vlds[0]) = st[set][2]; *(LAS u32x4*)(bp_ + vlds[1]) = st[set][3]; } while (0)
    { const int u0 = NA_UNIT(0); NA_LOADT(0, u0, 0); NA_LOADT(1, u0, 1); }
    const float scale = 0.088388347648318440f, L2E = 1.4426950408889634f;
    for (int ui = 0; ui < nun; ++ui) {
        const bool has_next = (ui + 1 < nun);
        const int u = NA_UNIT(ui), un = has_next ? NA_UNIT(ui + 1) : u;
        const int pr = u >> 4, r0 = 4 * (u & 15), b = pr >> 3, head = pr & 7, kr0 = min(max(r0 - 4, 0), 56), n = min(max(r0 - 1, 0), 56) - kr0 + 8;
        const int r = r0 + qr, rsw = min(max(r - 4, 0), 56);
        const size_t tokq = (size_t)b * SEQ + r * 64;
        bf16x8 qf[2][4];
#pragma unroll
        for (int c2 = 0; c2 < 2; ++c2) { const bf16_t* qp = PROJ + (tokq + 16 * (2 * ch + c2) + l15) * PP + C_NAQ + head * 128 + 8 * g;
#pragma unroll
            for (int dc = 0; dc < 4; ++dc) qf[c2][dc] = *(const bf16x8*)(qp + dc * 32); }
#pragma unroll
        for (int c2 = 0; c2 < 2; ++c2)
#pragma unroll
            for (int dc = 0; dc < 4; ++dc) asm volatile("" : "+v"(qf[c2][dc]));
        float mrun[2] = {-1e30f, -1e30f}, lrun[2] = {0.f, 0.f};
        f32x4 O[2][8];
#pragma unroll
        for (int c2 = 0; c2 < 2; ++c2)
#pragma unroll
            for (int db = 0; db < 8; ++db) O[c2][db] = (f32x4){0.f, 0.f, 0.f, 0.f};
        const LAS unsigned char* rph = (const LAS unsigned char*)(rp + head * 480);
#pragma unroll
        for (int t = 0; t < 12; ++t) {
            NA_WRITET(t % 2, t);
            if (t + 2 < 12) NA_LOADT(t % 2, u, t + 2); else NA_LOADT(t % 2, un, t + 2 - 12);
            __syncthreads();
            const int kr = kr0 + t;
            if (kr >= rsw && kr < rsw + 8) {
                const LAS unsigned char* bp = lds + (t & 1) * BUF;
                const LAS unsigned char* brow = rph + (kr - r + 7) * 128;
                float bias[2][8]; f32x4 S[2][2]; float sv[2][8];
#pragma unroll
                for (int c2 = 0; c2 < 2; ++c2)
#pragma unroll
                    for (int e = 0; e < 8; ++e) bias[c2][e] = *(const LAS float*)(brow + boff[c2][e]);
#pragma unroll
                for (int c2 = 0; c2 < 2; ++c2) {
                    const int cb = min(max(16 * (2 * ch + c2) - 8, 0), 32);
                    const LAS unsigned char* kp = bp + (cb + l15) * KROW + 16 * g;
                    bf16x8 ka[2][4];
#pragma unroll
                    for (int kb = 0; kb < 2; ++kb)
#pragma unroll
                        for (int dc = 0; dc < 4; ++dc) ka[kb][dc] = *(const LAS bf16x8*)(kp + kb * 16 * KROW + dc * 64);
                    S[c2][0] = (f32x4){0.f, 0.f, 0.f, 0.f}; S[c2][1] = (f32x4){0.f, 0.f, 0.f, 0.f};
#pragma unroll
                    for (int dc = 0; dc < 4; ++dc)
#pragma unroll
                        for (int kb = 0; kb < 2; ++kb) S[c2][kb] = __builtin_amdgcn_mfma_f32_16x16x32_bf16(ka[kb][dc], qf[c2][dc], S[c2][kb], 0, 0, 0);
                }
                float tml[2];
#pragma unroll
                for (int c2 = 0; c2 < 2; ++c2) { float tm = -1e30f;
#pragma unroll
                    for (int e = 0; e < 8; ++e) { sv[c2][e] = fmaf(S[c2][e >> 2][e & 3], scale * L2E, bias[c2][e]); tm = fmaxf(tm, sv[c2][e]); }
                    tml[c2] = tm; }
                if (__any(tml[0] > mrun[0] + 40.f || tml[1] > mrun[1] + 40.f)) {
#pragma unroll
                    for (int c2 = 0; c2 < 2; ++c2) { float tm = tml[c2]; tm = fmaxf(tm, __shfl_xor(tm, 16)); tm = fmaxf(tm, __shfl_xor(tm, 32));
                        const float mn = fmaxf(mrun[c2], tm), alpha = __builtin_amdgcn_exp2f(mrun[c2] - mn);
                        mrun[c2] = mn; lrun[c2] *= alpha;
#pragma unroll
                        for (int db = 0; db < 8; ++db) O[c2][db] = O[c2][db] * alpha; }
                }
#pragma unroll
                for (int c2 = 0; c2 < 2; ++c2) { float ps = 0.f;
#pragma unroll
                    for (int e = 0; e < 8; ++e) { const float p = __builtin_amdgcn_exp2f(sv[c2][e] - mrun[c2]); sv[c2][e] = p; ps += p; }
                    lrun[c2] += ps; }
#pragma unroll
                for (int c2 = 0; c2 < 2; ++c2) {
                    const int cb = min(max(16 * (2 * ch + c2) - 8, 0), 32);
                    u32x4 pw; pw.x = pk_bf16(sv[c2][0], sv[c2][1]); pw.y = pk_bf16(sv[c2][2], sv[c2][3]); pw.z = pk_bf16(sv[c2][4], sv[c2][5]); pw.w = pk_bf16(sv[c2][6], sv[c2][7]);
                    const bf16x8 pj = __builtin_bit_cast(bf16x8, pw);
                    const LAS unsigned char* vp = bp + VOFF + l15 * VROW + (cb + 4 * g) * 2;
#pragma unroll
                    for (int dh = 0; dh < 2; ++dh) { u32x2 vlo[4], vhi[4];
#pragma unroll
                        for (int d4 = 0; d4 < 4; ++d4) { vlo[d4] = *(const LAS u32x2*)(vp + (dh * 4 + d4) * 16 * VROW); vhi[d4] = *(const LAS u32x2*)(vp + (dh * 4 + d4) * 16 * VROW + 32); }
#pragma unroll
                        for (int d4 = 0; d4 < 4; ++d4) { const u32x4 aw = {vlo[d4].x, vlo[d4].y, vhi[d4].x, vhi[d4].y};
                            O[c2][dh * 4 + d4] = __builtin_amdgcn_mfma_f32_16x16x32_bf16(__builtin_bit_cast(bf16x8, aw), pj, O[c2][dh * 4 + d4], 0, 0, 0); } }
                }
            }
        }
#pragma unroll
        for (int c2 = 0; c2 < 2; ++c2) {
            float lt = lrun[c2]; lt += __shfl_xor(lt, 16); lt += __shfl_xor(lt, 32);
            const float inv = 1.f / lt;
            bf16_t* op = OUT + (tokq + 16 * (2 * ch + c2) + l15) * opitch + head * 128 + 4 * g;
#pragma unroll
            for (int db = 0; db < 8; ++db) { u32x2 o; o.x = pk_bf16(O[c2][db][0] * inv, O[c2][db][1] * inv); o.y = pk_bf16(O[c2][db][2] * inv, O[c2][db][3] * inv); *(u32x2*)(op + db * 16) = o; }
        }
    }
#undef NA_LOADT
#undef NA_WRITET
#undef NA_DEC
#undef NA_UNIT
}
}

#define XB_TMO      128
#define XB_XCNT(j)  (256  + 64 * (j))
#define XB_XSUB(j)  (1280 + 64 * (j))
#define XB_XGEN(j)  (2304 + 64 * (j))
#define XB_TOP      3328
#define XB_TOPGEN   3392
#define XCD_BAR_WORDS 3456
#define XB_SPIN_CAP (1u << 18)

__device__ __forceinline__ unsigned xb_ld(unsigned* p)              { return __hip_atomic_load(p, __ATOMIC_RELAXED, __HIP_MEMORY_SCOPE_AGENT); }
__device__ __forceinline__ unsigned xb_add(unsigned* p, unsigned v) { return __hip_atomic_fetch_add(p, v, __ATOMIC_RELAXED, __HIP_MEMORY_SCOPE_AGENT); }
__device__ __forceinline__ unsigned xb_xcc_id() { return (unsigned)__builtin_amdgcn_s_getreg((3 << 11) | 20) & 0xFu; }
#define XB_SPIN(cond, bar) do { unsigned _sp = 0; while (cond) { __builtin_amdgcn_s_sleep(1); \
    if ((++_sp & 255u) == 0u) { if (xb_ld(&(bar)[XB_TMO])) break; if (_sp > XB_SPIN_CAP) { atomicAdd(&(bar)[XB_TMO], 1u); break; } } } } while (0)

struct XcdBarrier {
    unsigned* bar; unsigned x;
    volatile LAS unsigned* st;
};

__device__ __forceinline__ XcdBarrier xcd_barrier_post(unsigned* bar, volatile LAS unsigned* st) {
    XcdBarrier b; b.bar = bar; b.x = xb_xcc_id(); b.st = st;
    if (threadIdx.x == 0) (void)xb_add(&bar[XB_XCNT(b.x)], 1u);
    return b;
}
__device__ __forceinline__ void xcd_barrier_complete(unsigned* bar, unsigned x, unsigned& nloc, unsigned& nx) {
    const unsigned G = gridDim.x * gridDim.y * gridDim.z;
    unsigned sum, cnt, mine, sp = 0u;
    for (;;) {
        sum = 0u; cnt = 0u; mine = 0u;
#pragma unroll
        for (unsigned j = 0; j < 16; ++j) { const unsigned c = xb_ld(&bar[XB_XCNT(j)]); sum += c; cnt += (c > 0u) ? 1u : 0u; mine = (j == x) ? c : mine; }
        if (sum == G) break;
        __builtin_amdgcn_s_sleep(1);
        if ((++sp & 255u) == 0u) { if (xb_ld(&bar[XB_TMO])) break; if (sp > XB_SPIN_CAP) { atomicAdd(&bar[XB_TMO], 1u); break; } }
    }
    nloc = mine > 0u ? mine : 1u; nx = cnt > 0u ? cnt : 1u;
}

__device__ __forceinline__ void xcd_barrier(const XcdBarrier& b) {
    asm volatile("s_waitcnt vmcnt(0)" ::: "memory");
    __syncthreads();
    if (threadIdx.x == 0) {
        unsigned* bar = b.bar;
        __builtin_amdgcn_s_waitcnt(0);
        unsigned nloc = b.st[0], nx = b.st[1];
        if (nloc == 0u) { xcd_barrier_complete(bar, b.x, nloc, nx); b.st[0] = nloc; b.st[1] = nx; }
        const unsigned old = xb_add(&bar[XB_XSUB(b.x)], 1u);
        const unsigned gen = old / nloc;
        if (old + 1u == (gen + 1u) * nloc) {
            __builtin_amdgcn_fence(__ATOMIC_RELEASE, "agent");
            asm volatile("s_waitcnt vmcnt(0)" ::: "memory");
            const unsigned og = xb_add(&bar[XB_TOP], 1u);
            const unsigned tg = og / nx;
            if (og + 1u == (tg + 1u) * nx) xb_add(&bar[XB_TOPGEN], 1u);
            else XB_SPIN(xb_ld(&bar[XB_TOPGEN]) == tg, bar);
            __builtin_amdgcn_fence(__ATOMIC_ACQUIRE, "agent");
            xb_add(&bar[XB_XGEN(b.x)], 1u);
            asm volatile("s_waitcnt vmcnt(0)" ::: "memory");
        } else {
            XB_SPIN(xb_ld(&bar[XB_XGEN(b.x)]) == gen, bar);
            __builtin_amdgcn_fence(__ATOMIC_ACQUIRE, "agent");
            asm volatile("s_waitcnt vmcnt(0)" ::: "memory");
        }
    }
    __syncthreads();
}

#ifndef MK_PHASES
#define MK_PHASES 0xffff
#endif
#define PH(k) (((MK_PHASES) >> (k)) & 1)
#ifndef MK_SKELETON
#define MK_SKELETON 0
#endif
__global__ void __launch_bounds__(NTHREADS, 2) fwd_megakernel(Params P) {
    extern __shared__ __attribute__((aligned(16))) unsigned char lds_raw[];
    cg::grid_group grid = cg::this_grid();
    LAS unsigned char* lds = (LAS unsigned char*)lds_raw;
    const int wave = __builtin_amdgcn_readfirstlane((int)threadIdx.x >> 6);
#define tid ((int)threadIdx.x)
#define lane ((int)threadIdx.x & 63)
    const int G = gridDim.x, bid = blockIdx.x;
    const int vcu = (G % 8 == 0) ? (bid % 8) * (G / 8) + bid / 8 : bid;
    const int gw = vcu * 8 + wave, ngw = G * 8;
    unsigned char* ws = P.ws;
    if (tid < 16) ((LAS unsigned*)(lds + LDS_BYTES - 64))[tid] = 0u;
    __syncthreads();
    unsigned* BARW = (unsigned*)(ws + 512 * 1024);
    if (bid == 0) for (int i = tid; i < XCD_BAR_WORDS; i += NTHREADS) __hip_atomic_store(BARW + i, 0u, __ATOMIC_RELAXED, __HIP_MEMORY_SCOPE_AGENT);
    float* TAB = (float*)(ws + WS_TAB);
    bf16_t* WIN = (bf16_t*)(ws + WS_WIN); bf16_t* WNA = (bf16_t*)(ws + WS_WNA); bf16_t* WGQA = (bf16_t*)(ws + WS_WGQA); bf16_t* WMIX = (bf16_t*)(ws + WS_WMIX);
    bf16_t* WFF1 = (bf16_t*)(ws + WS_WFF1); bf16_t* WFF2 = (bf16_t*)(ws + WS_WFF2); bf16_t* WPG = (bf16_t*)(ws + WS_WPG); bf16_t* WPPJ = (bf16_t*)(ws + WS_WPP);
    bf16_t* PB = (bf16_t*)(ws + WS_PB); bf16_t* VT = (bf16_t*)(ws + WS_VT); bf16_t* PROJ = (bf16_t*)(ws + WS_PROJ);
    bf16_t* YB = (bf16_t*)(ws + WS_Y); bf16_t* HB = (bf16_t*)(ws + WS_H); bf16_t* HID = (bf16_t*)(ws + WS_HID); bf16_t* EP = (bf16_t*)(ws + WS_EP);
    bf16_t* XN = (bf16_t*)P.out;
    bf16_t* MG = (bf16_t*)P.out;
    bf16_t* AB = (bf16_t*)((unsigned char*)P.out + 192 * MiB);
    bf16_t* X1B = (bf16_t*)P.out;
    float* RS2 = (float*)(ws + 64 * 1024); float* RS3 = (float*)(ws + 256 * 1024);
    bf16_t* KC = (bf16_t*)(ws + 964 * MiB); bf16_t* VC = (bf16_t*)(ws + 988 * MiB); bf16_t* QC = nullptr;

    if (PH(0)) {
        for (int idx = bid * NTHREADS + tid; idx < 64 * 32; idx += G * NTHREADS) {
            const int pos = idx >> 5, i = idx & 31;
            const float freq = __builtin_amdgcn_exp2f(-(float)i * (13.287712379549449f / 32.f));
            const float rev = (float)pos * freq * 0.15915494309189535f; const float fr = rev - floorf(rev);
            TAB[idx * 2] = __builtin_amdgcn_cosf(fr); TAB[idx * 2 + 1] = __builtin_amdgcn_sinf(fr);
        }
        LAS float* scr = (LAS float*)(lds + wave * 16384);
        constexpr int NITEMS = (2048 / 64) * (8704 / 32) + 2 * (1024 / 64) * (2048 / 32) + 2 * (2048 / 64) * (2048 / 32) + (2048 / 64) * (8192 / 32) + (8192 / 64) * (2048 / 32) + (256 / 64) * (2048 / 32);
        for (int it = gw; it < NITEMS; it += ngw) {
            int r = it;
            if (transpose_mat(r, P.w_in, 2048, 8704, WIN, scr, lane, true)) continue;
            if (transpose_mat(r, P.w_na, 1024, 2048, WNA, scr, lane, false)) continue;
            if (transpose_mat(r, P.w_gqa, 1024, 2048, WGQA, scr, lane, false)) continue;
            if (transpose_mat(r, P.w_mix, 2048, 2048, WMIX, scr, lane, false)) continue;
            if (transpose_mat(r, P.w_ple_gate, 2048, 2048, WPG, scr, lane, false, P.ln_ple_pre)) continue;
            if (transpose_mat(r, P.w_ff1, 2048, 8192, WFF1, scr, lane, false, P.ln_mlp_pre)) continue;
            if (transpose_mat(r, P.w_ff2, 8192, 2048, WFF2, scr, lane, false)) continue;
            transpose_mat(r, P.w_ple_proj, 256, 2048, WPPJ, scr, lane, false);
        }
        for (size_t i = (size_t)bid * NTHREADS + tid; i < (size_t)T * PLE / 8; i += (size_t)G * NTHREADS) {
            const size_t e = i * 8; const float* src = e < (size_t)TP * PLE ? P.p_p + e : P.p_s + (e - (size_t)TP * PLE);
            const f32x4 a = *(const f32x4*)src, b = *(const f32x4*)(src + 4);
            u32x4 w; w.x = pk_bf16(a[0], a[1]); w.y = pk_bf16(a[2], a[3]); w.z = pk_bf16(b[0], b[1]); w.w = pk_bf16(b[2], b[3]);
            *(u32x4*)(PB + e) = w;
        }
        row_pass<0>(P, nullptr, nullptr, XN, nullptr, P.ln_mix_pre, gw, ngw);
    }
    grid.sync();
    XcdBarrier xbar = xcd_barrier_post(BARW, (volatile LAS unsigned*)(lds + LDS_BYTES - 64));
#if !MK_SKELETON
    if (PH(1)) {
        pg8::Gemm g{XN, WIN, T, 7680, 2048, 2048, 2048}; pg8::StaticOrder S; S.init(T, 7680, G, bid);
        pg8::EpiX<0> E{PROJ, PP, nullptr, 0};
        pg8::gemm_phase<pg8::EpiX<0>, pg8::StaticOrder, true, true>(lds, g, S, E);
        pg8::Gemm g2{WIN + (size_t)7680 * 2048, XN, 1024, T, 2048, 2048, 2048}; pg8::StaticOrder S2; S2.init(1024, T, G, bid);
        pg8::EpiX<5> E2{VT, T, nullptr, 0};
        pg8::gemm_phase<pg8::EpiX<5>, pg8::StaticOrder, true, true>(lds, g2, S2, E2);
    }
    xcd_barrier(xbar);
    if (PH(2)) {
        LAS float* tabl = (LAS float*)(lds + 98304);
        for (int i = tid; i < 64 * 32 * 2; i += NTHREADS) tabl[i] = TAB[i];
        __syncthreads();
        qk_norm_rope(P, PROJ, QC, KC, VC, tabl, gw, ngw, lane);
        na::na_phase(PROJ, VT, P.na_rpb, AB, 1024, vcu, G, lds);
        __syncthreads();
    }
    xcd_barrier(xbar);
    if (PH(3)) {
        const int NU = NBATCH * 2 * 64;
        for (int i = 0;; ++i) {
            int u;
            if (G == 256) { if (i >= 6) break; const int x = vcu >> 5, c = vcu & 31; u = (x * 3 + (i >> 1)) * 64 + (i & 1) * 32 + c; }
            else { u = bid + i * G; if (u >= NU) break; }
            const int pair = u >> 6, uu = u & 63, b = pair >> 1, kvh = pair & 1, h = kvh * 4 + (uu >> 4), qb = uu & 15;
            const gqa::bf16* Q = (const gqa::bf16*)(PROJ + ((size_t)b * SEQ + qb * 256) * PP + C_GQ + h * 128);
            const gqa::bf16* Kp = (const gqa::bf16*)(KC + (size_t)b * SEQ * 256 + kvh * 128);
            const gqa::bf16* Vp = (const gqa::bf16*)(VC + (size_t)b * SEQ * 256 + kvh * 128);
            gqa::attn_dense_body<gqa::bf16>(Q, Kp, Vp, (gqa::bf16*)(AB + (size_t)T * 1024 + ((size_t)b * SEQ + qb * 256) * 1024 + h * 128), SEQ, (char*)lds_raw, P.q_norm, TAB, qb * 256);
            __syncthreads();
        }
    }
    xcd_barrier(xbar);
    if (PH(4)) {
        pg8::SegOrder S; S.base.init(T, DM, G, bid);
        pg8::Gemm g{AB, WNA, T, DM, 1024, 1024, 1024, (size_t)T * 1024 * 2, (size_t)DM * 1024 * 2};
        pg8::EpiGate E{MG, DM, PROJ + C_GA, PROJ + C_GB, PP};
        pg8::gemm_phase<pg8::EpiGate, pg8::SegOrder, true, true>(lds, g, S, E);
    }
    xcd_barrier(xbar);
    if (PH(5)) {
        pg8::StaticOrder S; S.init(T, DM, G, bid);
        pg8::Gemm g{MG, WMIX, T, DM, DM, DM, DM}; pg8::EpiX<0> E{YB, DM, nullptr, 0};
        pg8::gemm_phase<pg8::EpiX<0>, pg8::StaticOrder, true, true>(lds, g, S, E);
    }
    xcd_barrier(xbar);
    if (PH(6)) row_pass<1>(P, YB, nullptr, X1B, RS2, P.ln_mix_post, gw, ngw);
    xcd_barrier(xbar);
    if (PH(7))
#pragma unroll
    for (int half = 0; half < 2; ++half) {
        const size_t r0 = (size_t)half * (T / 2);
        {
            pg8::StaticOrder S; S.init(T / 2, DFF, G, bid);
            pg8::Gemm g{X1B + r0 * DM, WFF1, T / 2, DFF, DM, DM, DM}; pg8::EpiX<1> E{HID, DFF, nullptr, 0, RS2 + r0};
            pg8::gemm_phase<pg8::EpiX<1>, pg8::StaticOrder, true, true>(lds, g, S, E);
        }
        xcd_barrier(xbar);
        {
            pg8::StaticOrder S; S.init(T / 2, DM, G, bid);
            pg8::Gemm g{HID, WFF2, T / 2, DM, DFF, DFF, DFF}; pg8::EpiX<0> E{YB + r0 * DM, DM, nullptr, 0};
            pg8::gemm_phase<pg8::EpiX<0>, pg8::StaticOrder, true, true>(lds, g, S, E);
        }
        xcd_barrier(xbar);
    }
    if (PH(8)) row_pass<3>(P, YB, X1B, YB, RS3, P.ln_mlp_post, gw, ngw);
    xcd_barrier(xbar);
    if (PH(9)) {
        pg8::StaticOrder S; S.init(T, DM, G, bid);
        pg8::Gemm g1{PB, WPPJ, T, DM, PLE, PLE, PLE}; pg8::EpiX<0> E1{EP, DM, nullptr, 0};
        pg8::gemm_phase<pg8::EpiX<0>, pg8::StaticOrder, true, true>(lds, g1, S, E1);
        pg8::Gemm g2{YB, WPG, T, DM, DM, DM, DM}; pg8::EpiX<4> E2{EP, DM, nullptr, 0, RS3};
        pg8::gemm_phase<pg8::EpiX<4>, pg8::StaticOrder, true, true>(lds, g2, S, E2);
    }
    xcd_barrier(xbar);
    if (PH(10)) row_pass<2>(P, EP, YB, nullptr, nullptr, P.ln_ple_post, gw, ngw);
#else
    for (int k = 0; k < 12; ++k) {
        for (size_t i = (size_t)bid * NTHREADS + tid; i < (size_t)T * DM / 64; i += (size_t)G * NTHREADS) P.out[i * 64 + k] = (float)k;
        xcd_barrier(xbar);
    }
#endif
}

#undef tid
#undef lane
extern "C" void kernel_launch(void* const* d_in, const int* in_sizes, int n_in, void* d_out, int out_size, void* d_ws, size_t ws_size, hipStream_t stream) {
    static int grid = 0;
    if (grid == 0) {
        if (n_in != 21 || out_size != T * DM || ws_size < WS_END) { fprintf(stderr, "kernel_launch: unexpected shapes: n_in %d out %d ws %zu (need >= %zu)\n", n_in, out_size, ws_size, (size_t)WS_END); grid = -1; return; }
        int dev = 0, cus = 0, per_cu = 0;
        if (hipGetDevice(&dev) != hipSuccess || hipDeviceGetAttribute(&cus, hipDeviceAttributeMultiprocessorCount, dev) != hipSuccess) { fprintf(stderr, "kernel_launch: device query failed\n"); grid = -1; return; }
        if (hipFuncSetAttribute((const void*)fwd_megakernel, hipFuncAttributeMaxDynamicSharedMemorySize, LDS_BYTES) != hipSuccess) { fprintf(stderr, "kernel_launch: hipFuncSetAttribute failed\n"); grid = -1; return; }
        if (hipOccupancyMaxActiveBlocksPerMultiprocessor(&per_cu, (const void*)fwd_megakernel, NTHREADS, LDS_BYTES) != hipSuccess || per_cu < 1) { fprintf(stderr, "kernel_launch: occupancy query says %d\n", per_cu); per_cu = 1; }
        (void)hipGetLastError();
        grid = cus * per_cu;
    }
    if (grid < 0) return;
    Params p{};
    p.x_p = (const float*)d_in[0]; p.x_s = (const float*)d_in[1]; p.p_p = (const float*)d_in[2]; p.p_s = (const float*)d_in[3];
    p.ln_mix_pre = (const float*)d_in[4]; p.w_in = (const float*)d_in[5]; p.q_norm = (const float*)d_in[6]; p.k_norm = (const float*)d_in[7]; p.na_rpb = (const float*)d_in[8];
    p.w_na = (const float*)d_in[9]; p.w_gqa = (const float*)d_in[10]; p.w_mix = (const float*)d_in[11]; p.ln_mix_post = (const float*)d_in[12]; p.ln_mlp_pre = (const float*)d_in[13];
    p.w_ff1 = (const float*)d_in[14]; p.w_ff2 = (const float*)d_in[15]; p.ln_mlp_post = (const float*)d_in[16]; p.ln_ple_pre = (const float*)d_in[17];
    p.w_ple_gate = (const float*)d_in[18]; p.w_ple_proj = (const float*)d_in[19]; p.ln_ple_post = (const float*)d_in[20];
    p.out = (float*)d_out; p.ws = (unsigned char*)d_ws;
    void* args[] = {&p};
    const hipError_t e = hipLaunchCooperativeKernel((const void*)fwd_megakernel, dim3(grid), dim3(NTHREADS), args, LDS_BYTES, stream);
    if (e != hipSuccess) fprintf(stderr, "kernel_launch: cooperative launch failed: %s (grid %d)\n", hipGetErrorString(e), grid);
}
```

```cpp
#include <hip/hip_runtime.h>
#include <hip/hip_cooperative_groups.h>
#include <hip/hip_bf16.h>
#include <cstdio>
#include <cstdint>
namespace cg = cooperative_groups;
namespace pg8 {
#define PG8_LAS __attribute__((address_space(3)))
typedef unsigned short bf16_t;
typedef short bf16x8 __attribute__((ext_vector_type(8)));
typedef float f32x4 __attribute__((ext_vector_type(4)));
typedef unsigned u32x4 __attribute__((ext_vector_type(4)));
constexpr int BM = 256, BK = 64, HALF = 128, HTB = HALF * BK * 2  , STAGE_BYTES = 8 * HTB, NXCD = 8, WGM = 8;

__host__ __device__ __forceinline__ int lds_byte(int r, int c) { const int st = (r >> 4) * 2 + (c >> 5), rr = r & 15, cc = c & 31, ob = rr * 64 + cc * 2; return st * 1024 + (ob ^ (((ob >> 9) & 1) << 5)); }
__host__ __device__ __forceinline__ void stage_rc(int b, int& R, int& C) { const int st = b / 1024, sb = b % 1024, swz = sb ^ (((sb >> 9) & 1) << 5); R = (st >> 1) * 16 + swz / 64; C = (st & 1) * 32 + (swz % 64) / 2; }
__host__ __device__ __forceinline__ int perm32(int rho) { const int n = rho >> 4, i = rho & 15; return 8 * (i >> 2) + 4 * n + (i & 3); }

struct Unit { int pm, pn, seg; };
struct Gemm { const bf16_t* A; const bf16_t* Bt; int M, N, K, lda, ldb; size_t segA = 0, segB = 0; };

struct StaticOrder {
    int nM, nN, nwg, G, c, wgm;
    __host__ __device__ void init(int M, int N, int G_, int c_, int wgm_ = WGM) { nM = M / BM; nN = N / BM; nwg = nM * nN; G = G_; c = c_; wgm = wgm_; }
    __host__ __device__ bool next(int i, Unit& u) const {
        const long L = (long)i * G + c; if (L >= nwg) return false;
        int wgid = (int)L; { const int q = nwg / NXCD, r = nwg % NXCD, xcd = wgid % NXCD, off = wgid / NXCD; wgid = (xcd < r ? xcd * (q + 1) : r * (q + 1) + (xcd - r) * q) + off; }
        const int nig = wgm * nN, gid = wgid / nig, fm = gid * wgm, gsz = (nM - fm) < wgm ? (nM - fm) : wgm;
        u.pm = fm + ((wgid % nig) % gsz); u.pn = (wgid % nig) / gsz; u.seg = 0; return true;
    }
    __device__ __forceinline__ void a_ready(const Unit&) const {}
    __device__ __forceinline__ void done(const Unit&) const {}
};

__device__ __forceinline__ unsigned cvt_pk_bf16(float lo, float hi) { unsigned r; asm volatile("v_cvt_pk_bf16_f32 %0, %1, %2" : "=v"(r) : "v"(lo), "v"(hi)); return r; }
typedef float f32x2 __attribute__((ext_vector_type(2)));
__device__ __forceinline__ f32x2 gelu_pk(f32x2 v) {
    const f32x2 av = __builtin_elementwise_abs(v), d = av * 0.2316418882f + 1.0f;
    f32x2 t; t.x = __builtin_amdgcn_rcpf(d.x); t.y = __builtin_amdgcn_rcpf(d.y);
    f32x2 q = t * 0.5307027145f + (-0.7265760135f); q = q * t + 0.7107068705f; q = q * t + (-0.142248368f); q = q * t + 0.127414796f; q = q * t;
    const f32x2 s = (v * v) * (-0.72134752044f);
    f32x2 e; e.x = __builtin_amdgcn_exp2f(s.x); e.y = __builtin_amdgcn_exp2f(s.y);
    const f32x2 m = v * (q * e), r = v - m;
    f32x2 o; o.x = v.x < 0.f ? m.x : r.x; o.y = v.y < 0.f ? m.y : r.y; return o;
}

template <int ACT  > struct EpiBf16 {
    static constexpr bool PERM = true, AFTER_DRAIN = false; static_assert(ACT == 0 || ACT == 1, "EpiBf16: ACT is 0 (none) or 1 (gelu_pk)");
    bf16_t* O; int ldc; const float* bias; int split_cols; size_t split_stride; float scale0;
    __device__ __forceinline__ void operator()(const f32x4 (&acc)[2][2][4][2], const Unit& u, int wr, int wc, int fr, int fq) const {
        const int row0 = u.pm * BM + wr * 64 + fr; int colt = u.pn * BM; bf16_t* base = O;
        float sc = 1.f; if (split_cols) { const int t = colt / split_cols; base += (size_t)t * split_stride; colt -= t * split_cols; if (t == 0) sc = scale0; }
        const int col0 = colt + wc * 32 + 8 * fq, bcol0 = u.pn * BM + wc * 32 + 8 * fq;
        f32x4 bv[2][2];
#pragma unroll
        for (int bj = 0; bj < 2; ++bj)
#pragma unroll
            for (int n = 0; n < 2; ++n) bv[bj][n] = bias ? *(const f32x4*)(bias + bcol0 + bj * HALF + 4 * n) : (f32x4){0.f, 0.f, 0.f, 0.f};
#pragma unroll
        for (int ai = 0; ai < 2; ++ai)
#pragma unroll
            for (int m = 0; m < 4; ++m) { bf16_t* rowp = base + (size_t)(row0 + ai * HALF + m * 16) * ldc + col0;
#pragma unroll
                for (int bj = 0; bj < 2; ++bj) { f32x4 v0 = acc[ai][bj][m][0] + bv[bj][0], v1 = acc[ai][bj][m][1] + bv[bj][1];
                    if (ACT == 1) { f32x2 a = gelu_pk((f32x2){v0[0], v0[1]}), b = gelu_pk((f32x2){v0[2], v0[3]}), c = gelu_pk((f32x2){v1[0], v1[1]}), d = gelu_pk((f32x2){v1[2], v1[3]});
                        v0 = (f32x4){a.x, a.y, b.x, b.y}; v1 = (f32x4){c.x, c.y, d.x, d.y}; }
                    v0 = v0 * sc; v1 = v1 * sc; u32x4 w; w.x = cvt_pk_bf16(v0[0], v0[1]); w.y = cvt_pk_bf16(v0[2], v0[3]); w.z = cvt_pk_bf16(v1[0], v1[1]); w.w = cvt_pk_bf16(v1[2], v1[3]);
                    *(u32x4*)(rowp + bj * HALF) = w; } }
    }
};
template <class Epi, class Sched, bool ALIGN_EPI = false, bool SP2 = false>
__device__ __forceinline__ void gemm_phase(PG8_LAS unsigned char* lds, const Gemm g, const Sched& S, const Epi& E) {
    int tid_l = threadIdx.x; asm volatile("" : "+v"(tid_l));
    const int tid = tid_l, wid = __builtin_amdgcn_readfirstlane(tid >> 6), lane = tid & 63, wr = wid >> 2, wc = wid & 3, fr = lane & 15, fq = lane >> 4;
    const int K = g.K, nt = K / BK;
    unsigned voffA[2], voffB[2];
#pragma unroll
    for (int i = 0; i < 2; ++i) { int R, C; stage_rc(tid * 16 + i * 8192, R, C); const int Rb = Epi::PERM ? ((R & ~31) + perm32(R & 31)) : R;
        voffA[i] = (unsigned)(R * g.lda + C) * 2u; voffB[i] = (unsigned)(Rb * g.ldb + C) * 2u; }
    const size_t kstep = (size_t)(BK * 2);
    const size_t hstepA = (size_t)HALF * g.lda * 2, hstepB = (size_t)HALF * g.ldb * 2;
    const size_t tstepA = 2 * hstepA, tstepB = 2 * hstepB;
    const unsigned ldsw = (unsigned)wid * 1024u;
    const int aoff = lds_byte(wr * 64 + fr, fq * 8), boff = lds_byte(wc * 32 + fr, fq * 8);
#define PG8_SA(b, h) (((b) * 2 + (h)) * HTB)
#define PG8_SB(b, h) ((4 + (b) * 2 + (h)) * HTB)
#define PG8_STAGE(bufoff, gbase, voff) do { _Pragma("unroll") for (int _i = 0; _i < 2; ++_i) \
        __builtin_amdgcn_global_load_lds((const unsigned*)((const char*)(gbase) + (voff)[_i]), (PG8_LAS unsigned*)(lds + (bufoff) + ldsw + _i * 8192), 16, 0, 0); } while (0)
#define PG8_LDA(dst, b, h) do { _Pragma("unroll") for (int m = 0; m < 4; ++m) _Pragma("unroll") for (int k = 0; k < 2; ++k) dst[m][k] = *(const PG8_LAS bf16x8*)(lds + PG8_SA(b, h) + aoff + m * 2048 + k * 1024); } while (0)
#define PG8_LDB(dst, b, h) do { _Pragma("unroll") for (int n = 0; n < 2; ++n) _Pragma("unroll") for (int k = 0; k < 2; ++k) dst[n][k] = *(const PG8_LAS bf16x8*)(lds + PG8_SB(b, h) + boff + n * 2048 + k * 1024); } while (0)
#define PG8_MMA(ai, bj, At, Bt) do { __builtin_amdgcn_s_setprio(1); _Pragma("unroll") for (int m = 0; m < 4; ++m) _Pragma("unroll") for (int n = 0; n < 2; ++n) _Pragma("unroll") for (int k = 0; k < 2; ++k) \
        acc[ai][bj][m][n] = __builtin_amdgcn_mfma_f32_16x16x32_bf16(Bt[n][k], At[m][k], acc[ai][bj][m][n], 0, 0, 0); __builtin_amdgcn_s_setprio(0); } while (0)
#define PG8_WAIT_V(n) asm volatile("s_waitcnt vmcnt(" #n ")" ::: "memory")
#define PG8_WAIT_L(n) asm volatile("s_waitcnt lgkmcnt(" #n ")" ::: "memory")
#define PG8_BAR __builtin_amdgcn_s_barrier()
#define PG8_SCHED __builtin_amdgcn_sched_barrier(0)
    Unit cur, nxt; int ui = 0;
    if (!S.next(0, cur)) return;
    f32x4 acc[2][2][4][2];
#pragma unroll
    for (int a = 0; a < 2; ++a)
#pragma unroll
        for (int b = 0; b < 2; ++b)
#pragma unroll
            for (int m = 0; m < 4; ++m)
#pragma unroll
                for (int n = 0; n < 2; ++n) acc[a][b][m][n] = (f32x4){0.f, 0.f, 0.f, 0.f};
    bf16x8 At[4][2], B0[2][2], B1[2][2];
    const char* cA = (const char*)g.A + (size_t)cur.seg * g.segA + (size_t)cur.pm * tstepA; const char* cB = (const char*)g.Bt + (size_t)cur.seg * g.segB + (size_t)cur.pn * tstepB;
    S.a_ready(cur);
    if constexpr (SP2) {
        PG8_STAGE(PG8_SB(0, 0), cB, voffB); PG8_STAGE(PG8_SB(0, 1), cB + hstepB, voffB); PG8_STAGE(PG8_SA(0, 0), cA, voffA); PG8_STAGE(PG8_SA(0, 1), cA + hstepA, voffA);
        if (wr == 1) PG8_BAR;
        PG8_WAIT_V(2); PG8_BAR;
        PG8_STAGE(PG8_SB(1, 0), cB + kstep, voffB); PG8_STAGE(PG8_SA(1, 0), cA + kstep, voffA); PG8_STAGE(PG8_SB(1, 1), cB + hstepB + kstep, voffB);
        PG8_WAIT_V(6); PG8_BAR;
    } else {
        PG8_STAGE(PG8_SB(0, 0), cB, voffB); PG8_STAGE(PG8_SA(0, 0), cA, voffA); PG8_STAGE(PG8_SB(0, 1), cB + hstepB, voffB); PG8_STAGE(PG8_SA(0, 1), cA + hstepA, voffA);
        if (wr == 1) PG8_BAR;
        PG8_WAIT_V(4); PG8_BAR;
        PG8_STAGE(PG8_SB(1, 0), cB + kstep, voffB); PG8_STAGE(PG8_SA(1, 0), cA + kstep, voffA); PG8_STAGE(PG8_SB(1, 1), cB + hstepB + kstep, voffB);
        PG8_WAIT_V(6); PG8_BAR;
    }
    for (;;) {
        const bool has_next = S.next(ui + 1, nxt);
        const char* nA = has_next ? (const char*)g.A + (size_t)nxt.seg * g.segA + (size_t)nxt.pm * tstepA : cA; const char* nB = has_next ? (const char*)g.Bt + (size_t)nxt.seg * g.segB + (size_t)nxt.pn * tstepB : cB;
        for (int t = 0; t < nt; t += 2) {
            const bool last = (t == nt - 2);
            const char* a1 = cA + (size_t)(t + 1) * kstep;
            const char* a2 = last ? nA : cA + (size_t)(t + 2) * kstep; const char* b2 = last ? nB : cB + (size_t)(t + 2) * kstep;
            const char* a3 = a2 + kstep; const char* b3 = b2 + kstep;
            if (last && has_next) S.a_ready(nxt);
            if constexpr (SP2) {
            PG8_LDB(B0, 0, 0); PG8_LDB(B1, 0, 1); PG8_SCHED; PG8_LDA(At, 0, 0); PG8_STAGE(PG8_SA(1, 1), a1 + hstepA, voffA);
            PG8_WAIT_V(8); PG8_WAIT_L(0); PG8_BAR; PG8_MMA(0, 0, At, B0); PG8_MMA(0, 1, At, B1); PG8_BAR; PG8_SCHED;
            PG8_LDA(At, 0, 1); PG8_STAGE(PG8_SB(0, 0), b2, voffB); PG8_STAGE(PG8_SB(0, 1), b2 + hstepB, voffB); PG8_STAGE(PG8_SA(0, 0), a2, voffA);
            PG8_WAIT_V(8); PG8_WAIT_L(0); PG8_BAR; PG8_MMA(1, 0, At, B0); PG8_MMA(1, 1, At, B1); PG8_BAR; PG8_SCHED;
            PG8_LDB(B0, 1, 0); PG8_LDB(B1, 1, 1); PG8_SCHED; PG8_LDA(At, 1, 0); PG8_STAGE(PG8_SA(0, 1), a2 + hstepA, voffA);
            PG8_WAIT_V(8); PG8_WAIT_L(0); PG8_BAR; PG8_MMA(0, 0, At, B0); PG8_MMA(0, 1, At, B1); PG8_BAR; PG8_SCHED;
            PG8_LDA(At, 1, 1); PG8_STAGE(PG8_SB(1, 0), b3, voffB); PG8_STAGE(PG8_SB(1, 1), b3 + hstepB, voffB); PG8_STAGE(PG8_SA(1, 0), a3, voffA);
            PG8_WAIT_V(8); PG8_WAIT_L(0); PG8_BAR; PG8_MMA(1, 0, At, B0); PG8_MMA(1, 1, At, B1); PG8_BAR; PG8_SCHED;
            } else {
            PG8_LDB(B0, 0, 0); PG8_SCHED; PG8_LDA(At, 0, 0); PG8_STAGE(PG8_SA(1, 1), a1 + hstepA, voffA);
            PG8_WAIT_L(8); PG8_BAR; PG8_WAIT_L(0); PG8_MMA(0, 0, At, B0); PG8_BAR; PG8_SCHED;
            PG8_LDB(B1, 0, 1); PG8_STAGE(PG8_SB(0, 0), b2, voffB);
            PG8_BAR; PG8_WAIT_L(0); PG8_MMA(0, 1, At, B1); PG8_BAR;
            PG8_LDA(At, 0, 1); PG8_STAGE(PG8_SA(0, 0), a2, voffA);
            PG8_BAR; PG8_WAIT_L(0); PG8_MMA(1, 0, At, B0); PG8_BAR; PG8_SCHED;
            PG8_STAGE(PG8_SB(0, 1), b2 + hstepB, voffB);
            PG8_WAIT_V(6); PG8_BAR; PG8_MMA(1, 1, At, B1); PG8_BAR;
            PG8_LDB(B0, 1, 0); PG8_SCHED; PG8_LDA(At, 1, 0); PG8_STAGE(PG8_SA(0, 1), a2 + hstepA, voffA);
            PG8_WAIT_L(8); PG8_BAR; PG8_WAIT_L(0); PG8_MMA(0, 0, At, B0); PG8_BAR; PG8_SCHED;
            PG8_LDB(B1, 1, 1); PG8_STAGE(PG8_SB(1, 0), b3, voffB);
            PG8_BAR; PG8_WAIT_L(0); PG8_MMA(0, 1, At, B1); PG8_BAR;
            PG8_LDA(At, 1, 1); PG8_STAGE(PG8_SA(1, 0), a3, voffA);
            PG8_BAR; PG8_WAIT_L(0); PG8_MMA(1, 0, At, B0); PG8_BAR; PG8_SCHED;
            PG8_STAGE(PG8_SB(1, 1), b3 + hstepB, voffB);
            PG8_WAIT_V(6); PG8_BAR; PG8_MMA(1, 1, At, B1); PG8_BAR;
            }
        }
        if constexpr (ALIGN_EPI) { if (wr == 0) PG8_BAR; }
        bool keep_acc = false;
        if constexpr (!Epi::AFTER_DRAIN) { if constexpr (Epi::SEG) { if (cur.seg == 0) { E.mid(acc, cur, wr, wc, fr, fq); keep_acc = true; } else E(acc, cur, wr, wc, fr, fq); } else E(acc, cur, wr, wc, fr, fq); S.done(cur); }
        if (!has_next) break;
        if (!keep_acc)
#pragma unroll
        for (int a = 0; a < 2; ++a)
#pragma unroll
            for (int b = 0; b < 2; ++b)
#pragma unroll
                for (int m = 0; m < 4; ++m)
#pragma unroll
                    for (int n = 0; n < 2; ++n) acc[a][b][m][n] = (f32x4){0.f, 0.f, 0.f, 0.f};
        cur = nxt; cA = nA; cB = nB; ++ui;
        if constexpr (ALIGN_EPI) { if (wr == 1) PG8_BAR; }
    }
    PG8_WAIT_V(0);
    if constexpr (!ALIGN_EPI) { if (wr == 0) PG8_BAR; }
    PG8_BAR;
    if constexpr (Epi::AFTER_DRAIN) { E.fused(acc, cur, wr, wc, fr, fq, lds, wid, lane); S.done(cur); }
#undef PG8_SA
#undef PG8_SB
#undef PG8_STAGE
#undef PG8_LDA
#undef PG8_LDB
#undef PG8_MMA
#undef PG8_WAIT_V
#undef PG8_WAIT_L
#undef PG8_BAR
#undef PG8_SCHED
}
}
namespace pg8 {
__device__ __forceinline__ float bf_lo(unsigned u) { return __uint_as_float(u << 16); }
__device__ __forceinline__ float bf_hi(unsigned u) { return __uint_as_float(u & 0xffff0000u); }
__device__ __forceinline__ float sigm(float x) { return __builtin_amdgcn_rcpf(1.f + __builtin_amdgcn_exp2f(-1.4426950408889634f * x)); }
template <int MODE> struct EpiX {
    static constexpr bool PERM = true, AFTER_DRAIN = false, SEG = false;
    bf16_t* O; int ldc; const bf16_t* G; int ldg; const float* RS = nullptr;
    __device__ __forceinline__ void operator()(const f32x4 (&acc)[2][2][4][2], const Unit& u, int wr, int wc, int fr, int fq) const {
        const int row0 = u.pm * BM + wr * 64 + fr; const int col0 = u.pn * BM + wc * 32 + 8 * fq;
#pragma unroll
        for (int ai = 0; ai < 2; ++ai)
#pragma unroll
            for (int m = 0; m < 4; ++m) { const size_t row = (size_t)(row0 + ai * HALF + m * 16);
#pragma unroll
                for (int bj = 0; bj < 2; ++bj) { const int col = col0 + bj * HALF;
                    const f32x4 a0 = acc[ai][bj][m][0], a1 = acc[ai][bj][m][1];
                    float v[8] = {a0[0], a0[1], a0[2], a0[3], a1[0], a1[1], a1[2], a1[3]};
                    bf16_t* op = O + row * ldc + col;
                    if (MODE == 5) op = O + ((((size_t)(col >> 12) * 64 + ((col >> 6) & 63)) * 8 + (row >> 7)) * 128 + (row & 127)) * 64 + (col & 63);
                    if (MODE == 1) {
                        const float rs = RS[row], rs2 = rs * rs;
#pragma unroll
                        for (int i = 0; i < 8; ++i) { const float r = fmaxf(v[i], 0.f); v[i] = r * r * rs2; } }
                    if (MODE == 2 || MODE == 3) { const u32x4 gw = *(const u32x4*)(G + row * ldg + col);
                        const float gf[8] = {bf_lo(gw.x), bf_hi(gw.x), bf_lo(gw.y), bf_hi(gw.y), bf_lo(gw.z), bf_hi(gw.z), bf_lo(gw.w), bf_hi(gw.w)};
#pragma unroll
                        for (int i = 0; i < 8; ++i) v[i] = sigm(gf[i]) * v[i]; }
                    if (MODE == 3) { const u32x4 ow = *(const u32x4*)op;
                        const float of[8] = {bf_lo(ow.x), bf_hi(ow.x), bf_lo(ow.y), bf_hi(ow.y), bf_lo(ow.z), bf_hi(ow.z), bf_lo(ow.w), bf_hi(ow.w)};
#pragma unroll
                        for (int i = 0; i < 8; ++i) v[i] += of[i]; }
                    if (MODE == 4) { const u32x4 ow = *(const u32x4*)op;
                        const float of[8] = {bf_lo(ow.x), bf_hi(ow.x), bf_lo(ow.y), bf_hi(ow.y), bf_lo(ow.z), bf_hi(ow.z), bf_lo(ow.w), bf_hi(ow.w)};
                        const float rs = RS[row];
#pragma unroll
                        for (int i = 0; i < 8; ++i) v[i] = of[i] * sigm(v[i] * rs); }
                    u32x4 w; w.x = cvt_pk_bf16(v[0], v[1]); w.y = cvt_pk_bf16(v[2], v[3]); w.z = cvt_pk_bf16(v[4], v[5]); w.w = cvt_pk_bf16(v[6], v[7]);
                    *(u32x4*)op = w; }
                if (MODE >= 2) asm volatile("" ::: "memory"); }
    }
};

struct SegOrder { StaticOrder base;
    __device__ bool next(int i, Unit& u) const { if (!base.next(i >> 1, u)) return false; u.seg = i & 1; return true; }
    __device__ __forceinline__ void a_ready(const Unit&) const {}
    __device__ __forceinline__ void done(const Unit&) const {} };
struct EpiGate {
    static constexpr bool PERM = true, AFTER_DRAIN = false, SEG = true;
    bf16_t* O; int ldc; const bf16_t* GA; const bf16_t* GB; int ldg;
    static __device__ __forceinline__ float eneg(float x) { return __builtin_amdgcn_exp2f(-1.4426950408889634f * fminf(fmaxf(x, -30.f), 30.f)); }
    __device__ __forceinline__ void mid(f32x4 (&acc)[2][2][4][2], const Unit& u, int wr, int wc, int fr, int fq) const {
        const int row0 = u.pm * BM + wr * 64 + fr; const int col0 = u.pn * BM + wc * 32 + 8 * fq;
#pragma unroll
        for (int ai = 0; ai < 2; ++ai)
#pragma unroll
            for (int m = 0; m < 4; ++m) { const size_t row = (size_t)(row0 + ai * HALF + m * 16);
#pragma unroll
                for (int bj = 0; bj < 2; ++bj) { const int col = col0 + bj * HALF;
                    const u32x4 aw = *(const u32x4*)(GA + row * ldg + col), bw = *(const u32x4*)(GB + row * ldg + col);
                    const float ga[8] = {bf_lo(aw.x), bf_hi(aw.x), bf_lo(aw.y), bf_hi(aw.y), bf_lo(aw.z), bf_hi(aw.z), bf_lo(aw.w), bf_hi(aw.w)};
                    const float gb[8] = {bf_lo(bw.x), bf_hi(bw.x), bf_lo(bw.y), bf_hi(bw.y), bf_lo(bw.z), bf_hi(bw.z), bf_lo(bw.w), bf_hi(bw.w)};
                    float r[8];
#pragma unroll
                    for (int i = 0; i < 8; ++i) r[i] = (1.f + eneg(gb[i])) * __builtin_amdgcn_rcpf(1.f + eneg(ga[i]));
                    acc[ai][bj][m][0] = acc[ai][bj][m][0] * (f32x4){r[0], r[1], r[2], r[3]}; acc[ai][bj][m][1] = acc[ai][bj][m][1] * (f32x4){r[4], r[5], r[6], r[7]}; }
                asm volatile("" ::: "memory"); }
    }
    __device__ __forceinline__ void operator()(const f32x4 (&acc)[2][2][4][2], const Unit& u, int wr, int wc, int fr, int fq) const {
        const int row0 = u.pm * BM + wr * 64 + fr; const int col0 = u.pn * BM + wc * 32 + 8 * fq;
#pragma unroll
        for (int ai = 0; ai < 2; ++ai)
#pragma unroll
            for (int m = 0; m < 4; ++m) { const size_t row = (size_t)(row0 + ai * HALF + m * 16);
#pragma unroll
                for (int bj = 0; bj < 2; ++bj) { const int col = col0 + bj * HALF;
                    const u32x4 bw = *(const u32x4*)(GB + row * ldg + col);
                    const float gb[8] = {bf_lo(bw.x), bf_hi(bw.x), bf_lo(bw.y), bf_hi(bw.y), bf_lo(bw.z), bf_hi(bw.z), bf_lo(bw.w), bf_hi(bw.w)};
                    const f32x4 a0 = acc[ai][bj][m][0], a1 = acc[ai][bj][m][1];
                    float v[8] = {a0[0], a0[1], a0[2], a0[3], a1[0], a1[1], a1[2], a1[3]};
#pragma unroll
                    for (int i = 0; i < 8; ++i) v[i] *= __builtin_amdgcn_rcpf(1.f + eneg(gb[i]));
                    u32x4 w; w.x = cvt_pk_bf16(v[0], v[1]); w.y = cvt_pk_bf16(v[2], v[3]); w.z = cvt_pk_bf16(v[4], v[5]); w.w = cvt_pk_bf16(v[6], v[7]);
                    *(u32x4*)(O + row * ldc + col) = w; }
                asm volatile("" ::: "memory"); }
    }
};
}
namespace gqa {
using bf16 = __hip_bfloat16;
constexpr int   D = 128, NW = 8, QBLK = 32, KVBLK = 64;
constexpr float SCALE = 0.088388347648318440f;
constexpr float THR = 8.f;
using f32x4 = __attribute__((ext_vector_type(4))) float;
constexpr int SDEPTH = 1;
constexpr int LDQ = 7680, LDK = 256, LDO = 1024;
constexpr size_t SHM_V = KVBLK * D * 2, SHM_K = KVBLK * D * 2, SHM_ATTN = 2 * SHM_V + 2 * SHM_K + NW * 64 * 4;
using bf16x8 = __attribute__((ext_vector_type(8))) short;
using s16x4  = __attribute__((ext_vector_type(4))) short;
using f32x16 = __attribute__((ext_vector_type(16))) float;
using f32x8  = __attribute__((ext_vector_type(8))) float;
using u32x4  = __attribute__((ext_vector_type(4))) unsigned;
#define KSWZ(row, colB) ((row) * 256 + ((colB) ^ (((row) & 7) << 4)))
#define SBAR() __builtin_amdgcn_sched_barrier(0)
__device__ __forceinline__ int crow(int r, int hi) { return (r & 3) + 8 * (r >> 2) + 4 * hi; }
__device__ __forceinline__ unsigned cvtpk(float lo, float hi) {
  unsigned r; asm volatile("v_cvt_pk_bf16_f32 %0, %1, %2" : "=v"(r) : "v"(lo), "v"(hi)); return r;
}
template <typename TIn> struct Stage;
template <> struct Stage<bf16>  { using T = bf16x8;
  __device__ static __forceinline__ T ld8(const bf16* p) { return *reinterpret_cast<const bf16x8*>(p); }
  __device__ static __forceinline__ bf16x8 tobf(T x) { return x; } };
template <> struct Stage<float> { using T = f32x8;
  __device__ static __forceinline__ T ld8(const float* p) { return *reinterpret_cast<const f32x8*>(p); }
  __device__ static __forceinline__ bf16x8 tobf(T x) {
    u32x4 w = {cvtpk(x[0], x[1]), cvtpk(x[2], x[3]), cvtpk(x[4], x[5]), cvtpk(x[6], x[7])}; return *reinterpret_cast<bf16x8*>(&w); } };

__device__ __forceinline__ void partialSM(f32x16& p0, f32x16& p1, float& m_reg, float& mn, float& alpha) {
  constexpr float C = SCALE * 1.4426950408889634f;
  float pmax = p0[0]; for (int r = 1; r < 16; ++r) pmax = fmaxf(pmax, p0[r]); for (int r = 0; r < 16; ++r) pmax = fmaxf(pmax, p1[r]);
  { auto rr = __builtin_amdgcn_permlane32_swap(__float_as_uint(pmax), __float_as_uint(pmax), false, false);
    pmax = fmaxf(__uint_as_float(rr[0]), __uint_as_float(rr[1])); }
  if (__builtin_expect(__all(pmax - m_reg <= THR / SCALE), 1)) { mn = m_reg; alpha = 1.f; }
  else { mn = fmaxf(m_reg, pmax); alpha = __builtin_amdgcn_exp2f((m_reg - mn) * C); m_reg = mn; }
  float mnC = -mn * C;
  for (int r = 0; r < 16; ++r) p0[r] = fmaf(p0[r], C, mnC); for (int r = 0; r < 16; ++r) p1[r] = fmaf(p1[r], C, mnC);
  for (int r = 0; r < 16; ++r) p0[r] = __builtin_amdgcn_exp2f(p0[r]);
}
__device__ __forceinline__ void finishSM(f32x16& p0, f32x16& p1, float alpha, float& l_reg, bf16x8& pa0, bf16x8& pa1, bf16x8& pa2, bf16x8& pa3) {
  for (int r = 0; r < 16; ++r) p1[r] = __builtin_amdgcn_exp2f(p1[r]);
  float ps = 0; for (int r = 0; r < 16; ++r) ps += p0[r]; for (int r = 0; r < 16; ++r) ps += p1[r];
  { auto rr = __builtin_amdgcn_permlane32_swap(__float_as_uint(ps), __float_as_uint(ps), false, false);
    ps = __uint_as_float(rr[0]) + __uint_as_float(rr[1]); }
  l_reg = l_reg * alpha + ps;
#define PK4(P, BASE, OUT) do { unsigned a0 = cvtpk(P[BASE + 0], P[BASE + 1]), a1 = cvtpk(P[BASE + 2], P[BASE + 3]);   \
    unsigned b0 = cvtpk(P[BASE + 4], P[BASE + 5]), b1 = cvtpk(P[BASE + 6], P[BASE + 7]);                              \
    auto r0 = __builtin_amdgcn_permlane32_swap(a0, b0, false, false); auto r1 = __builtin_amdgcn_permlane32_swap(a1, b1, false, false); \
    u32x4 w = {r0[0], r1[0], r0[1], r1[1]}; OUT = *reinterpret_cast<bf16x8*>(&w); } while (0)
  PK4(p0, 0, pa0); PK4(p0, 8, pa1); PK4(p1, 0, pa2); PK4(p1, 8, pa3);
#undef PK4
}
__device__ __forceinline__ void qkt(f32x16& p0, f32x16& p1, const bf16* Ks, const bf16x8* qr, int r32, int hi) {
  p0 = f32x16{}; p1 = f32x16{};
  for (int d0 = 0; d0 < 8; ++d0) { int cb = (d0 * 16 + hi * 8) * 2;
    bf16x8 b0 = *reinterpret_cast<const bf16x8*>((const char*)Ks + KSWZ(r32, cb));
    bf16x8 b1 = *reinterpret_cast<const bf16x8*>((const char*)Ks + KSWZ(32 + r32, cb));
    p0 = __builtin_amdgcn_mfma_f32_32x32x16_bf16(b0, qr[d0], p0, 0, 0, 0);
    p1 = __builtin_amdgcn_mfma_f32_32x32x16_bf16(b1, qr[d0], p1, 0, 0, 0); }
}
__device__ __forceinline__ int v_st(int k, int c) { const int kk = (k & ~0xC) | ((k & 4) << 1) | ((k & 8) >> 1); return ((kk >> 3) * 4 + (c >> 5)) * 512 + ((kk & 7) * 32 + (c & 31)) * 2; }
__device__ __forceinline__ int v_rd_base(int lane) { return ((lane & 3) << 3) | (((lane >> 2) & 3) << 6) | (((lane >> 4) & 1) << 5) | (((lane >> 5) & 1) << 8); }
constexpr int v_rd_off(int d0, int ks, int half) { return d0 * 512 + ks * 4096 + half * 2048; }
template <int OFF> __device__ __forceinline__ s16x4 tr_read(int vb) {
  s16x4 r; asm volatile("ds_read_b64_tr_b16 %0, %1 offset:%2" : "=&v"(r) : "v"(vb), "i"(OFF) : "memory"); return r;
}
template <int D0> __device__ __forceinline__ void pv_one(f32x16& od, int vb, bf16x8 pa0, bf16x8 pa1, bf16x8 pa2, bf16x8 pa3) {
  const s16x4 l0 = tr_read<v_rd_off(D0, 0, 0)>(vb), h0 = tr_read<v_rd_off(D0, 0, 1)>(vb), l1 = tr_read<v_rd_off(D0, 1, 0)>(vb), h1 = tr_read<v_rd_off(D0, 1, 1)>(vb);
  const s16x4 l2 = tr_read<v_rd_off(D0, 2, 0)>(vb), h2 = tr_read<v_rd_off(D0, 2, 1)>(vb), l3 = tr_read<v_rd_off(D0, 3, 0)>(vb), h3 = tr_read<v_rd_off(D0, 3, 1)>(vb);
  asm volatile("s_waitcnt lgkmcnt(0)" ::: "memory"); SBAR();
#define PK(L, H) (bf16x8){L[0], L[1], L[2], L[3], H[0], H[1], H[2], H[3]}
  od = __builtin_amdgcn_mfma_f32_32x32x16_bf16(pa0, PK(l0, h0), od, 0, 0, 0);
  od = __builtin_amdgcn_mfma_f32_32x32x16_bf16(pa1, PK(l1, h1), od, 0, 0, 0);
  od = __builtin_amdgcn_mfma_f32_32x32x16_bf16(pa2, PK(l2, h2), od, 0, 0, 0);
  od = __builtin_amdgcn_mfma_f32_32x32x16_bf16(pa3, PK(l3, h3), od, 0, 0, 0);
#undef PK
}
__device__ __forceinline__ void pv_d0(f32x16* o, int vb, bf16x8 pa0, bf16x8 pa1, bf16x8 pa2, bf16x8 pa3) {
  pv_one<0>(o[0], vb, pa0, pa1, pa2, pa3); pv_one<1>(o[1], vb, pa0, pa1, pa2, pa3); pv_one<2>(o[2], vb, pa0, pa1, pa2, pa3); pv_one<3>(o[3], vb, pa0, pa1, pa2, pa3);
}

template <typename TQ>
__device__ __forceinline__ void attn_dense_body(const TQ* Qb, const bf16* __restrict__ Kh, const bf16* __restrict__ Vh,
                                                bf16* Ob, int seq, char* lds, const float* __restrict__ qgain, const float* __restrict__ tab, int tok0) {
  using St = Stage<bf16>; using SQ = Stage<TQ>;
  int tid_l = threadIdx.x; asm volatile("" : "+v"(tid_l));
  const int tid = tid_l, wid = tid >> 6, lane = tid & 63, r32 = lane & 31, hi = lane >> 5;
  bf16* V_lds = (bf16*)lds; bf16* K_lds = (bf16*)(lds + 2 * SHM_V);
  float* ws = (float*)(lds + 2 * SHM_V + 2 * SHM_K) + wid * 64; float* li_l = ws; float* al_l = ws + 32;
  float m_reg = -1e30f, l_reg = 0; f32x16 o[4] = {}; bf16x8 qr[8];
  const TQ* Qw = Qb + (long)(wid * QBLK + r32) * LDQ + hi * 8;
  {
    float y[8][8]; float ss = 0.f;
#pragma unroll
    for (int d0 = 0; d0 < 8; ++d0) { const u32x4 w = *reinterpret_cast<const u32x4*>(Qw + d0 * 16);
      y[d0][0] = __uint_as_float(w.x << 16); y[d0][1] = __uint_as_float(w.x & 0xffff0000u); y[d0][2] = __uint_as_float(w.y << 16); y[d0][3] = __uint_as_float(w.y & 0xffff0000u);
      y[d0][4] = __uint_as_float(w.z << 16); y[d0][5] = __uint_as_float(w.z & 0xffff0000u); y[d0][6] = __uint_as_float(w.w << 16); y[d0][7] = __uint_as_float(w.w & 0xffff0000u);
#pragma unroll
      for (int j = 0; j < 8; ++j) ss += y[d0][j] * y[d0][j]; }
    { auto rr = __builtin_amdgcn_permlane32_swap(__float_as_uint(ss), __float_as_uint(ss), false, false); ss = __uint_as_float(rr[0]) + __uint_as_float(rr[1]); }
    const float rstd = __builtin_amdgcn_rsqf(ss * (1.f / 128.f) + 1e-6f);
#pragma unroll
    for (int d0 = 0; d0 < 8; ++d0) { const f32x4 ga = *reinterpret_cast<const f32x4*>(qgain + d0 * 16 + hi * 8), gb = *reinterpret_cast<const f32x4*>(qgain + d0 * 16 + hi * 8 + 4);
      y[d0][0] *= rstd * ga[0]; y[d0][1] *= rstd * ga[1]; y[d0][2] *= rstd * ga[2]; y[d0][3] *= rstd * ga[3]; y[d0][4] *= rstd * gb[0]; y[d0][5] *= rstd * gb[1]; y[d0][6] *= rstd * gb[2]; y[d0][7] *= rstd * gb[3]; }
    const int tok = tok0 + wid * QBLK + r32, prow = (tok >> 6) & 63, pcol = tok & 63;
#pragma unroll
    for (int hf = 0; hf < 2; ++hf) { const int pos = hf ? pcol : prow;
#pragma unroll
      for (int db = 0; db < 2; ++db) { const float* tp = tab + (pos * 32 + db * 16 + hi * 8) * 2;
        const f32x4 t0 = *reinterpret_cast<const f32x4*>(tp), t1 = *reinterpret_cast<const f32x4*>(tp + 4), t2 = *reinterpret_cast<const f32x4*>(tp + 8), t3 = *reinterpret_cast<const f32x4*>(tp + 12);
        const float cs[8] = {t0[0], t0[2], t1[0], t1[2], t2[0], t2[2], t3[0], t3[2]}, sn[8] = {t0[1], t0[3], t1[1], t1[3], t2[1], t2[3], t3[1], t3[3]};
#pragma unroll
        for (int j = 0; j < 8; ++j) { const float x1 = y[hf * 4 + db][j], x2 = y[hf * 4 + db + 2][j]; y[hf * 4 + db][j] = x1 * cs[j] - x2 * sn[j]; y[hf * 4 + db + 2][j] = x2 * cs[j] + x1 * sn[j]; } } }
#pragma unroll
    for (int d0 = 0; d0 < 8; ++d0) { u32x4 w = {cvtpk(y[d0][0], y[d0][1]), cvtpk(y[d0][2], y[d0][3]), cvtpk(y[d0][4], y[d0][5]), cvtpk(y[d0][6], y[d0][7])}; qr[d0] = *reinterpret_cast<bf16x8*>(&w); }
  }
  const int sr = tid >> 4, sc = (tid & 15) * 8, vst0 = v_st(sr, sc), vst1 = v_st(32 + sr, sc);
  const int vb0 = (int)(uintptr_t)V_lds + v_rd_base(lane);
  struct { typename St::T vs0, vs1, ks0, ks1; } sr_[SDEPTH];
  const unsigned voff0 = (unsigned)(sr * LDK + sc) * 2u, voff1 = voff0 + 32u * LDK * 2u;
#define SLOAD(i, k0) do { const char* vb_ = (const char*)Vh + (size_t)(k0) * (LDK * 2); const char* kb_ = (const char*)Kh + (size_t)(k0) * (LDK * 2); \
    sr_[i].vs0 = *(const bf16x8*)(vb_ + voff0); sr_[i].vs1 = *(const bf16x8*)(vb_ + voff1); \
    sr_[i].ks0 = *(const bf16x8*)(kb_ + voff0); sr_[i].ks1 = *(const bf16x8*)(kb_ + voff1); } while (0)
#define SWRITE(b, i) do { *(bf16x8*)((char*)V_lds + (b) * SHM_V + vst0) = St::tobf(sr_[i].vs0);          \
    *(bf16x8*)((char*)V_lds + (b) * SHM_V + vst1) = St::tobf(sr_[i].vs1); int kc = sc * 2;               \
    *(bf16x8*)((char*)K_lds + (b) * SHM_K + KSWZ(sr, kc)) = St::tobf(sr_[i].ks0);                       \
    *(bf16x8*)((char*)K_lds + (b) * SHM_K + KSWZ(32 + sr, kc)) = St::tobf(sr_[i].ks1); } while (0)
#define SWAIT() do { if constexpr (SDEPTH == 2) asm volatile("s_waitcnt vmcnt(4)" ::: "memory"); else asm volatile("s_waitcnt vmcnt(0)" ::: "memory"); } while (0)
#define RESC(a) do { if (__any((a) < 1.f)) { if (hi == 0) al_l[r32] = (a); asm volatile("s_waitcnt lgkmcnt(0)" ::: "memory"); \
    for (int d = 0; d < 4; ++d) for (int r = 0; r < 16; ++r) o[d][r] *= al_l[crow(r, hi)]; } } while (0)
  f32x16 pA0, pA1, pB0, pB1; float mnA, mnB, alA, alB; bf16x8 pa0, pa1, pa2, pa3; const int NT = seq / KVBLK;
  constexpr int SE = 0, SO = SDEPTH - 1;
  SLOAD(SE, 0); asm volatile("s_waitcnt vmcnt(0)" ::: "memory"); SWRITE(0, SE); __syncthreads();
  qkt(pA0, pA1, K_lds, qr, r32, hi); partialSM(pA0, pA1, m_reg, mnA, alA);
  SLOAD(SO, KVBLK); if constexpr (SDEPTH == 2) { if (2 < NT) SLOAD(SE, 2 * KVBLK); }
  SWAIT(); SWRITE(1, SO); __syncthreads();
  for (int j = 1; j + 1 < NT; j += 2) {
    SBAR(); qkt(pB0, pB1, (bf16*)((char*)K_lds + SHM_K), qr, r32, hi);
    finishSM(pA0, pA1, alA, l_reg, pa0, pa1, pa2, pa3); SBAR();
    SLOAD(SO, (j + SDEPTH) * KVBLK); SBAR();
    pv_d0(o, vb0, pa0, pa1, pa2, pa3); partialSM(pB0, pB1, m_reg, mnB, alB);
    __syncthreads(); SWAIT(); SWRITE(0, SE);
    RESC(alB); __syncthreads();
    SBAR(); qkt(pA0, pA1, K_lds, qr, r32, hi);
    finishSM(pB0, pB1, alB, l_reg, pa0, pa1, pa2, pa3); SBAR();
    if (SDEPTH == 1 || j + 3 < NT) SLOAD(SE, (j + 1 + SDEPTH) * KVBLK); SBAR();
    pv_d0(o, vb0 + (int)SHM_V, pa0, pa1, pa2, pa3); partialSM(pA0, pA1, m_reg, mnA, alA);
    __syncthreads(); SWAIT(); SWRITE(1, SO);
    RESC(alA); __syncthreads();
  }
  SBAR(); qkt(pB0, pB1, (bf16*)((char*)K_lds + SHM_K), qr, r32, hi);
  finishSM(pA0, pA1, alA, l_reg, pa0, pa1, pa2, pa3); SBAR();
  pv_d0(o, vb0, pa0, pa1, pa2, pa3); partialSM(pB0, pB1, m_reg, mnB, alB);
  __syncthreads(); RESC(alB);
  finishSM(pB0, pB1, alB, l_reg, pa0, pa1, pa2, pa3); SBAR();
  pv_d0(o, vb0 + (int)SHM_V, pa0, pa1, pa2, pa3);
  if (hi == 0) li_l[r32] = l_reg; asm volatile("s_waitcnt lgkmcnt(0)" ::: "memory");
  float rli[16];
#pragma unroll
  for (int r = 0; r < 16; ++r) rli[r] = __builtin_amdgcn_rcpf(li_l[crow(r, hi)]);
  bf16* Ow = Ob + (long)(wid * QBLK) * LDO;
#pragma unroll
  for (int r = 0; r < 16; ++r) { int orow = crow(r, hi);
    for (int d0 = 0; d0 < 4; ++d0) Ow[(long)orow * LDO + d0 * 32 + r32] = __builtin_bit_cast(bf16, (unsigned short)(cvtpk(o[d0][r] * rli[r], 0.f) & 0xffffu)); }
#undef SLOAD
#undef SWRITE
#undef SWAIT
#undef RESC
}
#undef KSWZ
#undef SBAR
}
#define LAS __attribute__((address_space(3)))
typedef unsigned short bf16_t;
typedef float f32x4 __attribute__((ext_vector_type(4)));
typedef unsigned u32x4 __attribute__((ext_vector_type(4)));
typedef unsigned u32x2 __attribute__((ext_vector_type(2)));
typedef short bf16x8 __attribute__((ext_vector_type(8)));

constexpr int T = 49152, TP = 32768, DM = 2048, SEQ = 4096, NBATCH = 12, DFF = 8192, PLE = 256;
constexpr int PP = 7680;
constexpr int C_NAQ = 0, C_NAK = 1024, C_GQ = 2048, C_GK = 3072, C_GV = 3328, C_GA = 3584, C_GB = 5632;
constexpr float EPS = 1e-6f;
constexpr size_t MiB = 1u << 20;
constexpr size_t WS_TAB = 0, WS_WIN = 1 * MiB, WS_WNA = 35 * MiB, WS_WGQA = 39 * MiB, WS_WMIX = 43 * MiB, WS_WFF1 = 51 * MiB, WS_WFF2 = 83 * MiB,
                 WS_WPG = 115 * MiB, WS_WPP = 123 * MiB, WS_PB = 124 * MiB, WS_VT = 148 * MiB, WS_PROJ = 244 * MiB, WS_END0 = 964 * MiB;
constexpr size_t WS_Y = 244 * MiB, WS_H = 436 * MiB, WS_HID = 628 * MiB, WS_EP = 628 * MiB, WS_END = 1012 * MiB;
constexpr int LDS_BYTES = 147456;
constexpr int NTHREADS = 512;

struct Params {
    const float* x_p; const float* x_s; const float* p_p; const float* p_s;
    const float* ln_mix_pre; const float* w_in; const float* q_norm; const float* k_norm; const float* na_rpb;
    const float* w_na; const float* w_gqa; const float* w_mix; const float* ln_mix_post; const float* ln_mlp_pre;
    const float* w_ff1; const float* w_ff2; const float* ln_mlp_post; const float* ln_ple_pre; const float* w_ple_gate; const float* w_ple_proj; const float* ln_ple_post;
    float* out; unsigned char* ws;
};

__device__ __forceinline__ unsigned pk_bf16(float lo, float hi) { unsigned r; asm volatile("v_cvt_pk_bf16_f32 %0, %1, %2" : "=v"(r) : "v"(lo), "v"(hi)); return r; }
__device__ __forceinline__ float bflo(unsigned u) { return __uint_as_float(u << 16); }
__device__ __forceinline__ float bfhi(unsigned u) { return __uint_as_float(u & 0xffff0000u); }
__device__ __forceinline__ float wave_sum(float v) {
#pragma unroll
    for (int o = 1; o < 64; o <<= 1) v += __shfl_xor(v, o);
    return v;
}

__device__ __forceinline__ void transpose_item(const float* W, int K, int N, bf16_t* WT, int k0, int n0, int drow0, LAS float* scr, int lane, const float* gk) {
#pragma unroll 8
    for (int i = 0; i < 32; ++i) { const int kk = 2 * i + (lane >> 5); scr[kk * 33 + (lane & 31)] = W[(size_t)(k0 + kk) * N + n0 + (lane & 31)] * (gk ? gk[k0 + kk] : 1.f); }
    asm volatile("s_waitcnt lgkmcnt(0)" ::: "memory");
    const int c = lane & 7;
#pragma unroll
    for (int j = 0; j < 4; ++j) { const int n = (lane >> 3) + 8 * j; const LAS float* s = scr + (8 * c) * 33 + n;
        u32x4 o; o.x = pk_bf16(s[0 * 33], s[1 * 33]); o.y = pk_bf16(s[2 * 33], s[3 * 33]); o.z = pk_bf16(s[4 * 33], s[5 * 33]); o.w = pk_bf16(s[6 * 33], s[7 * 33]);
        *(u32x4*)(WT + (size_t)(drow0 + n) * K + k0 + 8 * c) = o; }
    asm volatile("s_waitcnt lgkmcnt(0)" ::: "memory");
}
__device__ __forceinline__ bool transpose_mat(int& r, const float* W, int K, int N, bf16_t* WT, LAS float* scr, int lane, bool remap_in, const float* gk = nullptr) {
    const int nblk = N / 32, items = (K / 64) * nblk;
    if (r >= items) { r -= items; return false; }
    const int kb = r / nblk, nb = r % nblk, n0 = nb * 32;
    int d0 = n0;
    if (remap_in) d0 = (n0 < 2048) ? n0 : (n0 < 3072 ? n0 - 2048 + 7680 : n0 - 1024);
    transpose_item(W, K, N, WT, kb * 64, n0, d0, scr, lane, gk);
    return true;
}

__device__ __forceinline__ const float* xrow_in(const Params& P, int m) { return m < TP ? P.x_p + (size_t)m * DM : P.x_s + (size_t)(m - TP) * DM; }

template <int MODE>
__device__ __forceinline__ void row_pass(const Params& P, const bf16_t* Y, const bf16_t* XS, bf16_t* XB, float* RS, const float* g1, int gw, int ngw) {
    int tid_l = threadIdx.x; asm volatile("" : "+v"(tid_l)); const int lane = tid_l & 63;
    for (int m0 = gw; m0 < T; m0 += 2 * ngw) {
        const int mr[2] = {m0, min(m0 + ngw, T - 1)}; const bool ok1 = (m0 + ngw < T);
        float x[2][4][8], y[2][4][8];
#pragma unroll
        for (int r = 0; r < 2; ++r) { const int mm = mr[r];
            if (MODE == 0 || MODE == 1) { const float* base = xrow_in(P, mm);
#pragma unroll
                for (int j = 0; j < 4; ++j) { const f32x4 a = *(const f32x4*)(base + j * 512 + lane * 8), b = *(const f32x4*)(base + j * 512 + lane * 8 + 4);
                    x[r][j][0] = a[0]; x[r][j][1] = a[1]; x[r][j][2] = a[2]; x[r][j][3] = a[3]; x[r][j][4] = b[0]; x[r][j][5] = b[1]; x[r][j][6] = b[2]; x[r][j][7] = b[3]; }
            } else {
#pragma unroll
                for (int j = 0; j < 4; ++j) { const u32x4 w = *(const u32x4*)(XS + (size_t)mm * DM + j * 512 + lane * 8);
                    x[r][j][0] = bflo(w.x); x[r][j][1] = bfhi(w.x); x[r][j][2] = bflo(w.y); x[r][j][3] = bfhi(w.y); x[r][j][4] = bflo(w.z); x[r][j][5] = bfhi(w.z); x[r][j][6] = bflo(w.w); x[r][j][7] = bfhi(w.w); }
            }
            if (MODE != 0) {
#pragma unroll
                for (int j = 0; j < 4; ++j) { const u32x4 w = *(const u32x4*)(Y + (size_t)mm * DM + j * 512 + lane * 8);
                    y[r][j][0] = bflo(w.x); y[r][j][1] = bfhi(w.x); y[r][j][2] = bflo(w.y); y[r][j][3] = bfhi(w.y); y[r][j][4] = bflo(w.z); y[r][j][5] = bfhi(w.z); y[r][j][6] = bflo(w.w); y[r][j][7] = bfhi(w.w); }
            }
        }
#pragma unroll
        for (int r = 0; r < 2; ++r) { const int mm = mr[r]; const bool ok = (r == 0) || ok1;
            if (MODE != 0) {
                float ss = 0.f;
#pragma unroll
                for (int j = 0; j < 4; ++j)
#pragma unroll
                    for (int i = 0; i < 8; ++i) ss += y[r][j][i] * y[r][j][i];
                const float rstd = __builtin_amdgcn_rsqf(wave_sum(ss) * (1.f / DM) + EPS);
#pragma unroll
                for (int j = 0; j < 4; ++j) { const f32x4 ga = *(const f32x4*)(g1 + j * 512 + lane * 8), gb = *(const f32x4*)(g1 + j * 512 + lane * 8 + 4);
                    const float gg[8] = {ga[0], ga[1], ga[2], ga[3], gb[0], gb[1], gb[2], gb[3]};
#pragma unroll
                    for (int i = 0; i < 8; ++i) x[r][j][i] += y[r][j][i] * rstd * gg[i]; }
            }
            if (MODE == 2) {
                if (ok) {
#pragma unroll
                    for (int j = 0; j < 4; ++j) { float* o = P.out + (size_t)mm * DM + j * 512 + lane * 8;
                        *(f32x4*)o = (f32x4){x[r][j][0], x[r][j][1], x[r][j][2], x[r][j][3]}; *(f32x4*)(o + 4) = (f32x4){x[r][j][4], x[r][j][5], x[r][j][6], x[r][j][7]}; } }
            } else {
                float ss = 0.f;
#pragma unroll
                for (int j = 0; j < 4; ++j)
#pragma unroll
                    for (int i = 0; i < 8; ++i) ss += x[r][j][i] * x[r][j][i];
                const float rstd = __builtin_amdgcn_rsqf(wave_sum(ss) * (1.f / DM) + EPS);
                if (ok) {
                    if (MODE == 0) {
#pragma unroll
                        for (int j = 0; j < 4; ++j) { const f32x4 ga = *(const f32x4*)(g1 + j * 512 + lane * 8), gb = *(const f32x4*)(g1 + j * 512 + lane * 8 + 4);
                            u32x4 w; w.x = pk_bf16(x[r][j][0] * rstd * ga[0], x[r][j][1] * rstd * ga[1]); w.y = pk_bf16(x[r][j][2] * rstd * ga[2], x[r][j][3] * rstd * ga[3]);
                            w.z = pk_bf16(x[r][j][4] * rstd * gb[0], x[r][j][5] * rstd * gb[1]); w.w = pk_bf16(x[r][j][6] * rstd * gb[2], x[r][j][7] * rstd * gb[3]);
                            *(u32x4*)(XB + (size_t)mm * DM + j * 512 + lane * 8) = w; }
                    } else {
                        if (lane == 0) RS[mm] = rstd;
#pragma unroll
                        for (int j = 0; j < 4; ++j) { u32x4 w; w.x = pk_bf16(x[r][j][0], x[r][j][1]); w.y = pk_bf16(x[r][j][2], x[r][j][3]); w.z = pk_bf16(x[r][j][4], x[r][j][5]); w.w = pk_bf16(x[r][j][6], x[r][j][7]);
                            *(u32x4*)(XB + (size_t)mm * DM + j * 512 + lane * 8) = w; }
                    }
                }
            }
        }
    }
}

__device__ __forceinline__ void qk_norm_rope(const Params& P, const bf16_t* PROJ, bf16_t* QC, bf16_t* KC, bf16_t* VC, const LAS float* tabl, int gw, int ngw, int lane_in) {
    (void)lane_in; int tid_l = threadIdx.x; asm volatile("" : "+v"(tid_l)); const int lane = tid_l & 63;
    const int hd4 = lane >> 4, c = lane & 15, half = c >> 3, isx2 = (c >> 2) & 1, i0 = (c & 3) * 8;
    float gq[8], gk[8];
#pragma unroll
    for (int i = 0; i < 8; ++i) { gq[i] = P.q_norm[c * 8 + i]; gk[i] = P.k_norm[c * 8 + i]; }
    for (int it0 = gw * 4; it0 < T; it0 += ngw * 4) {
        u32x4 wv[4];
#pragma unroll
        for (int k = 0; k < 4; ++k) { const int t = it0 + k, grp = 2;
            wv[k] = *(const u32x4*)(PROJ + (size_t)t * PP + C_GQ + (grp * 4 + hd4) * 128 + c * 8); }
#pragma unroll
        for (int k = 0; k < 4; ++k) {
            const int t = it0 + k, grp = 2;
            const u32x4 w = wv[k];
            float x[8] = {bflo(w.x), bfhi(w.x), bflo(w.y), bfhi(w.y), bflo(w.z), bfhi(w.z), bflo(w.w), bfhi(w.w)};
            float ss = 0.f;
#pragma unroll
            for (int i = 0; i < 8; ++i) ss += x[i] * x[i];
            ss += __shfl_xor(ss, 1); ss += __shfl_xor(ss, 2); ss += __shfl_xor(ss, 4); ss += __shfl_xor(ss, 8);
            const float rstd = __builtin_amdgcn_rsqf(ss * (1.f / 128.f) + EPS);
            const int sq = t & (SEQ - 1), pos = half ? (sq & 63) : (sq >> 6);
            const LAS float* tp = tabl + (pos * 32 + i0) * 2;
            float o[8];
#pragma unroll
            for (int i = 0; i < 8; ++i) { const float y = x[i] * rstd * (grp < 2 ? gq[i] : gk[i]); const float yp = __shfl_xor(y, 4);
                const float cs = tp[2 * i], sn = tp[2 * i + 1]; o[i] = isx2 ? (y * cs + yp * sn) : (y * cs - yp * sn); }
            u32x4 r; r.x = pk_bf16(o[0], o[1]); r.y = pk_bf16(o[2], o[3]); r.z = pk_bf16(o[4], o[5]); r.w = pk_bf16(o[6], o[7]);
            bf16_t* dst;
            if (grp < 2) dst = QC + (size_t)t * 1024 + (grp * 4 + hd4) * 128 + c * 8;
            else if (hd4 < 2) dst = KC + (size_t)t * 256 + hd4 * 128 + c * 8;
            else { dst = VC + (size_t)t * 256 + (hd4 - 2) * 128 + c * 8; r = w; }
            *(u32x4*)dst = r;
        }
    }
}

namespace na {
constexpr int KROW = 272, VROW = 144, VOFF = 64 * KROW, BUF = 36864, RPB_OFF = 2 * BUF, NA_LDS_END = RPB_OFF + 16384;
__device__ __forceinline__ void na_phase(const bf16_t* PROJ, const bf16_t* VT, const float* rpb, bf16_t* OUT, int opitch, int vcu, int G, LAS unsigned char* lds) {
    const int NU = NBATCH * 8 * 16, per = (NU + G - 1) / G;
    const bool xmap = (G == 256);
    const int ub = vcu * per, nun = xmap ? 6 : max(min(ub + per, NU) - ub, 0);
#define NA_UNIT(i) (xmap ? ((((vcu >> 5) * 12 + 2 * (i) + ((vcu & 31) >> 4)) << 4) + (vcu & 15)) : (ub + (i)))
    int tid_l = threadIdx.x; asm volatile("" : "+v"(tid_l));
    const int tid = tid_l, w = __builtin_amdgcn_readfirstlane(tid >> 6), lane = tid & 63, l15 = lane & 15, g = lane >> 4;
    const int qr = w >> 1, ch = w & 1;
    LAS float* rp = (LAS float*)(lds + RPB_OFF);
    for (int i = tid; i < 8 * 15 * 32; i += NTHREADS) { const int c31 = i & 31, hr = i >> 5; rp[i] = (c31 < 31) ? rpb[hr * 31 + c31] * 1.4426950408889634f : -1e30f; }
    if (nun <= 0) return;
    unsigned boff[2][8];
#pragma unroll
    for (int c2 = 0; c2 < 2; ++c2) { const int qc0 = 16 * (2 * ch + c2), cb = min(max(qc0 - 8, 0), 32), qcol = qc0 + l15, cs = min(max(qcol - 8, 0), 48);
#pragma unroll
        for (int e = 0; e < 8; ++e) { const int kc = cb + (e >> 2) * 16 + 4 * g + (e & 3); boff[c2][e] = ((kc >= cs) && (kc < cs + 16)) ? (unsigned)(kc - qcol + 15) * 4u : 124u; } }
    u32x4 st[2][4];
    unsigned koff[2], klds[2], vlds[2];
#pragma unroll
    for (int i_ = 0; i_ < 2; ++i_) { const int c_ = tid + 512 * i_;
        koff[i_] = (unsigned)((c_ >> 4) * PP + (c_ & 15) * 8) * 2u; klds[i_] = (unsigned)((c_ >> 4) * KROW + (c_ & 15) * 16);
        vlds[i_] = (unsigned)(VOFF + (c_ >> 3) * VROW + (c_ & 7) * 16); }
#define NA_DEC(uu) const int pr_ = (uu) >> 4, r0_ = 4 * ((uu) & 15), b_ = pr_ >> 3, hd_ = pr_ & 7, kr0_ = min(max(r0_ - 4, 0), 56), n_ = min(max(r0_ - 1, 0), 56) - kr0_ + 8
#define NA_LOADT(set, uu, t) do { NA_DEC(uu); { const int kr_ = min(kr0_ + (t), 63); (void)n_;     \
        const char* kb_ = (const char*)(PROJ + ((size_t)b_ * SEQ + (size_t)kr_ * 64) * PP + C_NAK + hd_ * 128); \
        const char* vb_ = (const char*)(VT + ((((size_t)b_ * 64 + kr_) * 8 + hd_) * 128) * 64); \
        st[set][0] = *(const u32x4*)(kb_ + koff[0]); st[set][1] = *(const u32x4*)(kb_ + koff[1]); \
        st[set][2] = *(const u32x4*)(vb_ + (unsigned)tid * 16u); st[set][3] = *(const u32x4*)(vb_ + (unsigned)(tid + 512) * 16u); } } while (0)
#define NA_WRITET(set, t) do { LAS unsigned char* bp_ = lds + ((t) & 1) * BUF; \
        *(LAS u32x4*)(bp_ + klds[0]) = st[set][0]; *(LAS u32x4*)(bp_ + klds[1]) = st[set][1]; *(LAS u32x4*)(bp_ + vlds[0]) = st[set][2]; *(LAS u32x4*)(bp_ + vlds[1]) = st[set][3]; } while (0)
    { const int u0 = NA_UNIT(0); NA_LOADT(0, u0, 0); NA_LOADT(1, u0, 1); }
    const float scale = 0.088388347648318440f, L2E = 1.4426950408889634f;
    for (int ui = 0; ui < nun; ++ui) {
        const bool has_next = (ui + 1 < nun);
        const int u = NA_UNIT(ui), un = has_next ? NA_UNIT(ui + 1) : u;
        const int pr = u >> 4, r0 = 4 * (u & 15), b = pr >> 3, head = pr & 7, kr0 = min(max(r0 - 4, 0), 56), n = min(max(r0 - 1, 0), 56) - kr0 + 8;
        const int r = r0 + qr, rsw = min(max(r - 4, 0), 56);
        const size_t tokq = (size_t)b * SEQ + r * 64;
        bf16x8 qf[2][4];
#pragma unroll
        for (int c2 = 0; c2 < 2; ++c2) { const bf16_t* qp = PROJ + (tokq + 16 * (2 * ch + c2) + l15) * PP + C_NAQ + head * 128 + 8 * g;
#pragma unroll
            for (int dc = 0; dc < 4; ++dc) qf[c2][dc] = *(const bf16x8*)(qp + dc * 32); }
#pragma unroll
        for (int c2 = 0; c2 < 2; ++c2)
#pragma unroll
            for (int dc = 0; dc < 4; ++dc) asm volatile("" : "+v"(qf[c2][dc]));
        float mrun[2] = {-1e30f, -1e30f}, lrun[2] = {0.f, 0.f};
        f32x4 O[2][8];
#pragma unroll
        for (int c2 = 0; c2 < 2; ++c2)
#pragma unroll
            for (int db = 0; db < 8; ++db) O[c2][db] = (f32x4){0.f, 0.f, 0.f, 0.f};
        const LAS unsigned char* rph = (const LAS unsigned char*)(rp + head * 480);
#pragma unroll
        for (int t = 0; t < 12; ++t) {
            NA_WRITET(t % 2, t);
            if (t + 2 < 12) NA_LOADT(t % 2, u, t + 2); else NA_LOADT(t % 2, un, t + 2 - 12);
            __syncthreads();
            const int kr = kr0 + t;
            if (kr >= rsw && kr < rsw + 8) {
                const LAS unsigned char* bp = lds + (t & 1) * BUF;
                const LAS unsigned char* brow = rph + (kr - r + 7) * 128;
                float bias[2][8]; f32x4 S[2][2]; float sv[2][8];
#pragma unroll
                for (int c2 = 0; c2 < 2; ++c2)
#pragma unroll
                    for (int e = 0; e < 8; ++e) bias[c2][e] = *(const LAS float*)(brow + boff[c2][e]);
#pragma unroll
                for (int c2 = 0; c2 < 2; ++c2) {
                    const int cb = min(max(16 * (2 * ch + c2) - 8, 0), 32);
                    const LAS unsigned char* kp = bp + (cb + l15) * KROW + 16 * g;
                    bf16x8 ka[2][4];
#pragma unroll
                    for (int kb = 0; kb < 2; ++kb)
#pragma unroll
                        for (int dc = 0; dc < 4; ++dc) ka[kb][dc] = *(const LAS bf16x8*)(kp + kb * 16 * KROW + dc * 64);
                    S[c2][0] = (f32x4){0.f, 0.f, 0.f, 0.f}; S[c2][1] = (f32x4){0.f, 0.f, 0.f, 0.f};
#pragma unroll
                    for (int dc = 0; dc < 4; ++dc)
#pragma unroll
                        for (int kb = 0; kb < 2; ++kb) S[c2][kb] = __builtin_amdgcn_mfma_f32_16x16x32_bf16(ka[kb][dc], qf[c2][dc], S[c2][kb], 0, 0, 0);
                }
                float tml[2];
#pragma unroll
                for (int c2 = 0; c2 < 2; ++c2) { float tm = -1e30f;
#pragma unroll
                    for (int e = 0; e < 8; ++e) { sv[c2][e] = fmaf(S[c2][e >> 2][e & 3], scale * L2E, bias[c2][e]); tm = fmaxf(tm, sv[c2][e]); }
                    tml[c2] = tm; }
                if (__any(tml[0] > mrun[0] + 40.f || tml[1] > mrun[1] + 40.f)) {
#pragma unroll
                    for (int c2 = 0; c2 < 2; ++c2) { float tm = tml[c2]; tm = fmaxf(tm, __shfl_xor(tm, 16)); tm = fmaxf(tm, __shfl_xor(tm, 32));
                        const float mn = fmaxf(mrun[c2], tm), alpha = __builtin_amdgcn_exp2f(mrun[c2] - mn);
                        mrun[c2] = mn; lrun[c2] *= alpha;
#pragma unroll
                        for (int db = 0; db < 8; ++db) O[c2][db] = O[c2][db] * alpha; }
                }
#pragma unroll
                for (int c2 = 0; c2 < 2; ++c2) { float ps = 0.f;
#pragma unroll
                    for (int e = 0; e < 8; ++e) { const float p = __builtin_amdgcn_exp2f(sv[c2][e] - mrun[c2]); sv[c2][e] = p; ps += p; }
                    lrun[c2] += ps; }
#pragma unroll
                for (int c2 = 0; c2 < 2; ++c2) {
                    const int cb = min(max(16 * (2 * ch + c2) - 8, 0), 32);
                    u32x4 pw; pw.x = pk_bf16(sv[c2][0], sv[c2][1]); pw.y = pk_bf16(sv[c2][2], sv[c2][3]); pw.z = pk_bf16(sv[c2][4], sv[c2][5]); pw.w = pk_bf16(sv[c2][6], sv[c2][7]);
                    const bf16x8 pj = __builtin_bit_cast(bf16x8, pw);
                    const LAS unsigned char* vp = bp + VOFF + l15 * VROW + (cb + 4 * g) * 2;
#pragma unroll
                    for (int dh = 0; dh < 2; ++dh) { u32x2 vlo[4], vhi[4];
#pragma unroll
                        for (int d4 = 0; d4 < 4; ++d4) { vlo[d4] = *(const LAS u32x2*)(vp + (dh * 4 + d4) * 16 * VROW); vhi[d4] = *(const LAS u32x2*)(vp + (dh * 4 + d4) * 16 * VROW + 32); }
#pragma unroll
                        for (int d4 = 0; d4 < 4; ++d4) { const u32x4 aw = {vlo[d4].x, vlo[d4].y, vhi[d4].x, vhi[d4].y};
                            O[c2][dh * 4 + d4] = __builtin_amdgcn_mfma_f32_16x16x32_bf16(__builtin_bit_cast(bf16x8, aw), pj, O[c2][dh * 4 + d4], 0, 0, 0); } }
                }
            }
        }
#pragma unroll
        for (int c2 = 0; c2 < 2; ++c2) {
            float lt = lrun[c2]; lt += __shfl_xor(lt, 16); lt += __shfl_xor(lt, 32);
            const float inv = 1.f / lt;
            bf16_t* op = OUT + (tokq + 16 * (2 * ch + c2) + l15) * opitch + head * 128 + 4 * g;
#pragma unroll
            for (int db = 0; db < 8; ++db) { u32x2 o; o.x = pk_bf16(O[c2][db][0] * inv, O[c2][db][1] * inv); o.y = pk_bf16(O[c2][db][2] * inv, O[c2][db][3] * inv); *(u32x2*)(op + db * 16) = o; }
        }
    }
#undef NA_LOADT
#undef NA_WRITET
#undef NA_DEC
#undef NA_UNIT
}
}

#define XB_TMO      128
#define XB_XCNT(j)  (256  + 64 * (j))
#define XB_XSUB(j)  (1280 + 64 * (j))
#define XB_XGEN(j)  (2304 + 64 * (j))
#define XB_TOP      3328
#define XB_TOPGEN   3392
#define XCD_BAR_WORDS 3456
#define XB_SPIN_CAP (1u << 18)

__device__ __forceinline__ unsigned xb_ld(unsigned* p)              { return __hip_atomic_load(p, __ATOMIC_RELAXED, __HIP_MEMORY_SCOPE_AGENT); }
__device__ __forceinline__ unsigned xb_add(unsigned* p, unsigned v) { return __hip_atomic_fetch_add(p, v, __ATOMIC_RELAXED, __HIP_MEMORY_SCOPE_AGENT); }
__device__ __forceinline__ unsigned xb_xcc_id() { return (unsigned)__builtin_amdgcn_s_getreg((3 << 11) | 20) & 0xFu; }
#define XB_SPIN(cond, bar) do { unsigned _sp = 0; while (cond) { __builtin_amdgcn_s_sleep(1); \
    if ((++_sp & 255u) == 0u) { if (xb_ld(&(bar)[XB_TMO])) break; if (_sp > XB_SPIN_CAP) { atomicAdd(&(bar)[XB_TMO], 1u); break; } } } } while (0)

struct XcdBarrier {
    unsigned* bar; unsigned x;
    volatile LAS unsigned* st;
};

__device__ __forceinline__ XcdBarrier xcd_barrier_post(unsigned* bar, volatile LAS unsigned* st) {
    XcdBarrier b; b.bar = bar; b.x = xb_xcc_id(); b.st = st;
    if (threadIdx.x == 0) (void)xb_add(&bar[XB_XCNT(b.x)], 1u);
    return b;
}
__device__ __forceinline__ void xcd_barrier_complete(unsigned* bar, unsigned x, unsigned& nloc, unsigned& nx) {
    const unsigned G = gridDim.x * gridDim.y * gridDim.z;
    unsigned sum, cnt, mine, sp = 0u;
    for (;;) {
        sum = 0u; cnt = 0u; mine = 0u;
#pragma unroll
        for (unsigned j = 0; j < 16; ++j) { const unsigned c = xb_ld(&bar[XB_XCNT(j)]); sum += c; cnt += (c > 0u) ? 1u : 0u; mine = (j == x) ? c : mine; }
        if (sum == G) break;
        __builtin_amdgcn_s_sleep(1);
        if ((++sp & 255u) == 0u) { if (xb_ld(&bar[XB_TMO])) break; if (sp > XB_SPIN_CAP) { atomicAdd(&bar[XB_TMO], 1u); break; } }
    }
    nloc = mine > 0u ? mine : 1u; nx = cnt > 0u ? cnt : 1u;
}

__device__ __forceinline__ void xcd_barrier(const XcdBarrier& b) {
    asm volatile("s_waitcnt vmcnt(0)" ::: "memory");
    __syncthreads();
    if (threadIdx.x == 0) {
        unsigned* bar = b.bar;
        __builtin_amdgcn_s_waitcnt(0);
        unsigned nloc = b.st[0], nx = b.st[1];
        if (nloc == 0u) { xcd_barrier_complete(bar, b.x, nloc, nx); b.st[0] = nloc; b.st[1] = nx; }
        const unsigned old = xb_add(&bar[XB_XSUB(b.x)], 1u);
        const unsigned gen = old / nloc;
        if (old + 1u == (gen + 1u) * nloc) {
            __builtin_amdgcn_fence(__ATOMIC_RELEASE, "agent");
            asm volatile("s_waitcnt vmcnt(0)" ::: "memory");
            const unsigned og = xb_add(&bar[XB_TOP], 1u);
            const unsigned tg = og / nx;
            if (og + 1u == (tg + 1u) * nx) xb_add(&bar[XB_TOPGEN], 1u);
            else XB_SPIN(xb_ld(&bar[XB_TOPGEN]) == tg, bar);
            __builtin_amdgcn_fence(__ATOMIC_ACQUIRE, "agent");
            xb_add(&bar[XB_XGEN(b.x)], 1u);
            asm volatile("s_waitcnt vmcnt(0)" ::: "memory");
        } else {
            XB_SPIN(xb_ld(&bar[XB_XGEN(b.x)]) == gen, bar);
            __builtin_amdgcn_fence(__ATOMIC_ACQUIRE, "agent");
            asm volatile("s_waitcnt vmcnt(0)" ::: "memory");
        }
    }
    __syncthreads();
}

#ifndef MK_PHASES
#define MK_PHASES 0xffff
#endif
#define PH(k) (((MK_PHASES) >> (k)) & 1)
#ifndef WGM_WIDE
#define WGM_WIDE 4
#endif
#ifndef WGM_N8
#define WGM_N8 4
#endif
#ifndef MK_SKELETON
#define MK_SKELETON 0
#endif
__global__ void __launch_bounds__(NTHREADS, 2) fwd_megakernel(Params P) {
    extern __shared__ __attribute__((aligned(16))) unsigned char lds_raw[];
    cg::grid_group grid = cg::this_grid();
    LAS unsigned char* lds = (LAS unsigned char*)lds_raw;
    const int wave = __builtin_amdgcn_readfirstlane((int)threadIdx.x >> 6);
#define tid ((int)threadIdx.x)
#define lane ((int)threadIdx.x & 63)
    const int G = gridDim.x, bid = blockIdx.x;
    const int vcu = (G % 8 == 0) ? (bid % 8) * (G / 8) + bid / 8 : bid;
    const int gw = vcu * 8 + wave, ngw = G * 8;
    unsigned char* ws = P.ws;
    if (tid < 16) ((LAS unsigned*)(lds + LDS_BYTES - 64))[tid] = 0u;
    __syncthreads();
    unsigned* BARW = (unsigned*)(ws + 512 * 1024);
    if (bid == 0) for (int i = tid; i < XCD_BAR_WORDS; i += NTHREADS) __hip_atomic_store(BARW + i, 0u, __ATOMIC_RELAXED, __HIP_MEMORY_SCOPE_AGENT);
    float* TAB = (float*)(ws + WS_TAB);
    bf16_t* WIN = (bf16_t*)(ws + WS_WIN); bf16_t* WNA = (bf16_t*)(ws + WS_WNA); bf16_t* WGQA = (bf16_t*)(ws + WS_WGQA); bf16_t* WMIX = (bf16_t*)(ws + WS_WMIX);
    bf16_t* WFF1 = (bf16_t*)(ws + WS_WFF1); bf16_t* WFF2 = (bf16_t*)(ws + WS_WFF2); bf16_t* WPG = (bf16_t*)(ws + WS_WPG); bf16_t* WPPJ = (bf16_t*)(ws + WS_WPP);
    bf16_t* PB = (bf16_t*)(ws + WS_PB); bf16_t* VT = (bf16_t*)(ws + WS_VT); bf16_t* PROJ = (bf16_t*)(ws + WS_PROJ);
    bf16_t* YB = (bf16_t*)(ws + WS_Y); bf16_t* HB = (bf16_t*)(ws + WS_H); bf16_t* HID = (bf16_t*)(ws + WS_HID); bf16_t* EP = (bf16_t*)(ws + WS_EP);
    bf16_t* XN = (bf16_t*)P.out;
    bf16_t* MG = (bf16_t*)P.out;
    bf16_t* AB = (bf16_t*)((unsigned char*)P.out + 192 * MiB);
    bf16_t* X1B = (bf16_t*)P.out;
    float* RS2 = (float*)(ws + 64 * 1024); float* RS3 = (float*)(ws + 256 * 1024);
    bf16_t* KC = (bf16_t*)(ws + 964 * MiB); bf16_t* VC = (bf16_t*)(ws + 988 * MiB); bf16_t* QC = nullptr;

    if (PH(0)) {
        for (int idx = bid * NTHREADS + tid; idx < 64 * 32; idx += G * NTHREADS) {
            const int pos = idx >> 5, i = idx & 31;
            const float freq = __builtin_amdgcn_exp2f(-(float)i * (13.287712379549449f / 32.f));
            const float rev = (float)pos * freq * 0.15915494309189535f; const float fr = rev - floorf(rev);
            TAB[idx * 2] = __builtin_amdgcn_cosf(fr); TAB[idx * 2 + 1] = __builtin_amdgcn_sinf(fr);
        }
        LAS float* scr = (LAS float*)(lds + wave * 16384);
        constexpr int NITEMS = (2048 / 64) * (8704 / 32) + 2 * (1024 / 64) * (2048 / 32) + 2 * (2048 / 64) * (2048 / 32) + (2048 / 64) * (8192 / 32) + (8192 / 64) * (2048 / 32) + (256 / 64) * (2048 / 32);
        for (int it = gw; it < NITEMS; it += ngw) {
            int r = it;
            if (transpose_mat(r, P.w_in, 2048, 8704, WIN, scr, lane, true)) continue;
            if (transpose_mat(r, P.w_na, 1024, 2048, WNA, scr, lane, false)) continue;
            if (transpose_mat(r, P.w_gqa, 1024, 2048, WGQA, scr, lane, false)) continue;
            if (transpose_mat(r, P.w_mix, 2048, 2048, WMIX, scr, lane, false)) continue;
            if (transpose_mat(r, P.w_ple_gate, 2048, 2048, WPG, scr, lane, false, P.ln_ple_pre)) continue;
            if (transpose_mat(r, P.w_ff1, 2048, 8192, WFF1, scr, lane, false, P.ln_mlp_pre)) continue;
            if (transpose_mat(r, P.w_ff2, 8192, 2048, WFF2, scr, lane, false)) continue;
            transpose_mat(r, P.w_ple_proj, 256, 2048, WPPJ, scr, lane, false);
        }
        for (size_t i = (size_t)bid * NTHREADS + tid; i < (size_t)T * PLE / 8; i += (size_t)G * NTHREADS) {
            const size_t e = i * 8; const float* src = e < (size_t)TP * PLE ? P.p_p + e : P.p_s + (e - (size_t)TP * PLE);
            const f32x4 a = *(const f32x4*)src, b = *(const f32x4*)(src + 4);
            u32x4 w; w.x = pk_bf16(a[0], a[1]); w.y = pk_bf16(a[2], a[3]); w.z = pk_bf16(b[0], b[1]); w.w = pk_bf16(b[2], b[3]);
            *(u32x4*)(PB + e) = w;
        }
        row_pass<0>(P, nullptr, nullptr, XN, nullptr, P.ln_mix_pre, gw, ngw);
    }
    grid.sync();
    XcdBarrier xbar = xcd_barrier_post(BARW, (volatile LAS unsigned*)(lds + LDS_BYTES - 64));
#if !MK_SKELETON
    if (PH(1)) {
        pg8::Gemm g{XN, WIN, T, 7680, 2048, 2048, 2048}; pg8::StaticOrder S; S.init(T, 7680, G, bid, WGM_WIDE);
        pg8::EpiX<0> E{PROJ, PP, nullptr, 0};
        pg8::gemm_phase<pg8::EpiX<0>, pg8::StaticOrder, true, true>(lds, g, S, E);
        pg8::Gemm g2{WIN + (size_t)7680 * 2048, XN, 1024, T, 2048, 2048, 2048}; pg8::StaticOrder S2; S2.init(1024, T, G, bid);
        pg8::EpiX<5> E2{VT, T, nullptr, 0};
        pg8::gemm_phase<pg8::EpiX<5>, pg8::StaticOrder, true, true>(lds, g2, S2, E2);
    }
    xcd_barrier(xbar);
    if (PH(2)) {
        LAS float* tabl = (LAS float*)(lds + 98304);
        for (int i = tid; i < 64 * 32 * 2; i += NTHREADS) tabl[i] = TAB[i];
        __syncthreads();
        qk_norm_rope(P, PROJ, QC, KC, VC, tabl, gw, ngw, lane);
        na::na_phase(PROJ, VT, P.na_rpb, AB, 1024, vcu, G, lds);
        __syncthreads();
    }
    xcd_barrier(xbar);
    if (PH(3)) {
        const int NU = NBATCH * 2 * 64;
        for (int i = 0;; ++i) {
            int u;
            if (G == 256) { if (i >= 6) break; const int x = vcu >> 5, c = vcu & 31; u = (x * 3 + (i >> 1)) * 64 + (i & 1) * 32 + c; }
            else { u = bid + i * G; if (u >= NU) break; }
            const int pair = u >> 6, uu = u & 63, b = pair >> 1, kvh = pair & 1, h = kvh * 4 + (uu >> 4), qb = uu & 15;
            const gqa::bf16* Q = (const gqa::bf16*)(PROJ + ((size_t)b * SEQ + qb * 256) * PP + C_GQ + h * 128);
            const gqa::bf16* Kp = (const gqa::bf16*)(KC + (size_t)b * SEQ * 256 + kvh * 128);
            const gqa::bf16* Vp = (const gqa::bf16*)(VC + (size_t)b * SEQ * 256 + kvh * 128);
            gqa::attn_dense_body<gqa::bf16>(Q, Kp, Vp, (gqa::bf16*)(AB + (size_t)T * 1024 + ((size_t)b * SEQ + qb * 256) * 1024 + h * 128), SEQ, (char*)lds_raw, P.q_norm, TAB, qb * 256);
            __syncthreads();
        }
    }
    xcd_barrier(xbar);
    if (PH(4)) {
        pg8::SegOrder S; S.base.init(T, DM, G, bid, WGM_N8);
        pg8::Gemm g{AB, WNA, T, DM, 1024, 1024, 1024, (size_t)T * 1024 * 2, (size_t)DM * 1024 * 2};
        pg8::EpiGate E{MG, DM, PROJ + C_GA, PROJ + C_GB, PP};
        pg8::gemm_phase<pg8::EpiGate, pg8::SegOrder, true, true>(lds, g, S, E);
    }
    xcd_barrier(xbar);
    if (PH(5)) {
        pg8::StaticOrder S; S.init(T, DM, G, bid, WGM_N8);
        pg8::Gemm g{MG, WMIX, T, DM, DM, DM, DM}; pg8::EpiX<0> E{YB, DM, nullptr, 0};
        pg8::gemm_phase<pg8::EpiX<0>, pg8::StaticOrder, true, true>(lds, g, S, E);
    }
    xcd_barrier(xbar);
    if (PH(6)) row_pass<1>(P, YB, nullptr, X1B, RS2, P.ln_mix_post, gw, ngw);
    xcd_barrier(xbar);
    if (PH(7))
#pragma unroll
    for (int half = 0; half < 2; ++half) {
        const size_t r0 = (size_t)half * (T / 2);
        {
            pg8::StaticOrder S; S.init(T / 2, DFF, G, bid, WGM_WIDE);
            pg8::Gemm g{X1B + r0 * DM, WFF1, T / 2, DFF, DM, DM, DM}; pg8::EpiX<1> E{HID, DFF, nullptr, 0, RS2 + r0};
            pg8::gemm_phase<pg8::EpiX<1>, pg8::StaticOrder, true, true>(lds, g, S, E);
        }
        xcd_barrier(xbar);
        {
            pg8::StaticOrder S; S.init(T / 2, DM, G, bid, WGM_N8);
            pg8::Gemm g{HID, WFF2, T / 2, DM, DFF, DFF, DFF}; pg8::EpiX<0> E{YB + r0 * DM, DM, nullptr, 0};
            pg8::gemm_phase<pg8::EpiX<0>, pg8::StaticOrder, true, true>(lds, g, S, E);
        }
        xcd_barrier(xbar);
    }
    if (PH(8)) row_pass<3>(P, YB, X1B, YB, RS3, P.ln_mlp_post, gw, ngw);
    xcd_barrier(xbar);
    if (PH(9)) {
        pg8::StaticOrder S; S.init(T, DM, G, bid, WGM_N8);
        pg8::Gemm g1{PB, WPPJ, T, DM, PLE, PLE, PLE}; pg8::EpiX<0> E1{EP, DM, nullptr, 0};
        pg8::gemm_phase<pg8::EpiX<0>, pg8::StaticOrder, true, true>(lds, g1, S, E1);
        pg8::Gemm g2{YB, WPG, T, DM, DM, DM, DM}; pg8::EpiX<4> E2{EP, DM, nullptr, 0, RS3};
        pg8::gemm_phase<pg8::EpiX<4>, pg8::StaticOrder, true, true>(lds, g2, S, E2);
    }
    xcd_barrier(xbar);
    if (PH(10)) row_pass<2>(P, EP, YB, nullptr, nullptr, P.ln_ple_post, gw, ngw);
#else
    for (int k = 0; k < 12; ++k) {
        for (size_t i = (size_t)bid * NTHREADS + tid; i < (size_t)T * DM / 64; i += (size_t)G * NTHREADS) P.out[i * 64 + k] = (float)k;
        xcd_barrier(xbar);
    }
#endif
}

#undef tid
#undef lane
extern "C" void kernel_launch(void* const* d_in, const int* in_sizes, int n_in, void* d_out, int out_size, void* d_ws, size_t ws_size, hipStream_t stream) {
    static int grid = 0;
    if (grid == 0) {
        if (n_in != 21 || out_size != T * DM || ws_size < WS_END) { fprintf(stderr, "kernel_launch: unexpected shapes: n_in %d out %d ws %zu (need >= %zu)\n", n_in, out_size, ws_size, (size_t)WS_END); grid = -1; return; }
        int dev = 0, cus = 0, per_cu = 0;
        if (hipGetDevice(&dev) != hipSuccess || hipDeviceGetAttribute(&cus, hipDeviceAttributeMultiprocessorCount, dev) != hipSuccess) { fprintf(stderr, "kernel_launch: device query failed\n"); grid = -1; return; }
        if (hipFuncSetAttribute((const void*)fwd_megakernel, hipFuncAttributeMaxDynamicSharedMemorySize, LDS_BYTES) != hipSuccess) { fprintf(stderr, "kernel_launch: hipFuncSetAttribute failed\n"); grid = -1; return; }
        if (hipOccupancyMaxActiveBlocksPerMultiprocessor(&per_cu, (const void*)fwd_megakernel, NTHREADS, LDS_BYTES) != hipSuccess || per_cu < 1) { fprintf(stderr, "kernel_launch: occupancy query says %d\n", per_cu); per_cu = 1; }
        (void)hipGetLastError();
        grid = cus * per_cu;
    }
    if (grid < 0) return;
    Params p{};
    p.x_p = (const float*)d_in[0]; p.x_s = (const float*)d_in[1]; p.p_p = (const float*)d_in[2]; p.p_s = (const float*)d_in[3];
    p.ln_mix_pre = (const float*)d_in[4]; p.w_in = (const float*)d_in[5]; p.q_norm = (const float*)d_in[6]; p.k_norm = (const float*)d_in[7]; p.na_rpb = (const float*)d_in[8];
    p.w_na = (const float*)d_in[9]; p.w_gqa = (const float*)d_in[10]; p.w_mix = (const float*)d_in[11]; p.ln_mix_post = (const float*)d_in[12]; p.ln_mlp_pre = (const float*)d_in[13];
    p.w_ff1 = (const float*)d_in[14]; p.w_ff2 = (const float*)d_in[15]; p.ln_mlp_post = (const float*)d_in[16]; p.ln_ple_pre = (const float*)d_in[17];
    p.w_ple_gate = (const float*)d_in[18]; p.w_ple_proj = (const float*)d_in[19]; p.ln_ple_post = (const float*)d_in[20];
    p.out = (float*)d_out; p.ws = (unsigned char*)d_ws;
    void* args[] = {&p};
    const hipError_t e = hipLaunchCooperativeKernel((const void*)fwd_megakernel, dim3(grid), dim3(NTHREADS), args, LDS_BYTES, stream);
    if (e != hipSuccess) fprintf(stderr, "kernel_launch: cooperative launch failed: %s (grid %d)\n", hipGetErrorString(e), grid);
}
```

```cpp
#include <hip/hip_runtime.h>
#include <hip/hip_cooperative_groups.h>
#include <hip/hip_bf16.h>
#include <cstdio>
#include <cstdint>
namespace cg = cooperative_groups;
namespace pg8 {
#define PG8_LAS __attribute__((address_space(3)))
typedef unsigned short bf16_t;
typedef short bf16x8 __attribute__((ext_vector_type(8)));
typedef float f32x4 __attribute__((ext_vector_type(4)));
typedef unsigned u32x4 __attribute__((ext_vector_type(4)));
constexpr int BM = 256, BK = 64, HALF = 128, HTB = HALF * BK * 2  , STAGE_BYTES = 8 * HTB, NXCD = 8, WGM = 8;

__host__ __device__ __forceinline__ int lds_byte(int r, int c) { const int st = (r >> 4) * 2 + (c >> 5), rr = r & 15, cc = c & 31, ob = rr * 64 + cc * 2; return st * 1024 + (ob ^ (((ob >> 9) & 1) << 5)); }
__host__ __device__ __forceinline__ void stage_rc(int b, int& R, int& C) { const int st = b / 1024, sb = b % 1024, swz = sb ^ (((sb >> 9) & 1) << 5); R = (st >> 1) * 16 + swz / 64; C = (st & 1) * 32 + (swz % 64) / 2; }
__host__ __device__ __forceinline__ int perm32(int rho) { const int n = rho >> 4, i = rho & 15; return 8 * (i >> 2) + 4 * n + (i & 3); }

struct Unit { int pm, pn, seg; };
struct Gemm { const bf16_t* A; const bf16_t* Bt; int M, N, K, lda, ldb; size_t segA = 0, segB = 0; };

struct StaticOrder {
    int nM, nN, nwg, G, c, wgm;
    __host__ __device__ void init(int M, int N, int G_, int c_, int wgm_ = WGM) { nM = M / BM; nN = N / BM; nwg = nM * nN; G = G_; c = c_; wgm = wgm_; }
    __host__ __device__ bool next(int i, Unit& u) const {
        const long L = (long)i * G + c; if (L >= nwg) return false;
        int wgid = (int)L;
#if defined(PG8_ILV) && PG8_ILV
        if (nwg % (NXCD * 32) == 0 && G == NXCD * 32) wgid = ((wgid / (NXCD * 32)) * NXCD + (wgid % NXCD)) * 32 + (wgid % (NXCD * 32)) / NXCD;
        else
#endif
        { const int q = nwg / NXCD, r = nwg % NXCD, xcd = wgid % NXCD, off = wgid / NXCD; wgid = (xcd < r ? xcd * (q + 1) : r * (q + 1) + (xcd - r) * q) + off; }
        const int nig = wgm * nN, gid = wgid / nig, fm = gid * wgm, gsz = (nM - fm) < wgm ? (nM - fm) : wgm;
        u.pm = fm + ((wgid % nig) % gsz); u.pn = (wgid % nig) / gsz; u.seg = 0; return true;
    }
    __device__ __forceinline__ void a_ready(const Unit&) const {}
    __device__ __forceinline__ void done(const Unit&) const {}
};

__device__ __forceinline__ unsigned cvt_pk_bf16(float lo, float hi) { unsigned r; asm volatile("v_cvt_pk_bf16_f32 %0, %1, %2" : "=v"(r) : "v"(lo), "v"(hi)); return r; }
typedef float f32x2 __attribute__((ext_vector_type(2)));
__device__ __forceinline__ f32x2 gelu_pk(f32x2 v) {
    const f32x2 av = __builtin_elementwise_abs(v), d = av * 0.2316418882f + 1.0f;
    f32x2 t; t.x = __builtin_amdgcn_rcpf(d.x); t.y = __builtin_amdgcn_rcpf(d.y);
    f32x2 q = t * 0.5307027145f + (-0.7265760135f); q = q * t + 0.7107068705f; q = q * t + (-0.142248368f); q = q * t + 0.127414796f; q = q * t;
    const f32x2 s = (v * v) * (-0.72134752044f);
    f32x2 e; e.x = __builtin_amdgcn_exp2f(s.x); e.y = __builtin_amdgcn_exp2f(s.y);
    const f32x2 m = v * (q * e), r = v - m;
    f32x2 o; o.x = v.x < 0.f ? m.x : r.x; o.y = v.y < 0.f ? m.y : r.y; return o;
}

template <int ACT  > struct EpiBf16 {
    static constexpr bool PERM = true, AFTER_DRAIN = false; static_assert(ACT == 0 || ACT == 1, "EpiBf16: ACT is 0 (none) or 1 (gelu_pk)");
    bf16_t* O; int ldc; const float* bias; int split_cols; size_t split_stride; float scale0;
    __device__ __forceinline__ void operator()(const f32x4 (&acc)[2][2][4][2], const Unit& u, int wr, int wc, int fr, int fq) const {
        const int row0 = u.pm * BM + wr * 64 + fr; int colt = u.pn * BM; bf16_t* base = O;
        float sc = 1.f; if (split_cols) { const int t = colt / split_cols; base += (size_t)t * split_stride; colt -= t * split_cols; if (t == 0) sc = scale0; }
        const int col0 = colt + wc * 32 + 8 * fq, bcol0 = u.pn * BM + wc * 32 + 8 * fq;
        f32x4 bv[2][2];
#pragma unroll
        for (int bj = 0; bj < 2; ++bj)
#pragma unroll
            for (int n = 0; n < 2; ++n) bv[bj][n] = bias ? *(const f32x4*)(bias + bcol0 + bj * HALF + 4 * n) : (f32x4){0.f, 0.f, 0.f, 0.f};
#pragma unroll
        for (int ai = 0; ai < 2; ++ai)
#pragma unroll
            for (int m = 0; m < 4; ++m) { bf16_t* rowp = base + (size_t)(row0 + ai * HALF + m * 16) * ldc + col0;
#pragma unroll
                for (int bj = 0; bj < 2; ++bj) { f32x4 v0 = acc[ai][bj][m][0] + bv[bj][0], v1 = acc[ai][bj][m][1] + bv[bj][1];
                    if (ACT == 1) { f32x2 a = gelu_pk((f32x2){v0[0], v0[1]}), b = gelu_pk((f32x2){v0[2], v0[3]}), c = gelu_pk((f32x2){v1[0], v1[1]}), d = gelu_pk((f32x2){v1[2], v1[3]});
                        v0 = (f32x4){a.x, a.y, b.x, b.y}; v1 = (f32x4){c.x, c.y, d.x, d.y}; }
                    v0 = v0 * sc; v1 = v1 * sc; u32x4 w; w.x = cvt_pk_bf16(v0[0], v0[1]); w.y = cvt_pk_bf16(v0[2], v0[3]); w.z = cvt_pk_bf16(v1[0], v1[1]); w.w = cvt_pk_bf16(v1[2], v1[3]);
                    *(u32x4*)(rowp + bj * HALF) = w; } }
    }
};
template <class Epi, class Sched, bool ALIGN_EPI = false, bool SP2 = false>
__device__ __forceinline__ void gemm_phase(PG8_LAS unsigned char* lds, const Gemm g, const Sched& S, const Epi& E) {
    int tid_l = threadIdx.x; asm volatile("" : "+v"(tid_l));
    const int tid = tid_l, wid = __builtin_amdgcn_readfirstlane(tid >> 6), lane = tid & 63, wr = wid >> 2, wc = wid & 3, fr = lane & 15, fq = lane >> 4;
    const int K = g.K, nt = K / BK;
    unsigned voffA[2], voffB[2];
#pragma unroll
    for (int i = 0; i < 2; ++i) { int R, C; stage_rc(tid * 16 + i * 8192, R, C); const int Rb = Epi::PERM ? ((R & ~31) + perm32(R & 31)) : R;
        voffA[i] = (unsigned)(R * g.lda + C) * 2u; voffB[i] = (unsigned)(Rb * g.ldb + C) * 2u; }
    const size_t kstep = (size_t)(BK * 2);
    const size_t hstepA = (size_t)HALF * g.lda * 2, hstepB = (size_t)HALF * g.ldb * 2;
    const size_t tstepA = 2 * hstepA, tstepB = 2 * hstepB;
    const unsigned ldsw = (unsigned)wid * 1024u;
    const int aoff = lds_byte(wr * 64 + fr, fq * 8), boff = lds_byte(wc * 32 + fr, fq * 8);
#define PG8_SA(b, h) (((b) * 2 + (h)) * HTB)
#define PG8_SB(b, h) ((4 + (b) * 2 + (h)) * HTB)
#define PG8_STAGE(bufoff, gbase, voff) do { _Pragma("unroll") for (int _i = 0; _i < 2; ++_i) \
        __builtin_amdgcn_global_load_lds((const unsigned*)((const char*)(gbase) + (voff)[_i]), (PG8_LAS unsigned*)(lds + (bufoff) + ldsw + _i * 8192), 16, 0, 0); } while (0)
#define PG8_LDA(dst, b, h) do { _Pragma("unroll") for (int m = 0; m < 4; ++m) _Pragma("unroll") for (int k = 0; k < 2; ++k) dst[m][k] = *(const PG8_LAS bf16x8*)(lds + PG8_SA(b, h) + aoff + m * 2048 + k * 1024); } while (0)
#define PG8_LDB(dst, b, h) do { _Pragma("unroll") for (int n = 0; n < 2; ++n) _Pragma("unroll") for (int k = 0; k < 2; ++k) dst[n][k] = *(const PG8_LAS bf16x8*)(lds + PG8_SB(b, h) + boff + n * 2048 + k * 1024); } while (0)
#define PG8_MMA(ai, bj, At, Bt) do { __builtin_amdgcn_s_setprio(1); _Pragma("unroll") for (int m = 0; m < 4; ++m) _Pragma("unroll") for (int n = 0; n < 2; ++n) _Pragma("unroll") for (int k = 0; k < 2; ++k) \
        acc[ai][bj][m][n] = __builtin_amdgcn_mfma_f32_16x16x32_bf16(Bt[n][k], At[m][k], acc[ai][bj][m][n], 0, 0, 0); __builtin_amdgcn_s_setprio(0); } while (0)
#define PG8_WAIT_V(n) asm volatile("s_waitcnt vmcnt(" #n ")" ::: "memory")
#define PG8_WAIT_L(n) asm volatile("s_waitcnt lgkmcnt(" #n ")" ::: "memory")
#define PG8_BAR __builtin_amdgcn_s_barrier()
#define PG8_SCHED __builtin_amdgcn_sched_barrier(0)
    Unit cur, nxt; int ui = 0;
    if (!S.next(0, cur)) return;
    f32x4 acc[2][2][4][2];
#pragma unroll
    for (int a = 0; a < 2; ++a)
#pragma unroll
        for (int b = 0; b < 2; ++b)
#pragma unroll
            for (int m = 0; m < 4; ++m)
#pragma unroll
                for (int n = 0; n < 2; ++n) acc[a][b][m][n] = (f32x4){0.f, 0.f, 0.f, 0.f};
    bf16x8 At[4][2], B0[2][2], B1[2][2];
    const char* cA = (const char*)g.A + (size_t)cur.seg * g.segA + (size_t)cur.pm * tstepA; const char* cB = (const char*)g.Bt + (size_t)cur.seg * g.segB + (size_t)cur.pn * tstepB;
    S.a_ready(cur);
    if constexpr (SP2) {
        PG8_STAGE(PG8_SB(0, 0), cB, voffB); PG8_STAGE(PG8_SB(0, 1), cB + hstepB, voffB); PG8_STAGE(PG8_SA(0, 0), cA, voffA); PG8_STAGE(PG8_SA(0, 1), cA + hstepA, voffA);
        if (wr == 1) PG8_BAR;
        PG8_WAIT_V(2); PG8_BAR;
        PG8_STAGE(PG8_SB(1, 0), cB + kstep, voffB); PG8_STAGE(PG8_SA(1, 0), cA + kstep, voffA); PG8_STAGE(PG8_SB(1, 1), cB + hstepB + kstep, voffB);
        PG8_WAIT_V(6); PG8_BAR;
    } else {
        PG8_STAGE(PG8_SB(0, 0), cB, voffB); PG8_STAGE(PG8_SA(0, 0), cA, voffA); PG8_STAGE(PG8_SB(0, 1), cB + hstepB, voffB); PG8_STAGE(PG8_SA(0, 1), cA + hstepA, voffA);
        if (wr == 1) PG8_BAR;
        PG8_WAIT_V(4); PG8_BAR;
        PG8_STAGE(PG8_SB(1, 0), cB + kstep, voffB); PG8_STAGE(PG8_SA(1, 0), cA + kstep, voffA); PG8_STAGE(PG8_SB(1, 1), cB + hstepB + kstep, voffB);
        PG8_WAIT_V(6); PG8_BAR;
    }
    for (;;) {
        const bool has_next = S.next(ui + 1, nxt);
        const char* nA = has_next ? (const char*)g.A + (size_t)nxt.seg * g.segA + (size_t)nxt.pm * tstepA : cA; const char* nB = has_next ? (const char*)g.Bt + (size_t)nxt.seg * g.segB + (size_t)nxt.pn * tstepB : cB;
        for (int t = 0; t < nt; t += 2) {
            const bool last = (t == nt - 2);
            const char* a1 = cA + (size_t)(t + 1) * kstep;
            const char* a2 = last ? nA : cA + (size_t)(t + 2) * kstep; const char* b2 = last ? nB : cB + (size_t)(t + 2) * kstep;
            const char* a3 = a2 + kstep; const char* b3 = b2 + kstep;
            if (last && has_next) S.a_ready(nxt);
            if constexpr (SP2) {
            PG8_LDB(B0, 0, 0); PG8_LDB(B1, 0, 1); PG8_SCHED; PG8_LDA(At, 0, 0); PG8_STAGE(PG8_SA(1, 1), a1 + hstepA, voffA);
            PG8_WAIT_V(8); PG8_WAIT_L(0); PG8_BAR; PG8_MMA(0, 0, At, B0); PG8_MMA(0, 1, At, B1); PG8_BAR; PG8_SCHED;
            PG8_LDA(At, 0, 1); PG8_STAGE(PG8_SB(0, 0), b2, voffB); PG8_STAGE(PG8_SB(0, 1), b2 + hstepB, voffB); PG8_STAGE(PG8_SA(0, 0), a2, voffA);
            PG8_WAIT_V(8); PG8_WAIT_L(0); PG8_BAR; PG8_MMA(1, 0, At, B0); PG8_MMA(1, 1, At, B1); PG8_BAR; PG8_SCHED;
            PG8_LDB(B0, 1, 0); PG8_LDB(B1, 1, 1); PG8_SCHED; PG8_LDA(At, 1, 0); PG8_STAGE(PG8_SA(0, 1), a2 + hstepA, voffA);
            PG8_WAIT_V(8); PG8_WAIT_L(0); PG8_BAR; PG8_MMA(0, 0, At, B0); PG8_MMA(0, 1, At, B1); PG8_BAR; PG8_SCHED;
            PG8_LDA(At, 1, 1); PG8_STAGE(PG8_SB(1, 0), b3, voffB); PG8_STAGE(PG8_SB(1, 1), b3 + hstepB, voffB); PG8_STAGE(PG8_SA(1, 0), a3, voffA);
            PG8_WAIT_V(8); PG8_WAIT_L(0); PG8_BAR; PG8_MMA(1, 0, At, B0); PG8_MMA(1, 1, At, B1); PG8_BAR; PG8_SCHED;
            } else {
            PG8_LDB(B0, 0, 0); PG8_SCHED; PG8_LDA(At, 0, 0); PG8_STAGE(PG8_SA(1, 1), a1 + hstepA, voffA);
            PG8_WAIT_L(8); PG8_BAR; PG8_WAIT_L(0); PG8_MMA(0, 0, At, B0); PG8_BAR; PG8_SCHED;
            PG8_LDB(B1, 0, 1); PG8_STAGE(PG8_SB(0, 0), b2, voffB);
            PG8_BAR; PG8_WAIT_L(0); PG8_MMA(0, 1, At, B1); PG8_BAR;
            PG8_LDA(At, 0, 1); PG8_STAGE(PG8_SA(0, 0), a2, voffA);
            PG8_BAR; PG8_WAIT_L(0); PG8_MMA(1, 0, At, B0); PG8_BAR; PG8_SCHED;
            PG8_STAGE(PG8_SB(0, 1), b2 + hstepB, voffB);
            PG8_WAIT_V(6); PG8_BAR; PG8_MMA(1, 1, At, B1); PG8_BAR;
            PG8_LDB(B0, 1, 0); PG8_SCHED; PG8_LDA(At, 1, 0); PG8_STAGE(PG8_SA(0, 1), a2 + hstepA, voffA);
            PG8_WAIT_L(8); PG8_BAR; PG8_WAIT_L(0); PG8_MMA(0, 0, At, B0); PG8_BAR; PG8_SCHED;
            PG8_LDB(B1, 1, 1); PG8_STAGE(PG8_SB(1, 0), b3, voffB);
            PG8_BAR; PG8_WAIT_L(0); PG8_MMA(0, 1, At, B1); PG8_BAR;
            PG8_LDA(At, 1, 1); PG8_STAGE(PG8_SA(1, 0), a3, voffA);
            PG8_BAR; PG8_WAIT_L(0); PG8_MMA(1, 0, At, B0); PG8_BAR; PG8_SCHED;
            PG8_STAGE(PG8_SB(1, 1), b3 + hstepB, voffB);
            PG8_WAIT_V(6); PG8_BAR; PG8_MMA(1, 1, At, B1); PG8_BAR;
            }
        }
        if constexpr (ALIGN_EPI) { if (wr == 0) PG8_BAR; }
        bool keep_acc = false;
        if constexpr (!Epi::AFTER_DRAIN) { if constexpr (Epi::SEG) { if (cur.seg == 0) { E.mid(acc, cur, wr, wc, fr, fq); keep_acc = true; } else E(acc, cur, wr, wc, fr, fq); } else E(acc, cur, wr, wc, fr, fq); S.done(cur); }
        if (!has_next) break;
        if (!keep_acc)
#pragma unroll
        for (int a = 0; a < 2; ++a)
#pragma unroll
            for (int b = 0; b < 2; ++b)
#pragma unroll
                for (int m = 0; m < 4; ++m)
#pragma unroll
                    for (int n = 0; n < 2; ++n) acc[a][b][m][n] = (f32x4){0.f, 0.f, 0.f, 0.f};
        cur = nxt; cA = nA; cB = nB; ++ui;
        if constexpr (ALIGN_EPI) { if (wr == 1) PG8_BAR; }
    }
    PG8_WAIT_V(0);
    if constexpr (!ALIGN_EPI) { if (wr == 0) PG8_BAR; }
    PG8_BAR;
    if constexpr (Epi::AFTER_DRAIN) { E.fused(acc, cur, wr, wc, fr, fq, lds, wid, lane); S.done(cur); }
#undef PG8_SA
#undef PG8_SB
#undef PG8_STAGE
#undef PG8_LDA
#undef PG8_LDB
#undef PG8_MMA
#undef PG8_WAIT_V
#undef PG8_WAIT_L
#undef PG8_BAR
#undef PG8_SCHED
}
}
namespace pg8 {
__device__ __forceinline__ float bf_lo(unsigned u) { return __uint_as_float(u << 16); }
__device__ __forceinline__ float bf_hi(unsigned u) { return __uint_as_float(u & 0xffff0000u); }
__device__ __forceinline__ float sigm(float x) { return __builtin_amdgcn_rcpf(1.f + __builtin_amdgcn_exp2f(-1.4426950408889634f * x)); }
template <int MODE> struct EpiX {
    static constexpr bool PERM = true, AFTER_DRAIN = false, SEG = false;
    bf16_t* O; int ldc; const bf16_t* G; int ldg; const float* RS = nullptr;
    __device__ __forceinline__ void operator()(const f32x4 (&acc)[2][2][4][2], const Unit& u, int wr, int wc, int fr, int fq) const {
        const int row0 = u.pm * BM + wr * 64 + fr; const int col0 = u.pn * BM + wc * 32 + 8 * fq;
#pragma unroll
        for (int ai = 0; ai < 2; ++ai)
#pragma unroll
            for (int m = 0; m < 4; ++m) { const size_t row = (size_t)(row0 + ai * HALF + m * 16);
#pragma unroll
                for (int bj = 0; bj < 2; ++bj) { const int col = col0 + bj * HALF;
                    const f32x4 a0 = acc[ai][bj][m][0], a1 = acc[ai][bj][m][1];
                    float v[8] = {a0[0], a0[1], a0[2], a0[3], a1[0], a1[1], a1[2], a1[3]};
                    bf16_t* op = O + row * ldc + col;
                    if (MODE == 5) op = O + ((((size_t)(col >> 12) * 64 + ((col >> 6) & 63)) * 8 + (row >> 7)) * 128 + (row & 127)) * 64 + (col & 63);
                    if (MODE == 1) {
                        const float rs = RS[row], rs2 = rs * rs;
#pragma unroll
                        for (int i = 0; i < 8; ++i) { const float r = fmaxf(v[i], 0.f); v[i] = r * r * rs2; } }
                    if (MODE == 2 || MODE == 3) { const u32x4 gw = *(const u32x4*)(G + row * ldg + col);
                        const float gf[8] = {bf_lo(gw.x), bf_hi(gw.x), bf_lo(gw.y), bf_hi(gw.y), bf_lo(gw.z), bf_hi(gw.z), bf_lo(gw.w), bf_hi(gw.w)};
#pragma unroll
                        for (int i = 0; i < 8; ++i) v[i] = sigm(gf[i]) * v[i]; }
                    if (MODE == 3) { const u32x4 ow = *(const u32x4*)op;
                        const float of[8] = {bf_lo(ow.x), bf_hi(ow.x), bf_lo(ow.y), bf_hi(ow.y), bf_lo(ow.z), bf_hi(ow.z), bf_lo(ow.w), bf_hi(ow.w)};
#pragma unroll
                        for (int i = 0; i < 8; ++i) v[i] += of[i]; }
                    if (MODE == 4) { const u32x4 ow = *(const u32x4*)op;
                        const float of[8] = {bf_lo(ow.x), bf_hi(ow.x), bf_lo(ow.y), bf_hi(ow.y), bf_lo(ow.z), bf_hi(ow.z), bf_lo(ow.w), bf_hi(ow.w)};
                        const float rs = RS[row];
#pragma unroll
                        for (int i = 0; i < 8; ++i) v[i] = of[i] * sigm(v[i] * rs); }
                    u32x4 w; w.x = cvt_pk_bf16(v[0], v[1]); w.y = cvt_pk_bf16(v[2], v[3]); w.z = cvt_pk_bf16(v[4], v[5]); w.w = cvt_pk_bf16(v[6], v[7]);
                    *(u32x4*)op = w; }
                if (MODE >= 2) asm volatile("" ::: "memory"); }
    }
};

struct SegOrder { StaticOrder base;
    __device__ bool next(int i, Unit& u) const { if (!base.next(i >> 1, u)) return false; u.seg = i & 1; return true; }
    __device__ __forceinline__ void a_ready(const Unit&) const {}
    __device__ __forceinline__ void done(const Unit&) const {} };
struct EpiGate {
    static constexpr bool PERM = true, AFTER_DRAIN = false, SEG = true;
    bf16_t* O; int ldc; const bf16_t* GA; const bf16_t* GB; int ldg;
    static __device__ __forceinline__ float eneg(float x) { return __builtin_amdgcn_exp2f(-1.4426950408889634f * fminf(fmaxf(x, -30.f), 30.f)); }
    __device__ __forceinline__ void mid(f32x4 (&acc)[2][2][4][2], const Unit& u, int wr, int wc, int fr, int fq) const {
        const int row0 = u.pm * BM + wr * 64 + fr; const int col0 = u.pn * BM + wc * 32 + 8 * fq;
#pragma unroll
        for (int ai = 0; ai < 2; ++ai)
#pragma unroll
            for (int m = 0; m < 4; ++m) { const size_t row = (size_t)(row0 + ai * HALF + m * 16);
#pragma unroll
                for (int bj = 0; bj < 2; ++bj) { const int col = col0 + bj * HALF;
                    const u32x4 aw = *(const u32x4*)(GA + row * ldg + col), bw = *(const u32x4*)(GB + row * ldg + col);
                    const float ga[8] = {bf_lo(aw.x), bf_hi(aw.x), bf_lo(aw.y), bf_hi(aw.y), bf_lo(aw.z), bf_hi(aw.z), bf_lo(aw.w), bf_hi(aw.w)};
                    const float gb[8] = {bf_lo(bw.x), bf_hi(bw.x), bf_lo(bw.y), bf_hi(bw.y), bf_lo(bw.z), bf_hi(bw.z), bf_lo(bw.w), bf_hi(bw.w)};
                    float r[8];
#pragma unroll
                    for (int i = 0; i < 8; ++i) r[i] = (1.f + eneg(gb[i])) * __builtin_amdgcn_rcpf(1.f + eneg(ga[i]));
                    acc[ai][bj][m][0] = acc[ai][bj][m][0] * (f32x4){r[0], r[1], r[2], r[3]}; acc[ai][bj][m][1] = acc[ai][bj][m][1] * (f32x4){r[4], r[5], r[6], r[7]}; }
                asm volatile("" ::: "memory"); }
    }
    __device__ __forceinline__ void operator()(const f32x4 (&acc)[2][2][4][2], const Unit& u, int wr, int wc, int fr, int fq) const {
        const int row0 = u.pm * BM + wr * 64 + fr; const int col0 = u.pn * BM + wc * 32 + 8 * fq;
#pragma unroll
        for (int ai = 0; ai < 2; ++ai)
#pragma unroll
            for (int m = 0; m < 4; ++m) { const size_t row = (size_t)(row0 + ai * HALF + m * 16);
#pragma unroll
                for (int bj = 0; bj < 2; ++bj) { const int col = col0 + bj * HALF;
                    const u32x4 bw = *(const u32x4*)(GB + row * ldg + col);
                    const float gb[8] = {bf_lo(bw.x), bf_hi(bw.x), bf_lo(bw.y), bf_hi(bw.y), bf_lo(bw.z), bf_hi(bw.z), bf_lo(bw.w), bf_hi(bw.w)};
                    const f32x4 a0 = acc[ai][bj][m][0], a1 = acc[ai][bj][m][1];
                    float v[8] = {a0[0], a0[1], a0[2], a0[3], a1[0], a1[1], a1[2], a1[3]};
#pragma unroll
                    for (int i = 0; i < 8; ++i) v[i] *= __builtin_amdgcn_rcpf(1.f + eneg(gb[i]));
                    u32x4 w; w.x = cvt_pk_bf16(v[0], v[1]); w.y = cvt_pk_bf16(v[2], v[3]); w.z = cvt_pk_bf16(v[4], v[5]); w.w = cvt_pk_bf16(v[6], v[7]);
                    *(u32x4*)(O + row * ldc + col) = w; }
                asm volatile("" ::: "memory"); }
    }
};
}
namespace gqa {
using bf16 = __hip_bfloat16;
constexpr int   D = 128, NW = 8, QBLK = 32, KVBLK = 64;
constexpr float SCALE = 0.088388347648318440f;
constexpr float THR = 8.f;
using f32x4 = __attribute__((ext_vector_type(4))) float;
constexpr int SDEPTH = 1;
constexpr int LDQ = 7680, LDK = 256, LDO = 1024;
constexpr size_t SHM_V = KVBLK * D * 2, SHM_K = KVBLK * D * 2, SHM_ATTN = 2 * SHM_V + 2 * SHM_K + NW * 64 * 4;
using bf16x8 = __attribute__((ext_vector_type(8))) short;
using s16x4  = __attribute__((ext_vector_type(4))) short;
using f32x16 = __attribute__((ext_vector_type(16))) float;
using f32x8  = __attribute__((ext_vector_type(8))) float;
using u32x4  = __attribute__((ext_vector_type(4))) unsigned;
#define KSWZ(row, colB) ((row) * 256 + ((colB) ^ (((row) & 7) << 4)))
#define SBAR() __builtin_amdgcn_sched_barrier(0)
__device__ __forceinline__ int crow(int r, int hi) { return (r & 3) + 8 * (r >> 2) + 4 * hi; }
__device__ __forceinline__ unsigned cvtpk(float lo, float hi) {
  unsigned r; asm volatile("v_cvt_pk_bf16_f32 %0, %1, %2" : "=v"(r) : "v"(lo), "v"(hi)); return r;
}
template <typename TIn> struct Stage;
template <> struct Stage<bf16>  { using T = bf16x8;
  __device__ static __forceinline__ T ld8(const bf16* p) { return *reinterpret_cast<const bf16x8*>(p); }
  __device__ static __forceinline__ bf16x8 tobf(T x) { return x; } };
template <> struct Stage<float> { using T = f32x8;
  __device__ static __forceinline__ T ld8(const float* p) { return *reinterpret_cast<const f32x8*>(p); }
  __device__ static __forceinline__ bf16x8 tobf(T x) {
    u32x4 w = {cvtpk(x[0], x[1]), cvtpk(x[2], x[3]), cvtpk(x[4], x[5]), cvtpk(x[6], x[7])}; return *reinterpret_cast<bf16x8*>(&w); } };

__device__ __forceinline__ void partialSM(f32x16& p0, f32x16& p1, float& m_reg, float& mn, float& alpha) {
  constexpr float C = SCALE * 1.4426950408889634f;
  float pmax = p0[0]; for (int r = 1; r < 16; ++r) pmax = fmaxf(pmax, p0[r]); for (int r = 0; r < 16; ++r) pmax = fmaxf(pmax, p1[r]);
  { auto rr = __builtin_amdgcn_permlane32_swap(__float_as_uint(pmax), __float_as_uint(pmax), false, false);
    pmax = fmaxf(__uint_as_float(rr[0]), __uint_as_float(rr[1])); }
  if (__builtin_expect(__all(pmax - m_reg <= THR / SCALE), 1)) { mn = m_reg; alpha = 1.f; }
  else { mn = fmaxf(m_reg, pmax); alpha = __builtin_amdgcn_exp2f((m_reg - mn) * C); m_reg = mn; }
  float mnC = -mn * C;
  for (int r = 0; r < 16; ++r) p0[r] = fmaf(p0[r], C, mnC); for (int r = 0; r < 16; ++r) p1[r] = fmaf(p1[r], C, mnC);
  for (int r = 0; r < 16; ++r) p0[r] = __builtin_amdgcn_exp2f(p0[r]);
}
__device__ __forceinline__ void finishSM(f32x16& p0, f32x16& p1, float alpha, float& l_reg, bf16x8& pa0, bf16x8& pa1, bf16x8& pa2, bf16x8& pa3) {
  for (int r = 0; r < 16; ++r) p1[r] = __builtin_amdgcn_exp2f(p1[r]);
  float ps = 0; for (int r = 0; r < 16; ++r) ps += p0[r]; for (int r = 0; r < 16; ++r) ps += p1[r];
  { auto rr = __builtin_amdgcn_permlane32_swap(__float_as_uint(ps), __float_as_uint(ps), false, false);
    ps = __uint_as_float(rr[0]) + __uint_as_float(rr[1]); }
  l_reg = l_reg * alpha + ps;
#define PK4(P, BASE, OUT) do { unsigned a0 = cvtpk(P[BASE + 0], P[BASE + 1]), a1 = cvtpk(P[BASE + 2], P[BASE + 3]);   \
    unsigned b0 = cvtpk(P[BASE + 4], P[BASE + 5]), b1 = cvtpk(P[BASE + 6], P[BASE + 7]);                              \
    auto r0 = __builtin_amdgcn_permlane32_swap(a0, b0, false, false); auto r1 = __builtin_amdgcn_permlane32_swap(a1, b1, false, false); \
    u32x4 w = {r0[0], r1[0], r0[1], r1[1]}; OUT = *reinterpret_cast<bf16x8*>(&w); } while (0)
  PK4(p0, 0, pa0); PK4(p0, 8, pa1); PK4(p1, 0, pa2); PK4(p1, 8, pa3);
#undef PK4
}
__device__ __forceinline__ void qkt(f32x16& p0, f32x16& p1, const bf16* Ks, const bf16x8* qr, int r32, int hi) {
  p0 = f32x16{}; p1 = f32x16{};
  for (int d0 = 0; d0 < 8; ++d0) { int cb = (d0 * 16 + hi * 8) * 2;
    bf16x8 b0 = *reinterpret_cast<const bf16x8*>((const char*)Ks + KSWZ(r32, cb));
    bf16x8 b1 = *reinterpret_cast<const bf16x8*>((const char*)Ks + KSWZ(32 + r32, cb));
    p0 = __builtin_amdgcn_mfma_f32_32x32x16_bf16(b0, qr[d0], p0, 0, 0, 0);
    p1 = __builtin_amdgcn_mfma_f32_32x32x16_bf16(b1, qr[d0], p1, 0, 0, 0); }
}
__device__ __forceinline__ int v_st(int k, int c) { const int kk = (k & ~0xC) | ((k & 4) << 1) | ((k & 8) >> 1); return ((kk >> 3) * 4 + (c >> 5)) * 512 + ((kk & 7) * 32 + (c & 31)) * 2; }
__device__ __forceinline__ int v_rd_base(int lane) { return ((lane & 3) << 3) | (((lane >> 2) & 3) << 6) | (((lane >> 4) & 1) << 5) | (((lane >> 5) & 1) << 8); }
constexpr int v_rd_off(int d0, int ks, int half) { return d0 * 512 + ks * 4096 + half * 2048; }
template <int OFF> __device__ __forceinline__ s16x4 tr_read(int vb) {
  s16x4 r; asm volatile("ds_read_b64_tr_b16 %0, %1 offset:%2" : "=&v"(r) : "v"(vb), "i"(OFF) : "memory"); return r;
}
template <int D0> __device__ __forceinline__ void pv_one(f32x16& od, int vb, bf16x8 pa0, bf16x8 pa1, bf16x8 pa2, bf16x8 pa3) {
  const s16x4 l0 = tr_read<v_rd_off(D0, 0, 0)>(vb), h0 = tr_read<v_rd_off(D0, 0, 1)>(vb), l1 = tr_read<v_rd_off(D0, 1, 0)>(vb), h1 = tr_read<v_rd_off(D0, 1, 1)>(vb);
  const s16x4 l2 = tr_read<v_rd_off(D0, 2, 0)>(vb), h2 = tr_read<v_rd_off(D0, 2, 1)>(vb), l3 = tr_read<v_rd_off(D0, 3, 0)>(vb), h3 = tr_read<v_rd_off(D0, 3, 1)>(vb);
  asm volatile("s_waitcnt lgkmcnt(0)" ::: "memory"); SBAR();
#define PK(L, H) (bf16x8){L[0], L[1], L[2], L[3], H[0], H[1], H[2], H[3]}
  od = __builtin_amdgcn_mfma_f32_32x32x16_bf16(pa0, PK(l0, h0), od, 0, 0, 0);
  od = __builtin_amdgcn_mfma_f32_32x32x16_bf16(pa1, PK(l1, h1), od, 0, 0, 0);
  od = __builtin_amdgcn_mfma_f32_32x32x16_bf16(pa2, PK(l2, h2), od, 0, 0, 0);
  od = __builtin_amdgcn_mfma_f32_32x32x16_bf16(pa3, PK(l3, h3), od, 0, 0, 0);
#undef PK
}
__device__ __forceinline__ void pv_d0(f32x16* o, int vb, bf16x8 pa0, bf16x8 pa1, bf16x8 pa2, bf16x8 pa3) {
  pv_one<0>(o[0], vb, pa0, pa1, pa2, pa3); pv_one<1>(o[1], vb, pa0, pa1, pa2, pa3); pv_one<2>(o[2], vb, pa0, pa1, pa2, pa3); pv_one<3>(o[3], vb, pa0, pa1, pa2, pa3);
}

template <typename TQ>
__device__ __forceinline__ void attn_dense_body(const TQ* Qb, const bf16* __restrict__ Kh, const bf16* __restrict__ Vh,
                                                bf16* Ob, int seq, char* lds, const float* __restrict__ qgain, const float* __restrict__ tab, int tok0) {
  using St = Stage<bf16>; using SQ = Stage<TQ>;
  int tid_l = threadIdx.x; asm volatile("" : "+v"(tid_l));
  const int tid = tid_l, wid = tid >> 6, lane = tid & 63, r32 = lane & 31, hi = lane >> 5;
  bf16* V_lds = (bf16*)lds; bf16* K_lds = (bf16*)(lds + 2 * SHM_V);
  float* ws = (float*)(lds + 2 * SHM_V + 2 * SHM_K) + wid * 64; float* li_l = ws; float* al_l = ws + 32;
  float m_reg = -1e30f, l_reg = 0; f32x16 o[4] = {}; bf16x8 qr[8];
  const TQ* Qw = Qb + (long)(wid * QBLK + r32) * LDQ + hi * 8;
  {
    float y[8][8]; float ss = 0.f;
#pragma unroll
    for (int d0 = 0; d0 < 8; ++d0) { const u32x4 w = *reinterpret_cast<const u32x4*>(Qw + d0 * 16);
      y[d0][0] = __uint_as_float(w.x << 16); y[d0][1] = __uint_as_float(w.x & 0xffff0000u); y[d0][2] = __uint_as_float(w.y << 16); y[d0][3] = __uint_as_float(w.y & 0xffff0000u);
      y[d0][4] = __uint_as_float(w.z << 16); y[d0][5] = __uint_as_float(w.z & 0xffff0000u); y[d0][6] = __uint_as_float(w.w << 16); y[d0][7] = __uint_as_float(w.w & 0xffff0000u);
#pragma unroll
      for (int j = 0; j < 8; ++j) ss += y[d0][j] * y[d0][j]; }
    { auto rr = __builtin_amdgcn_permlane32_swap(__float_as_uint(ss), __float_as_uint(ss), false, false); ss = __uint_as_float(rr[0]) + __uint_as_float(rr[1]); }
    const float rstd = __builtin_amdgcn_rsqf(ss * (1.f / 128.f) + 1e-6f);
#pragma unroll
    for (int d0 = 0; d0 < 8; ++d0) { const f32x4 ga = *reinterpret_cast<const f32x4*>(qgain + d0 * 16 + hi * 8), gb = *reinterpret_cast<const f32x4*>(qgain + d0 * 16 + hi * 8 + 4);
      y[d0][0] *= rstd * ga[0]; y[d0][1] *= rstd * ga[1]; y[d0][2] *= rstd * ga[2]; y[d0][3] *= rstd * ga[3]; y[d0][4] *= rstd * gb[0]; y[d0][5] *= rstd * gb[1]; y[d0][6] *= rstd * gb[2]; y[d0][7] *= rstd * gb[3]; }
    const int tok = tok0 + wid * QBLK + r32, prow = (tok >> 6) & 63, pcol = tok & 63;
#pragma unroll
    for (int hf = 0; hf < 2; ++hf) { const int pos = hf ? pcol : prow;
#pragma unroll
      for (int db = 0; db < 2; ++db) { const float* tp = tab + (pos * 32 + db * 16 + hi * 8) * 2;
        const f32x4 t0 = *reinterpret_cast<const f32x4*>(tp), t1 = *reinterpret_cast<const f32x4*>(tp + 4), t2 = *reinterpret_cast<const f32x4*>(tp + 8), t3 = *reinterpret_cast<const f32x4*>(tp + 12);
        const float cs[8] = {t0[0], t0[2], t1[0], t1[2], t2[0], t2[2], t3[0], t3[2]}, sn[8] = {t0[1], t0[3], t1[1], t1[3], t2[1], t2[3], t3[1], t3[3]};
#pragma unroll
        for (int j = 0; j < 8; ++j) { const float x1 = y[hf * 4 + db][j], x2 = y[hf * 4 + db + 2][j]; y[hf * 4 + db][j] = x1 * cs[j] - x2 * sn[j]; y[hf * 4 + db + 2][j] = x2 * cs[j] + x1 * sn[j]; } } }
#pragma unroll
    for (int d0 = 0; d0 < 8; ++d0) { u32x4 w = {cvtpk(y[d0][0], y[d0][1]), cvtpk(y[d0][2], y[d0][3]), cvtpk(y[d0][4], y[d0][5]), cvtpk(y[d0][6], y[d0][7])}; qr[d0] = *reinterpret_cast<bf16x8*>(&w); }
  }
  const int sr = tid >> 4, sc = (tid & 15) * 8, vst0 = v_st(sr, sc), vst1 = v_st(32 + sr, sc);
  const int vb0 = (int)(uintptr_t)V_lds + v_rd_base(lane);
  struct { typename St::T vs0, vs1, ks0, ks1; } sr_[SDEPTH];
  const unsigned voff0 = (unsigned)(sr * LDK + sc) * 2u, voff1 = voff0 + 32u * LDK * 2u;
#define SLOAD(i, k0) do { const char* vb_ = (const char*)Vh + (size_t)(k0) * (LDK * 2); const char* kb_ = (const char*)Kh + (size_t)(k0) * (LDK * 2); \
    sr_[i].vs0 = *(const bf16x8*)(vb_ + voff0); sr_[i].vs1 = *(const bf16x8*)(vb_ + voff1); \
    sr_[i].ks0 = *(const bf16x8*)(kb_ + voff0); sr_[i].ks1 = *(const bf16x8*)(kb_ + voff1); } while (0)
#define SWRITE(b, i) do { *(bf16x8*)((char*)V_lds + (b) * SHM_V + vst0) = St::tobf(sr_[i].vs0);          \
    *(bf16x8*)((char*)V_lds + (b) * SHM_V + vst1) = St::tobf(sr_[i].vs1); int kc = sc * 2;               \
    *(bf16x8*)((char*)K_lds + (b) * SHM_K + KSWZ(sr, kc)) = St::tobf(sr_[i].ks0);                       \
    *(bf16x8*)((char*)K_lds + (b) * SHM_K + KSWZ(32 + sr, kc)) = St::tobf(sr_[i].ks1); } while (0)
#define SWAIT() do { if constexpr (SDEPTH == 2) asm volatile("s_waitcnt vmcnt(4)" ::: "memory"); else asm volatile("s_waitcnt vmcnt(0)" ::: "memory"); } while (0)
#define RESC(a) do { if (__any((a) < 1.f)) { if (hi == 0) al_l[r32] = (a); asm volatile("s_waitcnt lgkmcnt(0)" ::: "memory"); \
    for (int d = 0; d < 4; ++d) for (int r = 0; r < 16; ++r) o[d][r] *= al_l[crow(r, hi)]; } } while (0)
  f32x16 pA0, pA1, pB0, pB1; float mnA, mnB, alA, alB; bf16x8 pa0, pa1, pa2, pa3; const int NT = seq / KVBLK;
  constexpr int SE = 0, SO = SDEPTH - 1;
  SLOAD(SE, 0); asm volatile("s_waitcnt vmcnt(0)" ::: "memory"); SWRITE(0, SE); __syncthreads();
  qkt(pA0, pA1, K_lds, qr, r32, hi); partialSM(pA0, pA1, m_reg, mnA, alA);
  SLOAD(SO, KVBLK); if constexpr (SDEPTH == 2) { if (2 < NT) SLOAD(SE, 2 * KVBLK); }
  SWAIT(); SWRITE(1, SO); __syncthreads();
  for (int j = 1; j + 1 < NT; j += 2) {
    SBAR(); qkt(pB0, pB1, (bf16*)((char*)K_lds + SHM_K), qr, r32, hi);
    finishSM(pA0, pA1, alA, l_reg, pa0, pa1, pa2, pa3); SBAR();
    SLOAD(SO, (j + SDEPTH) * KVBLK); SBAR();
    pv_d0(o, vb0, pa0, pa1, pa2, pa3); partialSM(pB0, pB1, m_reg, mnB, alB);
    __syncthreads(); SWAIT(); SWRITE(0, SE);
    RESC(alB); __syncthreads();
    SBAR(); qkt(pA0, pA1, K_lds, qr, r32, hi);
    finishSM(pB0, pB1, alB, l_reg, pa0, pa1, pa2, pa3); SBAR();
    if (SDEPTH == 1 || j + 3 < NT) SLOAD(SE, (j + 1 + SDEPTH) * KVBLK); SBAR();
    pv_d0(o, vb0 + (int)SHM_V, pa0, pa1, pa2, pa3); partialSM(pA0, pA1, m_reg, mnA, alA);
    __syncthreads(); SWAIT(); SWRITE(1, SO);
    RESC(alA); __syncthreads();
  }
  SBAR(); qkt(pB0, pB1, (bf16*)((char*)K_lds + SHM_K), qr, r32, hi);
  finishSM(pA0, pA1, alA, l_reg, pa0, pa1, pa2, pa3); SBAR();
  pv_d0(o, vb0, pa0, pa1, pa2, pa3); partialSM(pB0, pB1, m_reg, mnB, alB);
  __syncthreads(); RESC(alB);
  finishSM(pB0, pB1, alB, l_reg, pa0, pa1, pa2, pa3); SBAR();
  pv_d0(o, vb0 + (int)SHM_V, pa0, pa1, pa2, pa3);
  if (hi == 0) li_l[r32] = l_reg; asm volatile("s_waitcnt lgkmcnt(0)" ::: "memory");
  float rli[16];
#pragma unroll
  for (int r = 0; r < 16; ++r) rli[r] = __builtin_amdgcn_rcpf(li_l[crow(r, hi)]);
  bf16* Ow = Ob + (long)(wid * QBLK) * LDO;
#pragma unroll
  for (int r = 0; r < 16; ++r) { int orow = crow(r, hi);
    for (int d0 = 0; d0 < 4; ++d0) Ow[(long)orow * LDO + d0 * 32 + r32] = __builtin_bit_cast(bf16, (unsigned short)(cvtpk(o[d0][r] * rli[r], 0.f) & 0xffffu)); }
#undef SLOAD
#undef SWRITE
#undef SWAIT
#undef RESC
}
#undef KSWZ
#undef SBAR
}
#define LAS __attribute__((address_space(3)))
typedef unsigned short bf16_t;
typedef float f32x4 __attribute__((ext_vector_type(4)));
typedef unsigned u32x4 __attribute__((ext_vector_type(4)));
typedef unsigned u32x2 __attribute__((ext_vector_type(2)));
typedef short bf16x8 __attribute__((ext_vector_type(8)));

constexpr int T = 49152, TP = 32768, DM = 2048, SEQ = 4096, NBATCH = 12, DFF = 8192, PLE = 256;
constexpr int PP = 7680;
constexpr int C_NAQ = 0, C_NAK = 1024, C_GQ = 2048, C_GK = 3072, C_GV = 3328, C_GA = 3584, C_GB = 5632;
constexpr float EPS = 1e-6f;
constexpr size_t MiB = 1u << 20;
constexpr size_t WS_TAB = 0, WS_WIN = 1 * MiB, WS_WNA = 35 * MiB, WS_WGQA = 39 * MiB, WS_WMIX = 43 * MiB, WS_WFF1 = 51 * MiB, WS_WFF2 = 83 * MiB,
                 WS_WPG = 115 * MiB, WS_WPP = 123 * MiB, WS_PB = 124 * MiB, WS_VT = 148 * MiB, WS_PROJ = 244 * MiB, WS_END0 = 964 * MiB;
constexpr size_t WS_Y = 244 * MiB, WS_H = 436 * MiB, WS_HID = 628 * MiB, WS_EP = 628 * MiB, WS_END = 1016 * MiB;
constexpr int HIDP = 8192 + 64;
constexpr int LDS_BYTES = 147456;
constexpr int NTHREADS = 512;

struct Params {
    const float* x_p; const float* x_s; const float* p_p; const float* p_s;
    const float* ln_mix_pre; const float* w_in; const float* q_norm; const float* k_norm; const float* na_rpb;
    const float* w_na; const float* w_gqa; const float* w_mix; const float* ln_mix_post; const float* ln_mlp_pre;
    const float* w_ff1; const float* w_ff2; const float* ln_mlp_post; const float* ln_ple_pre; const float* w_ple_gate; const float* w_ple_proj; const float* ln_ple_post;
    float* out; unsigned char* ws;
};

__device__ __forceinline__ unsigned pk_bf16(float lo, float hi) { unsigned r; asm volatile("v_cvt_pk_bf16_f32 %0, %1, %2" : "=v"(r) : "v"(lo), "v"(hi)); return r; }
__device__ __forceinline__ float bflo(unsigned u) { return __uint_as_float(u << 16); }
__device__ __forceinline__ float bfhi(unsigned u) { return __uint_as_float(u & 0xffff0000u); }
__device__ __forceinline__ float wave_sum(float v) {
#pragma unroll
    for (int o = 1; o < 64; o <<= 1) v += __shfl_xor(v, o);
    return v;
}

__device__ __forceinline__ void transpose_item(const float* W, int K, int N, bf16_t* WT, int k0, int n0, int drow0, LAS float* scr, int lane, const float* gk) {
#pragma unroll 8
    for (int i = 0; i < 32; ++i) { const int kk = 2 * i + (lane >> 5); scr[kk * 33 + (lane & 31)] = W[(size_t)(k0 + kk) * N + n0 + (lane & 31)] * (gk ? gk[k0 + kk] : 1.f); }
    asm volatile("s_waitcnt lgkmcnt(0)" ::: "memory");
    const int c = lane & 7;
#pragma unroll
    for (int j = 0; j < 4; ++j) { const int n = (lane >> 3) + 8 * j; const LAS float* s = scr + (8 * c) * 33 + n;
        u32x4 o; o.x = pk_bf16(s[0 * 33], s[1 * 33]); o.y = pk_bf16(s[2 * 33], s[3 * 33]); o.z = pk_bf16(s[4 * 33], s[5 * 33]); o.w = pk_bf16(s[6 * 33], s[7 * 33]);
        *(u32x4*)(WT + (size_t)(drow0 + n) * K + k0 + 8 * c) = o; }
    asm volatile("s_waitcnt lgkmcnt(0)" ::: "memory");
}
__device__ __forceinline__ bool transpose_mat(int& r, const float* W, int K, int N, bf16_t* WT, LAS float* scr, int lane, bool remap_in, const float* gk = nullptr) {
    const int nblk = N / 32, items = (K / 64) * nblk;
    if (r >= items) { r -= items; return false; }
    const int kb = r / nblk, nb = r % nblk, n0 = nb * 32;
    int d0 = n0;
    if (remap_in) d0 = (n0 < 2048) ? n0 : (n0 < 3072 ? n0 - 2048 + 7680 : n0 - 1024);
    transpose_item(W, K, N, WT, kb * 64, n0, d0, scr, lane, gk);
    return true;
}

__device__ __forceinline__ const float* xrow_in(const Params& P, int m) { return m < TP ? P.x_p + (size_t)m * DM : P.x_s + (size_t)(m - TP) * DM; }

template <int MODE>
__device__ __forceinline__ void row_pass(const Params& P, const bf16_t* Y, const bf16_t* XS, bf16_t* XB, float* RS, const float* g1, int gw, int ngw) {
    int tid_l = threadIdx.x; asm volatile("" : "+v"(tid_l)); const int lane = tid_l & 63;
    for (int m0 = gw; m0 < T; m0 += 2 * ngw) {
        const int mr[2] = {m0, min(m0 + ngw, T - 1)}; const bool ok1 = (m0 + ngw < T);
        float x[2][4][8], y[2][4][8];
#pragma unroll
        for (int r = 0; r < 2; ++r) { const int mm = mr[r];
            if (MODE == 0 || MODE == 1) { const float* base = xrow_in(P, mm);
#pragma unroll
                for (int j = 0; j < 4; ++j) { const f32x4 a = *(const f32x4*)(base + j * 512 + lane * 8), b = *(const f32x4*)(base + j * 512 + lane * 8 + 4);
                    x[r][j][0] = a[0]; x[r][j][1] = a[1]; x[r][j][2] = a[2]; x[r][j][3] = a[3]; x[r][j][4] = b[0]; x[r][j][5] = b[1]; x[r][j][6] = b[2]; x[r][j][7] = b[3]; }
            } else {
#pragma unroll
                for (int j = 0; j < 4; ++j) { const u32x4 w = *(const u32x4*)(XS + (size_t)mm * DM + j * 512 + lane * 8);
                    x[r][j][0] = bflo(w.x); x[r][j][1] = bfhi(w.x); x[r][j][2] = bflo(w.y); x[r][j][3] = bfhi(w.y); x[r][j][4] = bflo(w.z); x[r][j][5] = bfhi(w.z); x[r][j][6] = bflo(w.w); x[r][j][7] = bfhi(w.w); }
            }
            if (MODE != 0) {
#pragma unroll
                for (int j = 0; j < 4; ++j) { const u32x4 w = *(const u32x4*)(Y + (size_t)mm * DM + j * 512 + lane * 8);
                    y[r][j][0] = bflo(w.x); y[r][j][1] = bfhi(w.x); y[r][j][2] = bflo(w.y); y[r][j][3] = bfhi(w.y); y[r][j][4] = bflo(w.z); y[r][j][5] = bfhi(w.z); y[r][j][6] = bflo(w.w); y[r][j][7] = bfhi(w.w); }
            }
        }
#pragma unroll
        for (int r = 0; r < 2; ++r) { const int mm = mr[r]; const bool ok = (r == 0) || ok1;
            if (MODE != 0) {
                float ss = 0.f;
#pragma unroll
                for (int j = 0; j < 4; ++j)
#pragma unroll
                    for (int i = 0; i < 8; ++i) ss += y[r][j][i] * y[r][j][i];
                const float rstd = __builtin_amdgcn_rsqf(wave_sum(ss) * (1.f / DM) + EPS);
#pragma unroll
                for (int j = 0; j < 4; ++j) { const f32x4 ga = *(const f32x4*)(g1 + j * 512 + lane * 8), gb = *(const f32x4*)(g1 + j * 512 + lane * 8 + 4);
                    const float gg[8] = {ga[0], ga[1], ga[2], ga[3], gb[0], gb[1], gb[2], gb[3]};
#pragma unroll
                    for (int i = 0; i < 8; ++i) x[r][j][i] += y[r][j][i] * rstd * gg[i]; }
            }
            if (MODE == 2) {
                if (ok) {
#pragma unroll
                    for (int j = 0; j < 4; ++j) { float* o = P.out + (size_t)mm * DM + j * 512 + lane * 8;
                        *(f32x4*)o = (f32x4){x[r][j][0], x[r][j][1], x[r][j][2], x[r][j][3]}; *(f32x4*)(o + 4) = (f32x4){x[r][j][4], x[r][j][5], x[r][j][6], x[r][j][7]}; } }
            } else {
                float ss = 0.f;
#pragma unroll
                for (int j = 0; j < 4; ++j)
#pragma unroll
                    for (int i = 0; i < 8; ++i) ss += x[r][j][i] * x[r][j][i];
                const float rstd = __builtin_amdgcn_rsqf(wave_sum(ss) * (1.f / DM) + EPS);
                if (ok) {
                    if (MODE == 0) {
#pragma unroll
                        for (int j = 0; j < 4; ++j) { const f32x4 ga = *(const f32x4*)(g1 + j * 512 + lane * 8), gb = *(const f32x4*)(g1 + j * 512 + lane * 8 + 4);
                            u32x4 w; w.x = pk_bf16(x[r][j][0] * rstd * ga[0], x[r][j][1] * rstd * ga[1]); w.y = pk_bf16(x[r][j][2] * rstd * ga[2], x[r][j][3] * rstd * ga[3]);
                            w.z = pk_bf16(x[r][j][4] * rstd * gb[0], x[r][j][5] * rstd * gb[1]); w.w = pk_bf16(x[r][j][6] * rstd * gb[2], x[r][j][7] * rstd * gb[3]);
                            *(u32x4*)(XB + (size_t)mm * DM + j * 512 + lane * 8) = w; }
                    } else {
                        if (lane == 0) RS[mm] = rstd;
#pragma unroll
                        for (int j = 0; j < 4; ++j) { u32x4 w; w.x = pk_bf16(x[r][j][0], x[r][j][1]); w.y = pk_bf16(x[r][j][2], x[r][j][3]); w.z = pk_bf16(x[r][j][4], x[r][j][5]); w.w = pk_bf16(x[r][j][6], x[r][j][7]);
                            *(u32x4*)(XB + (size_t)mm * DM + j * 512 + lane * 8) = w; }
                    }
                }
            }
        }
    }
}

__device__ __forceinline__ void qk_norm_rope(const Params& P, const bf16_t* PROJ, bf16_t* QC, bf16_t* KC, bf16_t* VC, const LAS float* tabl, int gw, int ngw, int lane_in) {
    (void)lane_in; int tid_l = threadIdx.x; asm volatile("" : "+v"(tid_l)); const int lane = tid_l & 63;
    const int hd4 = lane >> 4, c = lane & 15, half = c >> 3, isx2 = (c >> 2) & 1, i0 = (c & 3) * 8;
    float gq[8], gk[8];
#pragma unroll
    for (int i = 0; i < 8; ++i) { gq[i] = P.q_norm[c * 8 + i]; gk[i] = P.k_norm[c * 8 + i]; }
    for (int it0 = gw * 4; it0 < T; it0 += ngw * 4) {
        u32x4 wv[4];
#pragma unroll
        for (int k = 0; k < 4; ++k) { const int t = it0 + k, grp = 2;
            wv[k] = *(const u32x4*)(PROJ + (size_t)t * PP + C_GQ + (grp * 4 + hd4) * 128 + c * 8); }
#pragma unroll
        for (int k = 0; k < 4; ++k) {
            const int t = it0 + k, grp = 2;
            const u32x4 w = wv[k];
            float x[8] = {bflo(w.x), bfhi(w.x), bflo(w.y), bfhi(w.y), bflo(w.z), bfhi(w.z), bflo(w.w), bfhi(w.w)};
            float ss = 0.f;
#pragma unroll
            for (int i = 0; i < 8; ++i) ss += x[i] * x[i];
            ss += __shfl_xor(ss, 1); ss += __shfl_xor(ss, 2); ss += __shfl_xor(ss, 4); ss += __shfl_xor(ss, 8);
            const float rstd = __builtin_amdgcn_rsqf(ss * (1.f / 128.f) + EPS);
            const int sq = t & (SEQ - 1), pos = half ? (sq & 63) : (sq >> 6);
            const LAS float* tp = tabl + (pos * 32 + i0) * 2;
            float o[8];
#pragma unroll
            for (int i = 0; i < 8; ++i) { const float y = x[i] * rstd * (grp < 2 ? gq[i] : gk[i]); const float yp = __shfl_xor(y, 4);
                const float cs = tp[2 * i], sn = tp[2 * i + 1]; o[i] = isx2 ? (y * cs + yp * sn) : (y * cs - yp * sn); }
            u32x4 r; r.x = pk_bf16(o[0], o[1]); r.y = pk_bf16(o[2], o[3]); r.z = pk_bf16(o[4], o[5]); r.w = pk_bf16(o[6], o[7]);
            bf16_t* dst;
            if (grp < 2) dst = QC + (size_t)t * 1024 + (grp * 4 + hd4) * 128 + c * 8;
            else if (hd4 < 2) dst = KC + (size_t)t * 256 + hd4 * 128 + c * 8;
            else { dst = VC + (size_t)t * 256 + (hd4 - 2) * 128 + c * 8; r = w; }
            *(u32x4*)dst = r;
        }
    }
}

namespace na {
constexpr int KROW = 272, VROW = 144, VOFF = 64 * KROW, BUF = 36864, RPB_OFF = 2 * BUF, NA_LDS_END = RPB_OFF + 16384;
__device__ __forceinline__ void na_phase(const bf16_t* PROJ, const bf16_t* VT, const float* rpb, bf16_t* OUT, int opitch, int vcu, int G, LAS unsigned char* lds) {
    const int NU = NBATCH * 8 * 16, per = (NU + G - 1) / G;
    const bool xmap = (G == 256);
    const int ub = vcu * per, nun = xmap ? 6 : max(min(ub + per, NU) - ub, 0);
#define NA_UNIT(i) (xmap ? ((((vcu >> 5) * 12 + 2 * (i) + ((vcu & 31) >> 4)) << 4) + (vcu & 15)) : (ub + (i)))
    int tid_l = threadIdx.x; asm volatile("" : "+v"(tid_l));
    const int tid = tid_l, w = __builtin_amdgcn_readfirstlane(tid >> 6), lane = tid & 63, l15 = lane & 15, g = lane >> 4;
    const int qr = w >> 1, ch = w & 1;
    LAS float* rp = (LAS float*)(lds + RPB_OFF);
    for (int i = tid; i < 8 * 15 * 32; i += NTHREADS) { const int c31 = i & 31, hr = i >> 5; rp[i] = (c31 < 31) ? rpb[hr * 31 + c31] * 1.4426950408889634f : -1e30f; }
    if (nun <= 0) return;
    unsigned boff[2][8];
#pragma unroll
    for (int c2 = 0; c2 < 2; ++c2) { const int qc0 = 16 * (2 * ch + c2), cb = min(max(qc0 - 8, 0), 32), qcol = qc0 + l15, cs = min(max(qcol - 8, 0), 48);
#pragma unroll
        for (int e = 0; e < 8; ++e) { const int kc = cb + (e >> 2) * 16 + 4 * g + (e & 3); boff[c2][e] = ((kc >= cs) && (kc < cs + 16)) ? (unsigned)(kc - qcol + 15) * 4u : 124u; } }
    u32x4 st[2][4];
    unsigned koff[2], klds[2], vlds[2];
#pragma unroll
    for (int i_ = 0; i_ < 2; ++i_) { const int c_ = tid + 512 * i_;
        koff[i_] = (unsigned)((c_ >> 4) * PP + (c_ & 15) * 8) * 2u; klds[i_] = (unsigned)((c_ >> 4) * KROW + (c_ & 15) * 16);
        vlds[i_] = (unsigned)(VOFF + (c_ >> 3) * VROW + (c_ & 7) * 16); }
#define NA_DEC(uu) const int pr_ = (uu) >> 4, r0_ = 4 * ((uu) & 15), b_ = pr_ >> 3, hd_ = pr_ & 7, kr0_ = min(max(r0_ - 4, 0), 56), n_ = min(max(r0_ - 1, 0), 56) - kr0_ + 8
#define NA_LOADT(set, uu, t) do { NA_DEC(uu); { const int kr_ = min(kr0_ + (t), 63); (void)n_;     \
        const char* kb_ = (const char*)(PROJ + ((size_t)b_ * SEQ + (size_t)kr_ * 64) * PP + C_NAK + hd_ * 128); \
        const char* vb_ = (const char*)(VT + ((((size_t)b_ * 64 + kr_) * 8 + hd_) * 128) * 64); \
        st[set][0] = *(const u32x4*)(kb_ + koff[0]); st[set][1] = *(const u32x4*)(kb_ + koff[1]); \
        st[set][2] = *(const u32x4*)(vb_ + (unsigned)tid * 16u); st[set][3] = *(const u32x4*)(vb_ + (unsigned)(tid + 512) * 16u); } } while (0)
#define NA_WRITET(set, t) do { LAS unsigned char* bp_ = lds + ((t) & 1) * BUF; \
        *(LAS u32x4*)(bp_ + klds[0]) = st[set][0]; *(LAS u32x4*)(bp_ + klds[1]) = st[set][1]; *(LAS u32x4*)(bp_ + vlds[0]) = st[set][2]; *(LAS u32x4*)(bp_ + vlds[1]) = st[set][3]; } while (0)
    { const int u0 = NA_UNIT(0); NA_LOADT(0, u0, 0); NA_LOADT(1, u0, 1); }
    const float scale = 0.088388347648318440f, L2E = 1.4426950408889634f;
    for (int ui = 0; ui < nun; ++ui) {
        const bool has_next = (ui + 1 < nun);
        const int u = NA_UNIT(ui), un = has_next ? NA_UNIT(ui + 1) : u;
        const int pr = u >> 4, r0 = 4 * (u & 15), b = pr >> 3, head = pr & 7, kr0 = min(max(r0 - 4, 0), 56), n = min(max(r0 - 1, 0), 56) - kr0 + 8;
        const int r = r0 + qr, rsw = min(max(r - 4, 0), 56);
        const size_t tokq = (size_t)b * SEQ + r * 64;
        bf16x8 qf[2][4];
#pragma unroll
        for (int c2 = 0; c2 < 2; ++c2) { const bf16_t* qp = PROJ + (tokq + 16 * (2 * ch + c2) + l15) * PP + C_NAQ + head * 128 + 8 * g;
#pragma unroll
            for (int dc = 0; dc < 4; ++dc) qf[c2][dc] = *(const bf16x8*)(qp + dc * 32); }
#pragma unroll
        for (int c2 = 0; c2 < 2; ++c2)
#pragma unroll
            for (int dc = 0; dc < 4; ++dc) asm volatile("" : "+v"(qf[c2][dc]));
        float mrun[2] = {-1e30f, -1e30f}, lrun[2] = {0.f, 0.f};
        f32x4 O[2][8];
#pragma unroll
        for (int c2 = 0; c2 < 2; ++c2)
#pragma unroll
            for (int db = 0; db < 8; ++db) O[c2][db] = (f32x4){0.f, 0.f, 0.f, 0.f};
        const LAS unsigned char* rph = (const LAS unsigned char*)(rp + head * 480);
#pragma unroll
        for (int t = 0; t < 12; ++t) {
            NA_WRITET(t % 2, t);
            if (t + 2 < 12) NA_LOADT(t % 2, u, t + 2); else NA_LOADT(t % 2, un, t + 2 - 12);
            __syncthreads();
            const int kr = kr0 + t;
            if (kr >= rsw && kr < rsw + 8) {
                const LAS unsigned char* bp = lds + (t & 1) * BUF;
                const LAS unsigned char* brow = rph + (kr - r + 7) * 128;
                float bias[2][8]; f32x4 S[2][2]; float sv[2][8];
#pragma unroll
                for (int c2 = 0; c2 < 2; ++c2)
#pragma unroll
                    for (int e = 0; e < 8; ++e) bias[c2][e] = *(const LAS float*)(brow + boff[c2][e]);
#pragma unroll
                for (int c2 = 0; c2 < 2; ++c2) {
                    const int cb = min(max(16 * (2 * ch + c2) - 8, 0), 32);
                    const LAS unsigned char* kp = bp + (cb + l15) * KROW + 16 * g;
                    bf16x8 ka[2][4];
#pragma unroll
                    for (int kb = 0; kb < 2; ++kb)
#pragma unroll
                        for (int dc = 0; dc < 4; ++dc) ka[kb][dc] = *(const LAS bf16x8*)(kp + kb * 16 * KROW + dc * 64);
                    S[c2][0] = (f32x4){0.f, 0.f, 0.f, 0.f}; S[c2][1] = (f32x4){0.f, 0.f, 0.f, 0.f};
#pragma unroll
                    for (int dc = 0; dc < 4; ++dc)
#pragma unroll
                        for (int kb = 0; kb < 2; ++kb) S[c2][kb] = __builtin_amdgcn_mfma_f32_16x16x32_bf16(ka[kb][dc], qf[c2][dc], S[c2][kb], 0, 0, 0);
                }
                float tml[2];
#pragma unroll
                for (int c2 = 0; c2 < 2; ++c2) { float tm = -1e30f;
#pragma unroll
                    for (int e = 0; e < 8; ++e) { sv[c2][e] = fmaf(S[c2][e >> 2][e & 3], scale * L2E, bias[c2][e]); tm = fmaxf(tm, sv[c2][e]); }
                    tml[c2] = tm; }
                if (__any(tml[0] > mrun[0] + 40.f || tml[1] > mrun[1] + 40.f)) {
#pragma unroll
                    for (int c2 = 0; c2 < 2; ++c2) { float tm = tml[c2]; tm = fmaxf(tm, __shfl_xor(tm, 16)); tm = fmaxf(tm, __shfl_xor(tm, 32));
                        const float mn = fmaxf(mrun[c2], tm), alpha = __builtin_amdgcn_exp2f(mrun[c2] - mn);
                        mrun[c2] = mn; lrun[c2] *= alpha;
#pragma unroll
                        for (int db = 0; db < 8; ++db) O[c2][db] = O[c2][db] * alpha; }
                }
#pragma unroll
                for (int c2 = 0; c2 < 2; ++c2) { float ps = 0.f;
#pragma unroll
                    for (int e = 0; e < 8; ++e) { const float p = __builtin_amdgcn_exp2f(sv[c2][e] - mrun[c2]); sv[c2][e] = p; ps += p; }
                    lrun[c2] += ps; }
#pragma unroll
                for (int c2 = 0; c2 < 2; ++c2) {
                    const int cb = min(max(16 * (2 * ch + c2) - 8, 0), 32);
                    u32x4 pw; pw.x = pk_bf16(sv[c2][0], sv[c2][1]); pw.y = pk_bf16(sv[c2][2], sv[c2][3]); pw.z = pk_bf16(sv[c2][4], sv[c2][5]); pw.w = pk_bf16(sv[c2][6], sv[c2][7]);
                    const bf16x8 pj = __builtin_bit_cast(bf16x8, pw);
                    const LAS unsigned char* vp = bp + VOFF + l15 * VROW + (cb + 4 * g) * 2;
#pragma unroll
                    for (int dh = 0; dh < 2; ++dh) { u32x2 vlo[4], vhi[4];
#pragma unroll
                        for (int d4 = 0; d4 < 4; ++d4) { vlo[d4] = *(const LAS u32x2*)(vp + (dh * 4 + d4) * 16 * VROW); vhi[d4] = *(const LAS u32x2*)(vp + (dh * 4 + d4) * 16 * VROW + 32); }
#pragma unroll
                        for (int d4 = 0; d4 < 4; ++d4) { const u32x4 aw = {vlo[d4].x, vlo[d4].y, vhi[d4].x, vhi[d4].y};
                            O[c2][dh * 4 + d4] = __builtin_amdgcn_mfma_f32_16x16x32_bf16(__builtin_bit_cast(bf16x8, aw), pj, O[c2][dh * 4 + d4], 0, 0, 0); } }
                }
            }
        }
#pragma unroll
        for (int c2 = 0; c2 < 2; ++c2) {
            float lt = lrun[c2]; lt += __shfl_xor(lt, 16); lt += __shfl_xor(lt, 32);
            const float inv = 1.f / lt;
            bf16_t* op = OUT + (tokq + 16 * (2 * ch + c2) + l15) * opitch + head * 128 + 4 * g;
#pragma unroll
            for (int db = 0; db < 8; ++db) { u32x2 o; o.x = pk_bf16(O[c2][db][0] * inv, O[c2][db][1] * inv); o.y = pk_bf16(O[c2][db][2] * inv, O[c2][db][3] * inv); *(u32x2*)(op + db * 16) = o; }
        }
    }
#undef NA_LOADT
#undef NA_WRITET
#undef NA_DEC
#undef NA_UNIT
}
}

#define XB_TMO      128
#define XB_XCNT(j)  (256  + 64 * (j))
#define XB_XSUB(j)  (1280 + 64 * (j))
#define XB_XGEN(j)  (2304 + 64 * (j))
#define XB_TOP      3328
#define XB_TOPGEN   3392
#define XCD_BAR_WORDS 3456
#define XB_SPIN_CAP (1u << 18)

__device__ __forceinline__ unsigned xb_ld(unsigned* p)              { return __hip_atomic_load(p, __ATOMIC_RELAXED, __HIP_MEMORY_SCOPE_AGENT); }
__device__ __forceinline__ unsigned xb_add(unsigned* p, unsigned v) { return __hip_atomic_fetch_add(p, v, __ATOMIC_RELAXED, __HIP_MEMORY_SCOPE_AGENT); }
__device__ __forceinline__ unsigned xb_xcc_id() { return (unsigned)__builtin_amdgcn_s_getreg((3 << 11) | 20) & 0xFu; }
#define XB_SPIN(cond, bar) do { unsigned _sp = 0; while (cond) { __builtin_amdgcn_s_sleep(1); \
    if ((++_sp & 255u) == 0u) { if (xb_ld(&(bar)[XB_TMO])) break; if (_sp > XB_SPIN_CAP) { atomicAdd(&(bar)[XB_TMO], 1u); break; } } } } while (0)

struct XcdBarrier {
    unsigned* bar; unsigned x;
    volatile LAS unsigned* st;
};

__device__ __forceinline__ XcdBarrier xcd_barrier_post(unsigned* bar, volatile LAS unsigned* st) {
    XcdBarrier b; b.bar = bar; b.x = xb_xcc_id(); b.st = st;
    if (threadIdx.x == 0) (void)xb_add(&bar[XB_XCNT(b.x)], 1u);
    return b;
}
__device__ __forceinline__ void xcd_barrier_complete(unsigned* bar, unsigned x, unsigned& nloc, unsigned& nx) {
    const unsigned G = gridDim.x * gridDim.y * gridDim.z;
    unsigned sum, cnt, mine, sp = 0u;
    for (;;) {
        sum = 0u; cnt = 0u; mine = 0u;
#pragma unroll
        for (unsigned j = 0; j < 16; ++j) { const unsigned c = xb_ld(&bar[XB_XCNT(j)]); sum += c; cnt += (c > 0u) ? 1u : 0u; mine = (j == x) ? c : mine; }
        if (sum == G) break;
        __builtin_amdgcn_s_sleep(1);
        if ((++sp & 255u) == 0u) { if (xb_ld(&bar[XB_TMO])) break; if (sp > XB_SPIN_CAP) { atomicAdd(&bar[XB_TMO], 1u); break; } }
    }
    nloc = mine > 0u ? mine : 1u; nx = cnt > 0u ? cnt : 1u;
}

__device__ __forceinline__ void xcd_barrier(const XcdBarrier& b) {
    asm volatile("s_waitcnt vmcnt(0)" ::: "memory");
    __syncthreads();
    if (threadIdx.x == 0) {
        unsigned* bar = b.bar;
        __builtin_amdgcn_s_waitcnt(0);
        unsigned nloc = b.st[0], nx = b.st[1];
        if (nloc == 0u) { xcd_barrier_complete(bar, b.x, nloc, nx); b.st[0] = nloc; b.st[1] = nx; }
        const unsigned old = xb_add(&bar[XB_XSUB(b.x)], 1u);
        const unsigned gen = old / nloc;
        if (old + 1u == (gen + 1u) * nloc) {
            __builtin_amdgcn_fence(__ATOMIC_RELEASE, "agent");
            asm volatile("s_waitcnt vmcnt(0)" ::: "memory");
            const unsigned og = xb_add(&bar[XB_TOP], 1u);
            const unsigned tg = og / nx;
            if (og + 1u == (tg + 1u) * nx) xb_add(&bar[XB_TOPGEN], 1u);
            else XB_SPIN(xb_ld(&bar[XB_TOPGEN]) == tg, bar);
            __builtin_amdgcn_fence(__ATOMIC_ACQUIRE, "agent");
            xb_add(&bar[XB_XGEN(b.x)], 1u);
            asm volatile("s_waitcnt vmcnt(0)" ::: "memory");
        } else {
            XB_SPIN(xb_ld(&bar[XB_XGEN(b.x)]) == gen, bar);
            __builtin_amdgcn_fence(__ATOMIC_ACQUIRE, "agent");
            asm volatile("s_waitcnt vmcnt(0)" ::: "memory");
        }
    }
    __syncthreads();
}

#ifndef MK_PHASES
#define MK_PHASES 0xffff
#endif
#define PH(k) (((MK_PHASES) >> (k)) & 1)
#ifndef WGM_WIDE
#define WGM_WIDE 4
#endif
#ifndef WGM_N8
#define WGM_N8 4
#endif
#ifndef MK_SKELETON
#define MK_SKELETON 0
#endif
__global__ void __launch_bounds__(NTHREADS, 2) fwd_megakernel(Params P) {
    extern __shared__ __attribute__((aligned(16))) unsigned char lds_raw[];
    cg::grid_group grid = cg::this_grid();
    LAS unsigned char* lds = (LAS unsigned char*)lds_raw;
    const int wave = __builtin_amdgcn_readfirstlane((int)threadIdx.x >> 6);
#define tid ((int)threadIdx.x)
#define lane ((int)threadIdx.x & 63)
    const int G = gridDim.x, bid = blockIdx.x;
    const int vcu = (G % 8 == 0) ? (bid % 8) * (G / 8) + bid / 8 : bid;
    const int gw = vcu * 8 + wave, ngw = G * 8;
    unsigned char* ws = P.ws;
    if (tid < 16) ((LAS unsigned*)(lds + LDS_BYTES - 64))[tid] = 0u;
    __syncthreads();
    unsigned* BARW = (unsigned*)(ws + 512 * 1024);
    if (bid == 0) for (int i = tid; i < XCD_BAR_WORDS; i += NTHREADS) __hip_atomic_store(BARW + i, 0u, __ATOMIC_RELAXED, __HIP_MEMORY_SCOPE_AGENT);
    float* TAB = (float*)(ws + WS_TAB);
    bf16_t* WIN = (bf16_t*)(ws + WS_WIN); bf16_t* WNA = (bf16_t*)(ws + WS_WNA); bf16_t* WGQA = (bf16_t*)(ws + WS_WGQA); bf16_t* WMIX = (bf16_t*)(ws + WS_WMIX);
    bf16_t* WFF1 = (bf16_t*)(ws + WS_WFF1); bf16_t* WFF2 = (bf16_t*)(ws + WS_WFF2); bf16_t* WPG = (bf16_t*)(ws + WS_WPG); bf16_t* WPPJ = (bf16_t*)(ws + WS_WPP);
    bf16_t* PB = (bf16_t*)(ws + WS_PB); bf16_t* VT = (bf16_t*)(ws + WS_VT); bf16_t* PROJ = (bf16_t*)(ws + WS_PROJ);
    bf16_t* YB = (bf16_t*)(ws + WS_Y); bf16_t* HB = (bf16_t*)(ws + WS_H); bf16_t* HID = (bf16_t*)(ws + WS_HID); bf16_t* EP = (bf16_t*)(ws + WS_EP);
    bf16_t* XN = (bf16_t*)P.out;
    bf16_t* MG = (bf16_t*)P.out;
    bf16_t* AB = (bf16_t*)((unsigned char*)P.out + 192 * MiB);
    bf16_t* X1B = (bf16_t*)P.out;
    float* RS2 = (float*)(ws + 64 * 1024); float* RS3 = (float*)(ws + 256 * 1024);
    bf16_t* KC = (bf16_t*)(ws + 964 * MiB); bf16_t* VC = (bf16_t*)(ws + 988 * MiB); bf16_t* QC = nullptr;

    if (PH(0)) {
        for (int idx = bid * NTHREADS + tid; idx < 64 * 32; idx += G * NTHREADS) {
            const int pos = idx >> 5, i = idx & 31;
            const float freq = __builtin_amdgcn_exp2f(-(float)i * (13.287712379549449f / 32.f));
            const float rev = (float)pos * freq * 0.15915494309189535f; const float fr = rev - floorf(rev);
            TAB[idx * 2] = __builtin_amdgcn_cosf(fr); TAB[idx * 2 + 1] = __builtin_amdgcn_sinf(fr);
        }
        LAS float* scr = (LAS float*)(lds + wave * 16384);
        constexpr int NITEMS = (2048 / 64) * (8704 / 32) + 2 * (1024 / 64) * (2048 / 32) + 2 * (2048 / 64) * (2048 / 32) + (2048 / 64) * (8192 / 32) + (8192 / 64) * (2048 / 32) + (256 / 64) * (2048 / 32);
        for (int it = gw; it < NITEMS; it += ngw) {
            int r = it;
            if (transpose_mat(r, P.w_in, 2048, 8704, WIN, scr, lane, true)) continue;
            if (transpose_mat(r, P.w_na, 1024, 2048, WNA, scr, lane, false)) continue;
            if (transpose_mat(r, P.w_gqa, 1024, 2048, WGQA, scr, lane, false)) continue;
            if (transpose_mat(r, P.w_mix, 2048, 2048, WMIX, scr, lane, false)) continue;
            if (transpose_mat(r, P.w_ple_gate, 2048, 2048, WPG, scr, lane, false, P.ln_ple_pre)) continue;
            if (transpose_mat(r, P.w_ff1, 2048, 8192, WFF1, scr, lane, false, P.ln_mlp_pre)) continue;
            if (transpose_mat(r, P.w_ff2, 8192, 2048, WFF2, scr, lane, false)) continue;
            transpose_mat(r, P.w_ple_proj, 256, 2048, WPPJ, scr, lane, false);
        }
        for (size_t i = (size_t)bid * NTHREADS + tid; i < (size_t)T * PLE / 8; i += (size_t)G * NTHREADS) {
            const size_t e = i * 8; const float* src = e < (size_t)TP * PLE ? P.p_p + e : P.p_s + (e - (size_t)TP * PLE);
            const f32x4 a = *(const f32x4*)src, b = *(const f32x4*)(src + 4);
            u32x4 w; w.x = pk_bf16(a[0], a[1]); w.y = pk_bf16(a[2], a[3]); w.z = pk_bf16(b[0], b[1]); w.w = pk_bf16(b[2], b[3]);
            *(u32x4*)(PB + e) = w;
        }
        row_pass<0>(P, nullptr, nullptr, XN, nullptr, P.ln_mix_pre, gw, ngw);
    }
    grid.sync();
    XcdBarrier xbar = xcd_barrier_post(BARW, (volatile LAS unsigned*)(lds + LDS_BYTES - 64));
#if !MK_SKELETON
    if (PH(1)) {
        pg8::Gemm g{XN, WIN, T, 7680, 2048, 2048, 2048}; pg8::StaticOrder S; S.init(T, 7680, G, bid, WGM_WIDE);
        pg8::EpiX<0> E{PROJ, PP, nullptr, 0};
        pg8::gemm_phase<pg8::EpiX<0>, pg8::StaticOrder, true, true>(lds, g, S, E);
        pg8::Gemm g2{WIN + (size_t)7680 * 2048, XN, 1024, T, 2048, 2048, 2048}; pg8::StaticOrder S2; S2.init(1024, T, G, bid);
        pg8::EpiX<5> E2{VT, T, nullptr, 0};
        pg8::gemm_phase<pg8::EpiX<5>, pg8::StaticOrder, true, true>(lds, g2, S2, E2);
    }
    xcd_barrier(xbar);
    if (PH(2)) {
        LAS float* tabl = (LAS float*)(lds + 98304);
        for (int i = tid; i < 64 * 32 * 2; i += NTHREADS) tabl[i] = TAB[i];
        __syncthreads();
        qk_norm_rope(P, PROJ, QC, KC, VC, tabl, gw, ngw, lane);
        na::na_phase(PROJ, VT, P.na_rpb, AB, 1024, vcu, G, lds);
        __syncthreads();
    }
    xcd_barrier(xbar);
    if (PH(3)) {
        const int NU = NBATCH * 2 * 64;
        for (int i = 0;; ++i) {
            int u;
            if (G == 256) { if (i >= 6) break; const int x = vcu >> 5, c = vcu & 31; u = (x * 3 + (i >> 1)) * 64 + (i & 1) * 32 + c; }
            else { u = bid + i * G; if (u >= NU) break; }
            const int pair = u >> 6, uu = u & 63, b = pair >> 1, kvh = pair & 1, h = kvh * 4 + (uu >> 4), qb = uu & 15;
            const gqa::bf16* Q = (const gqa::bf16*)(PROJ + ((size_t)b * SEQ + qb * 256) * PP + C_GQ + h * 128);
            const gqa::bf16* Kp = (const gqa::bf16*)(KC + (size_t)b * SEQ * 256 + kvh * 128);
            const gqa::bf16* Vp = (const gqa::bf16*)(VC + (size_t)b * SEQ * 256 + kvh * 128);
            gqa::attn_dense_body<gqa::bf16>(Q, Kp, Vp, (gqa::bf16*)(AB + (size_t)T * 1024 + ((size_t)b * SEQ + qb * 256) * 1024 + h * 128), SEQ, (char*)lds_raw, P.q_norm, TAB, qb * 256);
            __syncthreads();
        }
    }
    xcd_barrier(xbar);
    if (PH(4)) {
        pg8::SegOrder S; S.base.init(T, DM, G, bid, WGM_N8);
        pg8::Gemm g{AB, WNA, T, DM, 1024, 1024, 1024, (size_t)T * 1024 * 2, (size_t)DM * 1024 * 2};
        pg8::EpiGate E{MG, DM, PROJ + C_GA, PROJ + C_GB, PP};
        pg8::gemm_phase<pg8::EpiGate, pg8::SegOrder, true, true>(lds, g, S, E);
    }
    xcd_barrier(xbar);
    if (PH(5)) {
        pg8::StaticOrder S; S.init(T, DM, G, bid, WGM_N8);
        pg8::Gemm g{MG, WMIX, T, DM, DM, DM, DM}; pg8::EpiX<0> E{YB, DM, nullptr, 0};
        pg8::gemm_phase<pg8::EpiX<0>, pg8::StaticOrder, true, true>(lds, g, S, E);
    }
    xcd_barrier(xbar);
    if (PH(6)) row_pass<1>(P, YB, nullptr, X1B, RS2, P.ln_mix_post, gw, ngw);
    xcd_barrier(xbar);
    if (PH(7))
#pragma unroll
    for (int half = 0; half < 2; ++half) {
        const size_t r0 = (size_t)half * (T / 2);
        {
            pg8::StaticOrder S; S.init(T / 2, DFF, G, bid, WGM_WIDE);
            pg8::Gemm g{X1B + r0 * DM, WFF1, T / 2, DFF, DM, DM, DM}; pg8::EpiX<1> E{HID, HIDP, nullptr, 0, RS2 + r0};
            pg8::gemm_phase<pg8::EpiX<1>, pg8::StaticOrder, true, true>(lds, g, S, E);
        }
        xcd_barrier(xbar);
        {
            pg8::StaticOrder S; S.init(T / 2, DM, G, bid, WGM_N8);
            pg8::Gemm g{HID, WFF2, T / 2, DM, DFF, HIDP, DFF}; pg8::EpiX<0> E{YB + r0 * DM, DM, nullptr, 0};
            pg8::gemm_phase<pg8::EpiX<0>, pg8::StaticOrder, true, true>(lds, g, S, E);
        }
        xcd_barrier(xbar);
    }
    if (PH(8)) row_pass<3>(P, YB, X1B, YB, RS3, P.ln_mlp_post, gw, ngw);
    xcd_barrier(xbar);
    if (PH(9)) {
        pg8::StaticOrder S; S.init(T, DM, G, bid, WGM_N8);
        pg8::Gemm g1{PB, WPPJ, T, DM, PLE, PLE, PLE}; pg8::EpiX<0> E1{EP, DM, nullptr, 0};
        pg8::gemm_phase<pg8::EpiX<0>, pg8::StaticOrder, true, true>(lds, g1, S, E1);
        pg8::Gemm g2{YB, WPG, T, DM, DM, DM, DM}; pg8::EpiX<4> E2{EP, DM, nullptr, 0, RS3};
        pg8::gemm_phase<pg8::EpiX<4>, pg8::StaticOrder, true, true>(lds, g2, S, E2);
    }
    xcd_barrier(xbar);
    if (PH(10)) row_pass<2>(P, EP, YB, nullptr, nullptr, P.ln_ple_post, gw, ngw);
#else
    for (int k = 0; k < 12; ++k) {
        for (size_t i = (size_t)bid * NTHREADS + tid; i < (size_t)T * DM / 64; i += (size_t)G * NTHREADS) P.out[i * 64 + k] = (float)k;
        xcd_barrier(xbar);
    }
#endif
}

#undef tid
#undef lane
extern "C" void kernel_launch(void* const* d_in, const int* in_sizes, int n_in, void* d_out, int out_size, void* d_ws, size_t ws_size, hipStream_t stream) {
    static int grid = 0;
    if (grid == 0) {
        if (n_in != 21 || out_size != T * DM || ws_size < WS_END) { fprintf(stderr, "kernel_launch: unexpected shapes: n_in %d out %d ws %zu (need >= %zu)\n", n_in, out_size, ws_size, (size_t)WS_END); grid = -1; return; }
        int dev = 0, cus = 0, per_cu = 0;
        if (hipGetDevice(&dev) != hipSuccess || hipDeviceGetAttribute(&cus, hipDeviceAttributeMultiprocessorCount, dev) != hipSuccess) { fprintf(stderr, "kernel_launch: device query failed\n"); grid = -1; return; }
        if (hipFuncSetAttribute((const void*)fwd_megakernel, hipFuncAttributeMaxDynamicSharedMemorySize, LDS_BYTES) != hipSuccess) { fprintf(stderr, "kernel_launch: hipFuncSetAttribute failed\n"); grid = -1; return; }
        if (hipOccupancyMaxActiveBlocksPerMultiprocessor(&per_cu, (const void*)fwd_megakernel, NTHREADS, LDS_BYTES) != hipSuccess || per_cu < 1) { fprintf(stderr, "kernel_launch: occupancy query says %d\n", per_cu); per_cu = 1; }
        (void)hipGetLastError();
        grid = cus * per_cu;
    }
    if (grid < 0) return;
    Params p{};
    p.x_p = (const float*)d_in[0]; p.x_s = (const float*)d_in[1]; p.p_p = (const float*)d_in[2]; p.p_s = (const float*)d_in[3];
    p.ln_mix_pre = (const float*)d_in[4]; p.w_in = (const float*)d_in[5]; p.q_norm = (const float*)d_in[6]; p.k_norm = (const float*)d_in[7]; p.na_rpb = (const float*)d_in[8];
    p.w_na = (const float*)d_in[9]; p.w_gqa = (const float*)d_in[10]; p.w_mix = (const float*)d_in[11]; p.ln_mix_post = (const float*)d_in[12]; p.ln_mlp_pre = (const float*)d_in[13];
    p.w_ff1 = (const float*)d_in[14]; p.w_ff2 = (const float*)d_in[15]; p.ln_mlp_post = (const float*)d_in[16]; p.ln_ple_pre = (const float*)d_in[17];
    p.w_ple_gate = (const float*)d_in[18]; p.w_ple_proj = (const float*)d_in[19]; p.ln_ple_post = (const float*)d_in[20];
    p.out = (float*)d_out; p.ws = (unsigned char*)d_ws;
    void* args[] = {&p};
    const hipError_t e = hipLaunchCooperativeKernel((const void*)fwd_megakernel, dim3(grid), dim3(NTHREADS), args, LDS_BYTES, stream);
    if (e != hipSuccess) fprintf(stderr, "kernel_launch: cooperative launch failed: %s (grid %d)\n", hipGetErrorString(e), grid);
}
```

```cpp
#include <hip/hip_runtime.h>
#include <hip/hip_cooperative_groups.h>
#include <hip/hip_bf16.h>
#include <cstdio>
#include <cstdint>
namespace cg = cooperative_groups;
namespace pg8 {
#define PG8_LAS __attribute__((address_space(3)))
typedef unsigned short bf16_t;
typedef short bf16x8 __attribute__((ext_vector_type(8)));
typedef float f32x4 __attribute__((ext_vector_type(4)));
typedef unsigned u32x4 __attribute__((ext_vector_type(4)));
constexpr int BM = 256, BK = 64, HALF = 128, HTB = HALF * BK * 2  , STAGE_BYTES = 8 * HTB, NXCD = 8, WGM = 8;

__host__ __device__ __forceinline__ int lds_byte(int r, int c) { const int st = (r >> 4) * 2 + (c >> 5), rr = r & 15, cc = c & 31, ob = rr * 64 + cc * 2; return st * 1024 + (ob ^ (((ob >> 9) & 1) << 5)); }
__host__ __device__ __forceinline__ void stage_rc(int b, int& R, int& C) { const int st = b / 1024, sb = b % 1024, swz = sb ^ (((sb >> 9) & 1) << 5); R = (st >> 1) * 16 + swz / 64; C = (st & 1) * 32 + (swz % 64) / 2; }
__host__ __device__ __forceinline__ int perm32(int rho) { const int n = rho >> 4, i = rho & 15; return 8 * (i >> 2) + 4 * n + (i & 3); }

struct Unit { int pm, pn, seg; };
struct Gemm { const bf16_t* A; const bf16_t* Bt; int M, N, K, lda, ldb; size_t segA = 0, segB = 0; };

struct StaticOrder {
    int nM, nN, nwg, G, c, wgm;
    __host__ __device__ void init(int M, int N, int G_, int c_, int wgm_ = WGM) { nM = M / BM; nN = N / BM; nwg = nM * nN; G = G_; c = c_; wgm = wgm_; }
    __host__ __device__ bool next(int i, Unit& u) const {
        const long L = (long)i * G + c; if (L >= nwg) return false;
        int wgid = (int)L;
#if defined(PG8_ILV) && PG8_ILV
        if (nwg % (NXCD * 32) == 0 && G == NXCD * 32) wgid = ((wgid / (NXCD * 32)) * NXCD + (wgid % NXCD)) * 32 + (wgid % (NXCD * 32)) / NXCD;
        else
#endif
        { const int q = nwg / NXCD, r = nwg % NXCD, xcd = wgid % NXCD, off = wgid / NXCD; wgid = (xcd < r ? xcd * (q + 1) : r * (q + 1) + (xcd - r) * q) + off; }
        const int nig = wgm * nN, gid = wgid / nig, fm = gid * wgm, gsz = (nM - fm) < wgm ? (nM - fm) : wgm;
        u.pm = fm + ((wgid % nig) % gsz); u.pn = (wgid % nig) / gsz; u.seg = 0; return true;
    }
    __device__ __forceinline__ void a_ready(const Unit&) const {}
    __device__ __forceinline__ void done(const Unit&) const {}
};

__device__ __forceinline__ unsigned cvt_pk_bf16(float lo, float hi) { unsigned r; asm volatile("v_cvt_pk_bf16_f32 %0, %1, %2" : "=v"(r) : "v"(lo), "v"(hi)); return r; }
typedef float f32x2 __attribute__((ext_vector_type(2)));
__device__ __forceinline__ f32x2 gelu_pk(f32x2 v) {
    const f32x2 av = __builtin_elementwise_abs(v), d = av * 0.2316418882f + 1.0f;
    f32x2 t; t.x = __builtin_amdgcn_rcpf(d.x); t.y = __builtin_amdgcn_rcpf(d.y);
    f32x2 q = t * 0.5307027145f + (-0.7265760135f); q = q * t + 0.7107068705f; q = q * t + (-0.142248368f); q = q * t + 0.127414796f; q = q * t;
    const f32x2 s = (v * v) * (-0.72134752044f);
    f32x2 e; e.x = __builtin_amdgcn_exp2f(s.x); e.y = __builtin_amdgcn_exp2f(s.y);
    const f32x2 m = v * (q * e), r = v - m;
    f32x2 o; o.x = v.x < 0.f ? m.x : r.x; o.y = v.y < 0.f ? m.y : r.y; return o;
}

template <int ACT  > struct EpiBf16 {
    static constexpr bool PERM = true, AFTER_DRAIN = false; static_assert(ACT == 0 || ACT == 1, "EpiBf16: ACT is 0 (none) or 1 (gelu_pk)");
    bf16_t* O; int ldc; const float* bias; int split_cols; size_t split_stride; float scale0;
    __device__ __forceinline__ void operator()(const f32x4 (&acc)[2][2][4][2], const Unit& u, int wr, int wc, int fr, int fq) const {
        const int row0 = u.pm * BM + wr * 64 + fr; int colt = u.pn * BM; bf16_t* base = O;
        float sc = 1.f; if (split_cols) { const int t = colt / split_cols; base += (size_t)t * split_stride; colt -= t * split_cols; if (t == 0) sc = scale0; }
        const int col0 = colt + wc * 32 + 8 * fq, bcol0 = u.pn * BM + wc * 32 + 8 * fq;
        f32x4 bv[2][2];
#pragma unroll
        for (int bj = 0; bj < 2; ++bj)
#pragma unroll
            for (int n = 0; n < 2; ++n) bv[bj][n] = bias ? *(const f32x4*)(bias + bcol0 + bj * HALF + 4 * n) : (f32x4){0.f, 0.f, 0.f, 0.f};
#pragma unroll
        for (int ai = 0; ai < 2; ++ai)
#pragma unroll
            for (int m = 0; m < 4; ++m) { bf16_t* rowp = base + (size_t)(row0 + ai * HALF + m * 16) * ldc + col0;
#pragma unroll
                for (int bj = 0; bj < 2; ++bj) { f32x4 v0 = acc[ai][bj][m][0] + bv[bj][0], v1 = acc[ai][bj][m][1] + bv[bj][1];
                    if (ACT == 1) { f32x2 a = gelu_pk((f32x2){v0[0], v0[1]}), b = gelu_pk((f32x2){v0[2], v0[3]}), c = gelu_pk((f32x2){v1[0], v1[1]}), d = gelu_pk((f32x2){v1[2], v1[3]});
                        v0 = (f32x4){a.x, a.y, b.x, b.y}; v1 = (f32x4){c.x, c.y, d.x, d.y}; }
                    v0 = v0 * sc; v1 = v1 * sc; u32x4 w; w.x = cvt_pk_bf16(v0[0], v0[1]); w.y = cvt_pk_bf16(v0[2], v0[3]); w.z = cvt_pk_bf16(v1[0], v1[1]); w.w = cvt_pk_bf16(v1[2], v1[3]);
                    *(u32x4*)(rowp + bj * HALF) = w; } }
    }
};
template <class Epi, class Sched, bool ALIGN_EPI = false, bool SP2 = false>
__device__ __forceinline__ void gemm_phase(PG8_LAS unsigned char* lds, const Gemm g, const Sched& S, const Epi& E) {
    int tid_l = threadIdx.x; asm volatile("" : "+v"(tid_l));
    const int tid = tid_l, wid = __builtin_amdgcn_readfirstlane(tid >> 6), lane = tid & 63, wr = wid >> 2, wc = wid & 3, fr = lane & 15, fq = lane >> 4;
    const int K = g.K, nt = K / BK;
    unsigned voffA[2], voffB[2];
#pragma unroll
    for (int i = 0; i < 2; ++i) { int R, C; stage_rc(tid * 16 + i * 8192, R, C); const int Rb = Epi::PERM ? ((R & ~31) + perm32(R & 31)) : R;
        voffA[i] = (unsigned)(R * g.lda + C) * 2u; voffB[i] = (unsigned)(Rb * g.ldb + C) * 2u; }
    const size_t kstep = (size_t)(BK * 2);
    const size_t hstepA = (size_t)HALF * g.lda * 2, hstepB = (size_t)HALF * g.ldb * 2;
    const size_t tstepA = 2 * hstepA, tstepB = 2 * hstepB;
    const unsigned ldsw = (unsigned)wid * 1024u;
    const int aoff = lds_byte(wr * 64 + fr, fq * 8), boff = lds_byte(wc * 32 + fr, fq * 8);
#define PG8_SA(b, h) (((b) * 2 + (h)) * HTB)
#define PG8_SB(b, h) ((4 + (b) * 2 + (h)) * HTB)
#define PG8_STAGE(bufoff, gbase, voff) do { _Pragma("unroll") for (int _i = 0; _i < 2; ++_i) \
        __builtin_amdgcn_global_load_lds((const unsigned*)((const char*)(gbase) + (voff)[_i]), (PG8_LAS unsigned*)(lds + (bufoff) + ldsw + _i * 8192), 16, 0, 0); } while (0)
#define PG8_LDA(dst, b, h) do { _Pragma("unroll") for (int m = 0; m < 4; ++m) _Pragma("unroll") for (int k = 0; k < 2; ++k) dst[m][k] = *(const PG8_LAS bf16x8*)(lds + PG8_SA(b, h) + aoff + m * 2048 + k * 1024); } while (0)
#define PG8_LDB(dst, b, h) do { _Pragma("unroll") for (int n = 0; n < 2; ++n) _Pragma("unroll") for (int k = 0; k < 2; ++k) dst[n][k] = *(const PG8_LAS bf16x8*)(lds + PG8_SB(b, h) + boff + n * 2048 + k * 1024); } while (0)
#define PG8_MMA(ai, bj, At, Bt) do { __builtin_amdgcn_s_setprio(1); _Pragma("unroll") for (int m = 0; m < 4; ++m) _Pragma("unroll") for (int n = 0; n < 2; ++n) _Pragma("unroll") for (int k = 0; k < 2; ++k) \
        acc[ai][bj][m][n] = __builtin_amdgcn_mfma_f32_16x16x32_bf16(Bt[n][k], At[m][k], acc[ai][bj][m][n], 0, 0, 0); __builtin_amdgcn_s_setprio(0); } while (0)
#define PG8_WAIT_V(n) asm volatile("s_waitcnt vmcnt(" #n ")" ::: "memory")
#define PG8_WAIT_L(n) asm volatile("s_waitcnt lgkmcnt(" #n ")" ::: "memory")
#define PG8_BAR __builtin_amdgcn_s_barrier()
#define PG8_SCHED __builtin_amdgcn_sched_barrier(0)
    Unit cur, nxt; int ui = 0;
    if (!S.next(0, cur)) return;
    f32x4 acc[2][2][4][2];
#pragma unroll
    for (int a = 0; a < 2; ++a)
#pragma unroll
        for (int b = 0; b < 2; ++b)
#pragma unroll
            for (int m = 0; m < 4; ++m)
#pragma unroll
                for (int n = 0; n < 2; ++n) acc[a][b][m][n] = (f32x4){0.f, 0.f, 0.f, 0.f};
    bf16x8 At[4][2], B0[2][2], B1[2][2];
    const char* cA = (const char*)g.A + (size_t)cur.seg * g.segA + (size_t)cur.pm * tstepA; const char* cB = (const char*)g.Bt + (size_t)cur.seg * g.segB + (size_t)cur.pn * tstepB;
    S.a_ready(cur);
    if constexpr (SP2) {
        PG8_STAGE(PG8_SB(0, 0), cB, voffB); PG8_STAGE(PG8_SB(0, 1), cB + hstepB, voffB); PG8_STAGE(PG8_SA(0, 0), cA, voffA); PG8_STAGE(PG8_SA(0, 1), cA + hstepA, voffA);
        if (wr == 1) PG8_BAR;
        PG8_WAIT_V(2); PG8_BAR;
        PG8_STAGE(PG8_SB(1, 0), cB + kstep, voffB); PG8_STAGE(PG8_SA(1, 0), cA + kstep, voffA); PG8_STAGE(PG8_SB(1, 1), cB + hstepB + kstep, voffB);
        PG8_WAIT_V(6); PG8_BAR;
    } else {
        PG8_STAGE(PG8_SB(0, 0), cB, voffB); PG8_STAGE(PG8_SA(0, 0), cA, voffA); PG8_STAGE(PG8_SB(0, 1), cB + hstepB, voffB); PG8_STAGE(PG8_SA(0, 1), cA + hstepA, voffA);
        if (wr == 1) PG8_BAR;
        PG8_WAIT_V(4); PG8_BAR;
        PG8_STAGE(PG8_SB(1, 0), cB + kstep, voffB); PG8_STAGE(PG8_SA(1, 0), cA + kstep, voffA); PG8_STAGE(PG8_SB(1, 1), cB + hstepB + kstep, voffB);
        PG8_WAIT_V(6); PG8_BAR;
    }
    for (;;) {
        const bool has_next = S.next(ui + 1, nxt);
        const char* nA = has_next ? (const char*)g.A + (size_t)nxt.seg * g.segA + (size_t)nxt.pm * tstepA : cA; const char* nB = has_next ? (const char*)g.Bt + (size_t)nxt.seg * g.segB + (size_t)nxt.pn * tstepB : cB;
        for (int t = 0; t < nt; t += 2) {
            const bool last = (t == nt - 2);
            const char* a1 = cA + (size_t)(t + 1) * kstep;
            const char* a2 = last ? nA : cA + (size_t)(t + 2) * kstep; const char* b2 = last ? nB : cB + (size_t)(t + 2) * kstep;
            const char* a3 = a2 + kstep; const char* b3 = b2 + kstep;
            if (last && has_next) S.a_ready(nxt);
            if constexpr (SP2) {
            PG8_LDB(B0, 0, 0); PG8_LDB(B1, 0, 1); PG8_SCHED; PG8_LDA(At, 0, 0); PG8_STAGE(PG8_SA(1, 1), a1 + hstepA, voffA);
            PG8_WAIT_V(8); PG8_WAIT_L(0); PG8_BAR; PG8_MMA(0, 0, At, B0); PG8_MMA(0, 1, At, B1); PG8_BAR; PG8_SCHED;
            PG8_LDA(At, 0, 1); PG8_STAGE(PG8_SB(0, 0), b2, voffB); PG8_STAGE(PG8_SB(0, 1), b2 + hstepB, voffB); PG8_STAGE(PG8_SA(0, 0), a2, voffA);
            PG8_WAIT_V(8); PG8_WAIT_L(0); PG8_BAR; PG8_MMA(1, 0, At, B0); PG8_MMA(1, 1, At, B1); PG8_BAR; PG8_SCHED;
            PG8_LDB(B0, 1, 0); PG8_LDB(B1, 1, 1); PG8_SCHED; PG8_LDA(At, 1, 0); PG8_STAGE(PG8_SA(0, 1), a2 + hstepA, voffA);
            PG8_WAIT_V(8); PG8_WAIT_L(0); PG8_BAR; PG8_MMA(0, 0, At, B0); PG8_MMA(0, 1, At, B1); PG8_BAR; PG8_SCHED;
            PG8_LDA(At, 1, 1); PG8_STAGE(PG8_SB(1, 0), b3, voffB); PG8_STAGE(PG8_SB(1, 1), b3 + hstepB, voffB); PG8_STAGE(PG8_SA(1, 0), a3, voffA);
            PG8_WAIT_V(8); PG8_WAIT_L(0); PG8_BAR; PG8_MMA(1, 0, At, B0); PG8_MMA(1, 1, At, B1); PG8_BAR; PG8_SCHED;
            } else {
            PG8_LDB(B0, 0, 0); PG8_SCHED; PG8_LDA(At, 0, 0); PG8_STAGE(PG8_SA(1, 1), a1 + hstepA, voffA);
            PG8_WAIT_L(8); PG8_BAR; PG8_WAIT_L(0); PG8_MMA(0, 0, At, B0); PG8_BAR; PG8_SCHED;
            PG8_LDB(B1, 0, 1); PG8_STAGE(PG8_SB(0, 0), b2, voffB);
            PG8_BAR; PG8_WAIT_L(0); PG8_MMA(0, 1, At, B1); PG8_BAR;
            PG8_LDA(At, 0, 1); PG8_STAGE(PG8_SA(0, 0), a2, voffA);
            PG8_BAR; PG8_WAIT_L(0); PG8_MMA(1, 0, At, B0); PG8_BAR; PG8_SCHED;
            PG8_STAGE(PG8_SB(0, 1), b2 + hstepB, voffB);
            PG8_WAIT_V(6); PG8_BAR; PG8_MMA(1, 1, At, B1); PG8_BAR;
            PG8_LDB(B0, 1, 0); PG8_SCHED; PG8_LDA(At, 1, 0); PG8_STAGE(PG8_SA(0, 1), a2 + hstepA, voffA);
            PG8_WAIT_L(8); PG8_BAR; PG8_WAIT_L(0); PG8_MMA(0, 0, At, B0); PG8_BAR; PG8_SCHED;
            PG8_LDB(B1, 1, 1); PG8_STAGE(PG8_SB(1, 0), b3, voffB);
            PG8_BAR; PG8_WAIT_L(0); PG8_MMA(0, 1, At, B1); PG8_BAR;
            PG8_LDA(At, 1, 1); PG8_STAGE(PG8_SA(1, 0), a3, voffA);
            PG8_BAR; PG8_WAIT_L(0); PG8_MMA(1, 0, At, B0); PG8_BAR; PG8_SCHED;
            PG8_STAGE(PG8_SB(1, 1), b3 + hstepB, voffB);
            PG8_WAIT_V(6); PG8_BAR; PG8_MMA(1, 1, At, B1); PG8_BAR;
            }
        }
        if constexpr (ALIGN_EPI) { if (wr == 0) PG8_BAR; }
        bool keep_acc = false;
        if constexpr (!Epi::AFTER_DRAIN) { if constexpr (Epi::SEG) { if (cur.seg == 0) { E.mid(acc, cur, wr, wc, fr, fq); keep_acc = true; } else E(acc, cur, wr, wc, fr, fq); } else E(acc, cur, wr, wc, fr, fq); S.done(cur); }
        if (!has_next) break;
        if (!keep_acc)
#pragma unroll
        for (int a = 0; a < 2; ++a)
#pragma unroll
            for (int b = 0; b < 2; ++b)
#pragma unroll
                for (int m = 0; m < 4; ++m)
#pragma unroll
                    for (int n = 0; n < 2; ++n) acc[a][b][m][n] = (f32x4){0.f, 0.f, 0.f, 0.f};
        cur = nxt; cA = nA; cB = nB; ++ui;
        if constexpr (ALIGN_EPI) { if (wr == 1) PG8_BAR; }
    }
    PG8_WAIT_V(0);
    if constexpr (!ALIGN_EPI) { if (wr == 0) PG8_BAR; }
    PG8_BAR;
    if constexpr (Epi::AFTER_DRAIN) { E.fused(acc, cur, wr, wc, fr, fq, lds, wid, lane); S.done(cur); }
#undef PG8_SA
#undef PG8_SB
#undef PG8_STAGE
#undef PG8_LDA
#undef PG8_LDB
#undef PG8_MMA
#undef PG8_WAIT_V
#undef PG8_WAIT_L
#undef PG8_BAR
#undef PG8_SCHED
}
}
namespace pg8 {
__device__ __forceinline__ float bf_lo(unsigned u) { return __uint_as_float(u << 16); }
__device__ __forceinline__ float bf_hi(unsigned u) { return __uint_as_float(u & 0xffff0000u); }
__device__ __forceinline__ float sigm(float x) { return __builtin_amdgcn_rcpf(1.f + __builtin_amdgcn_exp2f(-1.4426950408889634f * x)); }
template <int MODE> struct EpiX {
    static constexpr bool PERM = true, AFTER_DRAIN = false, SEG = false;
    bf16_t* O; int ldc; const bf16_t* G; int ldg; const float* RS = nullptr;
    __device__ __forceinline__ void operator()(const f32x4 (&acc)[2][2][4][2], const Unit& u, int wr, int wc, int fr, int fq) const {
        const int row0 = u.pm * BM + wr * 64 + fr; const int col0 = u.pn * BM + wc * 32 + 8 * fq;
#pragma unroll
        for (int ai = 0; ai < 2; ++ai)
#pragma unroll
            for (int m = 0; m < 4; ++m) { const size_t row = (size_t)(row0 + ai * HALF + m * 16);
#pragma unroll
                for (int bj = 0; bj < 2; ++bj) { const int col = col0 + bj * HALF;
                    const f32x4 a0 = acc[ai][bj][m][0], a1 = acc[ai][bj][m][1];
                    float v[8] = {a0[0], a0[1], a0[2], a0[3], a1[0], a1[1], a1[2], a1[3]};
                    bf16_t* op = O + row * ldc + col;
                    if (MODE == 5) op = O + ((((size_t)(col >> 12) * 64 + ((col >> 6) & 63)) * 8 + (row >> 7)) * 128 + (row & 127)) * 64 + (col & 63);
                    if (MODE == 1) {
                        const float rs = RS[row], rs2 = rs * rs;
#pragma unroll
                        for (int i = 0; i < 8; ++i) { const float r = fmaxf(v[i], 0.f); v[i] = r * r * rs2; } }
                    if (MODE == 2 || MODE == 3) { const u32x4 gw = *(const u32x4*)(G + row * ldg + col);
                        const float gf[8] = {bf_lo(gw.x), bf_hi(gw.x), bf_lo(gw.y), bf_hi(gw.y), bf_lo(gw.z), bf_hi(gw.z), bf_lo(gw.w), bf_hi(gw.w)};
#pragma unroll
                        for (int i = 0; i < 8; ++i) v[i] = sigm(gf[i]) * v[i]; }
                    if (MODE == 3) { const u32x4 ow = *(const u32x4*)op;
                        const float of[8] = {bf_lo(ow.x), bf_hi(ow.x), bf_lo(ow.y), bf_hi(ow.y), bf_lo(ow.z), bf_hi(ow.z), bf_lo(ow.w), bf_hi(ow.w)};
#pragma unroll
                        for (int i = 0; i < 8; ++i) v[i] += of[i]; }
                    if (MODE == 4) { const u32x4 ow = *(const u32x4*)op;
                        const float of[8] = {bf_lo(ow.x), bf_hi(ow.x), bf_lo(ow.y), bf_hi(ow.y), bf_lo(ow.z), bf_hi(ow.z), bf_lo(ow.w), bf_hi(ow.w)};
                        const float rs = RS[row];
#pragma unroll
                        for (int i = 0; i < 8; ++i) v[i] = of[i] * sigm(v[i] * rs); }
                    u32x4 w; w.x = cvt_pk_bf16(v[0], v[1]); w.y = cvt_pk_bf16(v[2], v[3]); w.z = cvt_pk_bf16(v[4], v[5]); w.w = cvt_pk_bf16(v[6], v[7]);
                    *(u32x4*)op = w; }
                if (MODE >= 2) asm volatile("" ::: "memory"); }
    }
};

struct SegOrder { StaticOrder base;
    __device__ bool next(int i, Unit& u) const { if (!base.next(i >> 1, u)) return false; u.seg = i & 1; return true; }
    __device__ __forceinline__ void a_ready(const Unit&) const {}
    __device__ __forceinline__ void done(const Unit&) const {} };
struct EpiGate {
    static constexpr bool PERM = true, AFTER_DRAIN = false, SEG = true;
    bf16_t* O; int ldc; const bf16_t* GA; const bf16_t* GB; int ldg;
    static __device__ __forceinline__ float eneg(float x) { return __builtin_amdgcn_exp2f(-1.4426950408889634f * fminf(fmaxf(x, -30.f), 30.f)); }
    __device__ __forceinline__ void mid(f32x4 (&acc)[2][2][4][2], const Unit& u, int wr, int wc, int fr, int fq) const {
        const int row0 = u.pm * BM + wr * 64 + fr; const int col0 = u.pn * BM + wc * 32 + 8 * fq;
#pragma unroll
        for (int ai = 0; ai < 2; ++ai)
#pragma unroll
            for (int m = 0; m < 4; ++m) { const size_t row = (size_t)(row0 + ai * HALF + m * 16);
#pragma unroll
                for (int bj = 0; bj < 2; ++bj) { const int col = col0 + bj * HALF;
                    const u32x4 aw = *(const u32x4*)(GA + row * ldg + col), bw = *(const u32x4*)(GB + row * ldg + col);
                    const float ga[8] = {bf_lo(aw.x), bf_hi(aw.x), bf_lo(aw.y), bf_hi(aw.y), bf_lo(aw.z), bf_hi(aw.z), bf_lo(aw.w), bf_hi(aw.w)};
                    const float gb[8] = {bf_lo(bw.x), bf_hi(bw.x), bf_lo(bw.y), bf_hi(bw.y), bf_lo(bw.z), bf_hi(bw.z), bf_lo(bw.w), bf_hi(bw.w)};
                    float r[8];
#pragma unroll
                    for (int i = 0; i < 8; ++i) r[i] = (1.f + eneg(gb[i])) * __builtin_amdgcn_rcpf(1.f + eneg(ga[i]));
                    acc[ai][bj][m][0] = acc[ai][bj][m][0] * (f32x4){r[0], r[1], r[2], r[3]}; acc[ai][bj][m][1] = acc[ai][bj][m][1] * (f32x4){r[4], r[5], r[6], r[7]}; }
                asm volatile("" ::: "memory"); }
    }
    __device__ __forceinline__ void operator()(const f32x4 (&acc)[2][2][4][2], const Unit& u, int wr, int wc, int fr, int fq) const {
        const int row0 = u.pm * BM + wr * 64 + fr; const int col0 = u.pn * BM + wc * 32 + 8 * fq;
#pragma unroll
        for (int ai = 0; ai < 2; ++ai)
#pragma unroll
            for (int m = 0; m < 4; ++m) { const size_t row = (size_t)(row0 + ai * HALF + m * 16);
#pragma unroll
                for (int bj = 0; bj < 2; ++bj) { const int col = col0 + bj * HALF;
                    const u32x4 bw = *(const u32x4*)(GB + row * ldg + col);
                    const float gb[8] = {bf_lo(bw.x), bf_hi(bw.x), bf_lo(bw.y), bf_hi(bw.y), bf_lo(bw.z), bf_hi(bw.z), bf_lo(bw.w), bf_hi(bw.w)};
                    const f32x4 a0 = acc[ai][bj][m][0], a1 = acc[ai][bj][m][1];
                    float v[8] = {a0[0], a0[1], a0[2], a0[3], a1[0], a1[1], a1[2], a1[3]};
#pragma unroll
                    for (int i = 0; i < 8; ++i) v[i] *= __builtin_amdgcn_rcpf(1.f + eneg(gb[i]));
                    u32x4 w; w.x = cvt_pk_bf16(v[0], v[1]); w.y = cvt_pk_bf16(v[2], v[3]); w.z = cvt_pk_bf16(v[4], v[5]); w.w = cvt_pk_bf16(v[6], v[7]);
                    *(u32x4*)(O + row * ldc + col) = w; }
                asm volatile("" ::: "memory"); }
    }
};
}
namespace gqa {
using bf16 = __hip_bfloat16;
constexpr int   D = 128, NW = 8, QBLK = 32, KVBLK = 64;
constexpr float SCALE = 0.088388347648318440f;
constexpr float THR = 8.f;
using f32x4 = __attribute__((ext_vector_type(4))) float;
constexpr int SDEPTH = 1;
constexpr int LDQ = 7680, LDK = 256, LDO = 1024;
constexpr size_t SHM_V = KVBLK * D * 2, SHM_K = KVBLK * D * 2, SHM_ATTN = 2 * SHM_V + 2 * SHM_K + NW * 64 * 4;
using bf16x8 = __attribute__((ext_vector_type(8))) short;
using s16x4  = __attribute__((ext_vector_type(4))) short;
using f32x16 = __attribute__((ext_vector_type(16))) float;
using f32x8  = __attribute__((ext_vector_type(8))) float;
using u32x4  = __attribute__((ext_vector_type(4))) unsigned;
#define KSWZ(row, colB) ((row) * 256 + ((colB) ^ (((row) & 7) << 4)))
#define SBAR() __builtin_amdgcn_sched_barrier(0)
__device__ __forceinline__ int crow(int r, int hi) { return (r & 3) + 8 * (r >> 2) + 4 * hi; }
__device__ __forceinline__ unsigned cvtpk(float lo, float hi) {
  unsigned r; asm volatile("v_cvt_pk_bf16_f32 %0, %1, %2" : "=v"(r) : "v"(lo), "v"(hi)); return r;
}
template <typename TIn> struct Stage;
template <> struct Stage<bf16>  { using T = bf16x8;
  __device__ static __forceinline__ T ld8(const bf16* p) { return *reinterpret_cast<const bf16x8*>(p); }
  __device__ static __forceinline__ bf16x8 tobf(T x) { return x; } };
template <> struct Stage<float> { using T = f32x8;
  __device__ static __forceinline__ T ld8(const float* p) { return *reinterpret_cast<const f32x8*>(p); }
  __device__ static __forceinline__ bf16x8 tobf(T x) {
    u32x4 w = {cvtpk(x[0], x[1]), cvtpk(x[2], x[3]), cvtpk(x[4], x[5]), cvtpk(x[6], x[7])}; return *reinterpret_cast<bf16x8*>(&w); } };

__device__ __forceinline__ void partialSM(f32x16& p0, f32x16& p1, float& m_reg, float& mn, float& alpha) {
  constexpr float C = SCALE * 1.4426950408889634f;
  float pmax = p0[0]; for (int r = 1; r < 16; ++r) pmax = fmaxf(pmax, p0[r]); for (int r = 0; r < 16; ++r) pmax = fmaxf(pmax, p1[r]);
  { auto rr = __builtin_amdgcn_permlane32_swap(__float_as_uint(pmax), __float_as_uint(pmax), false, false);
    pmax = fmaxf(__uint_as_float(rr[0]), __uint_as_float(rr[1])); }
  if (__builtin_expect(__all(pmax - m_reg <= THR / SCALE), 1)) { mn = m_reg; alpha = 1.f; }
  else { mn = fmaxf(m_reg, pmax); alpha = __builtin_amdgcn_exp2f((m_reg - mn) * C); m_reg = mn; }
  float mnC = -mn * C;
  for (int r = 0; r < 16; ++r) p0[r] = fmaf(p0[r], C, mnC); for (int r = 0; r < 16; ++r) p1[r] = fmaf(p1[r], C, mnC);
  for (int r = 0; r < 16; ++r) p0[r] = __builtin_amdgcn_exp2f(p0[r]);
}
__device__ __forceinline__ void finishSM(f32x16& p0, f32x16& p1, float alpha, float& l_reg, bf16x8& pa0, bf16x8& pa1, bf16x8& pa2, bf16x8& pa3) {
  for (int r = 0; r < 16; ++r) p1[r] = __builtin_amdgcn_exp2f(p1[r]);
  float ps = 0; for (int r = 0; r < 16; ++r) ps += p0[r]; for (int r = 0; r < 16; ++r) ps += p1[r];
  { auto rr = __builtin_amdgcn_permlane32_swap(__float_as_uint(ps), __float_as_uint(ps), false, false);
    ps = __uint_as_float(rr[0]) + __uint_as_float(rr[1]); }
  l_reg = l_reg * alpha + ps;
#define PK4(P, BASE, OUT) do { unsigned a0 = cvtpk(P[BASE + 0], P[BASE + 1]), a1 = cvtpk(P[BASE + 2], P[BASE + 3]);   \
    unsigned b0 = cvtpk(P[BASE + 4], P[BASE + 5]), b1 = cvtpk(P[BASE + 6], P[BASE + 7]);                              \
    auto r0 = __builtin_amdgcn_permlane32_swap(a0, b0, false, false); auto r1 = __builtin_amdgcn_permlane32_swap(a1, b1, false, false); \
    u32x4 w = {r0[0], r1[0], r0[1], r1[1]}; OUT = *reinterpret_cast<bf16x8*>(&w); } while (0)
  PK4(p0, 0, pa0); PK4(p0, 8, pa1); PK4(p1, 0, pa2); PK4(p1, 8, pa3);
#undef PK4
}
__device__ __forceinline__ void qkt(f32x16& p0, f32x16& p1, const bf16* Ks, const bf16x8* qr, int r32, int hi) {
  p0 = f32x16{}; p1 = f32x16{};
  for (int d0 = 0; d0 < 8; ++d0) { int cb = (d0 * 16 + hi * 8) * 2;
    bf16x8 b0 = *reinterpret_cast<const bf16x8*>((const char*)Ks + KSWZ(r32, cb));
    bf16x8 b1 = *reinterpret_cast<const bf16x8*>((const char*)Ks + KSWZ(32 + r32, cb));
    p0 = __builtin_amdgcn_mfma_f32_32x32x16_bf16(b0, qr[d0], p0, 0, 0, 0);
    p1 = __builtin_amdgcn_mfma_f32_32x32x16_bf16(b1, qr[d0], p1, 0, 0, 0); }
}
__device__ __forceinline__ int v_st(int k, int c) { const int kk = (k & ~0xC) | ((k & 4) << 1) | ((k & 8) >> 1); return ((kk >> 3) * 4 + (c >> 5)) * 512 + ((kk & 7) * 32 + (c & 31)) * 2; }
__device__ __forceinline__ int v_rd_base(int lane) { return ((lane & 3) << 3) | (((lane >> 2) & 3) << 6) | (((lane >> 4) & 1) << 5) | (((lane >> 5) & 1) << 8); }
constexpr int v_rd_off(int d0, int ks, int half) { return d0 * 512 + ks * 4096 + half * 2048; }
template <int OFF> __device__ __forceinline__ s16x4 tr_read(int vb) {
  s16x4 r; asm volatile("ds_read_b64_tr_b16 %0, %1 offset:%2" : "=&v"(r) : "v"(vb), "i"(OFF) : "memory"); return r;
}
template <int D0> __device__ __forceinline__ void pv_one(f32x16& od, int vb, bf16x8 pa0, bf16x8 pa1, bf16x8 pa2, bf16x8 pa3) {
  const s16x4 l0 = tr_read<v_rd_off(D0, 0, 0)>(vb), h0 = tr_read<v_rd_off(D0, 0, 1)>(vb), l1 = tr_read<v_rd_off(D0, 1, 0)>(vb), h1 = tr_read<v_rd_off(D0, 1, 1)>(vb);
  const s16x4 l2 = tr_read<v_rd_off(D0, 2, 0)>(vb), h2 = tr_read<v_rd_off(D0, 2, 1)>(vb), l3 = tr_read<v_rd_off(D0, 3, 0)>(vb), h3 = tr_read<v_rd_off(D0, 3, 1)>(vb);
  asm volatile("s_waitcnt lgkmcnt(0)" ::: "memory"); SBAR();
#define PK(L, H) (bf16x8){L[0], L[1], L[2], L[3], H[0], H[1], H[2], H[3]}
  od = __builtin_amdgcn_mfma_f32_32x32x16_bf16(pa0, PK(l0, h0), od, 0, 0, 0);
  od = __builtin_amdgcn_mfma_f32_32x32x16_bf16(pa1, PK(l1, h1), od, 0, 0, 0);
  od = __builtin_amdgcn_mfma_f32_32x32x16_bf16(pa2, PK(l2, h2), od, 0, 0, 0);
  od = __builtin_amdgcn_mfma_f32_32x32x16_bf16(pa3, PK(l3, h3), od, 0, 0, 0);
#undef PK
}
__device__ __forceinline__ void pv_d0(f32x16* o, int vb, bf16x8 pa0, bf16x8 pa1, bf16x8 pa2, bf16x8 pa3) {
  pv_one<0>(o[0], vb, pa0, pa1, pa2, pa3); pv_one<1>(o[1], vb, pa0, pa1, pa2, pa3); pv_one<2>(o[2], vb, pa0, pa1, pa2, pa3); pv_one<3>(o[3], vb, pa0, pa1, pa2, pa3);
}

template <typename TQ>
__device__ __forceinline__ void attn_dense_body(const TQ* Qb, const bf16* __restrict__ Kh, const bf16* __restrict__ Vh,
                                                bf16* Ob, int seq, char* lds, const float* __restrict__ qgain, const float* __restrict__ tab, int tok0) {
  using St = Stage<bf16>; using SQ = Stage<TQ>;
  int tid_l = threadIdx.x; asm volatile("" : "+v"(tid_l));
  const int tid = tid_l, wid = tid >> 6, lane = tid & 63, r32 = lane & 31, hi = lane >> 5;
  bf16* V_lds = (bf16*)lds; bf16* K_lds = (bf16*)(lds + 2 * SHM_V);
  float* ws = (float*)(lds + 2 * SHM_V + 2 * SHM_K) + wid * 64; float* li_l = ws; float* al_l = ws + 32;
  float m_reg = -1e30f, l_reg = 0; f32x16 o[4] = {}; bf16x8 qr[8];
  const TQ* Qw = Qb + (long)(wid * QBLK + r32) * LDQ + hi * 8;
  {
    float y[8][8]; float ss = 0.f;
#pragma unroll
    for (int d0 = 0; d0 < 8; ++d0) { const u32x4 w = *reinterpret_cast<const u32x4*>(Qw + d0 * 16);
      y[d0][0] = __uint_as_float(w.x << 16); y[d0][1] = __uint_as_float(w.x & 0xffff0000u); y[d0][2] = __uint_as_float(w.y << 16); y[d0][3] = __uint_as_float(w.y & 0xffff0000u);
      y[d0][4] = __uint_as_float(w.z << 16); y[d0][5] = __uint_as_float(w.z & 0xffff0000u); y[d0][6] = __uint_as_float(w.w << 16); y[d0][7] = __uint_as_float(w.w & 0xffff0000u);
#pragma unroll
      for (int j = 0; j < 8; ++j) ss += y[d0][j] * y[d0][j]; }
    { auto rr = __builtin_amdgcn_permlane32_swap(__float_as_uint(ss), __float_as_uint(ss), false, false); ss = __uint_as_float(rr[0]) + __uint_as_float(rr[1]); }
    const float rstd = __builtin_amdgcn_rsqf(ss * (1.f / 128.f) + 1e-6f);
#pragma unroll
    for (int d0 = 0; d0 < 8; ++d0) { const f32x4 ga = *reinterpret_cast<const f32x4*>(qgain + d0 * 16 + hi * 8), gb = *reinterpret_cast<const f32x4*>(qgain + d0 * 16 + hi * 8 + 4);
      y[d0][0] *= rstd * ga[0]; y[d0][1] *= rstd * ga[1]; y[d0][2] *= rstd * ga[2]; y[d0][3] *= rstd * ga[3]; y[d0][4] *= rstd * gb[0]; y[d0][5] *= rstd * gb[1]; y[d0][6] *= rstd * gb[2]; y[d0][7] *= rstd * gb[3]; }
    const int tok = tok0 + wid * QBLK + r32, prow = (tok >> 6) & 63, pcol = tok & 63;
#pragma unroll
    for (int hf = 0; hf < 2; ++hf) { const int pos = hf ? pcol : prow;
#pragma unroll
      for (int db = 0; db < 2; ++db) { const float* tp = tab + (pos * 32 + db * 16 + hi * 8) * 2;
        const f32x4 t0 = *reinterpret_cast<const f32x4*>(tp), t1 = *reinterpret_cast<const f32x4*>(tp + 4), t2 = *reinterpret_cast<const f32x4*>(tp + 8), t3 = *reinterpret_cast<const f32x4*>(tp + 12);
        const float cs[8] = {t0[0], t0[2], t1[0], t1[2], t2[0], t2[2], t3[0], t3[2]}, sn[8] = {t0[1], t0[3], t1[1], t1[3], t2[1], t2[3], t3[1], t3[3]};
#pragma unroll
        for (int j = 0; j < 8; ++j) { const float x1 = y[hf * 4 + db][j], x2 = y[hf * 4 + db + 2][j]; y[hf * 4 + db][j] = x1 * cs[j] - x2 * sn[j]; y[hf * 4 + db + 2][j] = x2 * cs[j] + x1 * sn[j]; } } }
#pragma unroll
    for (int d0 = 0; d0 < 8; ++d0) { u32x4 w = {cvtpk(y[d0][0], y[d0][1]), cvtpk(y[d0][2], y[d0][3]), cvtpk(y[d0][4], y[d0][5]), cvtpk(y[d0][6], y[d0][7])}; qr[d0] = *reinterpret_cast<bf16x8*>(&w); }
  }
  const int sr = tid >> 4, sc = (tid & 15) * 8, vst0 = v_st(sr, sc), vst1 = v_st(32 + sr, sc);
  const int vb0 = (int)(uintptr_t)V_lds + v_rd_base(lane);
  struct { typename St::T vs0, vs1, ks0, ks1; } sr_[SDEPTH];
  const unsigned voff0 = (unsigned)(sr * LDK + sc) * 2u, voff1 = voff0 + 32u * LDK * 2u;
#define SLOAD(i, k0) do { const char* vb_ = (const char*)Vh + (size_t)(k0) * (LDK * 2); const char* kb_ = (const char*)Kh + (size_t)(k0) * (LDK * 2); \
    sr_[i].vs0 = *(const bf16x8*)(vb_ + voff0); sr_[i].vs1 = *(const bf16x8*)(vb_ + voff1); \
    sr_[i].ks0 = *(const bf16x8*)(kb_ + voff0); sr_[i].ks1 = *(const bf16x8*)(kb_ + voff1); } while (0)
#define SWRITE(b, i) do { *(bf16x8*)((char*)V_lds + (b) * SHM_V + vst0) = St::tobf(sr_[i].vs0);          \
    *(bf16x8*)((char*)V_lds + (b) * SHM_V + vst1) = St::tobf(sr_[i].vs1); int kc = sc * 2;               \
    *(bf16x8*)((char*)K_lds + (b) * SHM_K + KSWZ(sr, kc)) = St::tobf(sr_[i].ks0);                       \
    *(bf16x8*)((char*)K_lds + (b) * SHM_K + KSWZ(32 + sr, kc)) = St::tobf(sr_[i].ks1); } while (0)
#define SWAIT() do { if constexpr (SDEPTH == 2) asm volatile("s_waitcnt vmcnt(4)" ::: "memory"); else asm volatile("s_waitcnt vmcnt(0)" ::: "memory"); } while (0)
#define RESC(a) do { if (__any((a) < 1.f)) { if (hi == 0) al_l[r32] = (a); asm volatile("s_waitcnt lgkmcnt(0)" ::: "memory"); \
    for (int d = 0; d < 4; ++d) for (int r = 0; r < 16; ++r) o[d][r] *= al_l[crow(r, hi)]; } } while (0)
  f32x16 pA0, pA1, pB0, pB1; float mnA, mnB, alA, alB; bf16x8 pa0, pa1, pa2, pa3; const int NT = seq / KVBLK;
  constexpr int SE = 0, SO = SDEPTH - 1;
  SLOAD(SE, 0); asm volatile("s_waitcnt vmcnt(0)" ::: "memory"); SWRITE(0, SE); __syncthreads();
  qkt(pA0, pA1, K_lds, qr, r32, hi); partialSM(pA0, pA1, m_reg, mnA, alA);
  SLOAD(SO, KVBLK); if constexpr (SDEPTH == 2) { if (2 < NT) SLOAD(SE, 2 * KVBLK); }
  SWAIT(); SWRITE(1, SO); __syncthreads();
  for (int j = 1; j + 1 < NT; j += 2) {
    SBAR(); qkt(pB0, pB1, (bf16*)((char*)K_lds + SHM_K), qr, r32, hi);
    finishSM(pA0, pA1, alA, l_reg, pa0, pa1, pa2, pa3); SBAR();
    SLOAD(SO, (j + SDEPTH) * KVBLK); SBAR();
    pv_d0(o, vb0, pa0, pa1, pa2, pa3); partialSM(pB0, pB1, m_reg, mnB, alB);
    __syncthreads(); SWAIT(); SWRITE(0, SE);
    RESC(alB); __syncthreads();
    SBAR(); qkt(pA0, pA1, K_lds, qr, r32, hi);
    finishSM(pB0, pB1, alB, l_reg, pa0, pa1, pa2, pa3); SBAR();
    if (SDEPTH == 1 || j + 3 < NT) SLOAD(SE, (j + 1 + SDEPTH) * KVBLK); SBAR();
    pv_d0(o, vb0 + (int)SHM_V, pa0, pa1, pa2, pa3); partialSM(pA0, pA1, m_reg, mnA, alA);
    __syncthreads(); SWAIT(); SWRITE(1, SO);
    RESC(alA); __syncthreads();
  }
  SBAR(); qkt(pB0, pB1, (bf16*)((char*)K_lds + SHM_K), qr, r32, hi);
  finishSM(pA0, pA1, alA, l_reg, pa0, pa1, pa2, pa3); SBAR();
  pv_d0(o, vb0, pa0, pa1, pa2, pa3); partialSM(pB0, pB1, m_reg, mnB, alB);
  __syncthreads(); RESC(alB);
  finishSM(pB0, pB1, alB, l_reg, pa0, pa1, pa2, pa3); SBAR();
  pv_d0(o, vb0 + (int)SHM_V, pa0, pa1, pa2, pa3);
  if (hi == 0) li_l[r32] = l_reg; asm volatile("s_waitcnt lgkmcnt(0)" ::: "memory");
  float rli[16];
#pragma unroll
  for (int r = 0; r < 16; ++r) rli[r] = __builtin_amdgcn_rcpf(li_l[crow(r, hi)]);
  bf16* Ow = Ob + (long)(wid * QBLK) * LDO;
#pragma unroll
  for (int r = 0; r < 16; ++r) { int orow = crow(r, hi);
    for (int d0 = 0; d0 < 4; ++d0) Ow[(long)orow * LDO + d0 * 32 + r32] = __builtin_bit_cast(bf16, (unsigned short)(cvtpk(o[d0][r] * rli[r], 0.f) & 0xffffu)); }
#undef SLOAD
#undef SWRITE
#undef SWAIT
#undef RESC
}
#undef KSWZ
#undef SBAR
}
#define LAS __attribute__((address_space(3)))
typedef unsigned short bf16_t;
typedef float f32x4 __attribute__((ext_vector_type(4)));
typedef unsigned u32x4 __attribute__((ext_vector_type(4)));
typedef unsigned u32x2 __attribute__((ext_vector_type(2)));
typedef short bf16x8 __attribute__((ext_vector_type(8)));

constexpr int T = 49152, TP = 32768, DM = 2048, SEQ = 4096, NBATCH = 12, DFF = 8192, PLE = 256;
constexpr int PP = 7680;
constexpr int C_NAQ = 0, C_NAK = 1024, C_GQ = 2048, C_GK = 3072, C_GV = 3328, C_GA = 3584, C_GB = 5632;
constexpr float EPS = 1e-6f;
constexpr size_t MiB = 1u << 20;
constexpr size_t WS_TAB = 0, WS_WIN = 1 * MiB, WS_WNA = 35 * MiB, WS_WGQA = 39 * MiB, WS_WMIX = 43 * MiB, WS_WFF1 = 51 * MiB, WS_WFF2 = 83 * MiB,
                 WS_WPG = 115 * MiB, WS_WPP = 123 * MiB, WS_PB = 124 * MiB, WS_VT = 148 * MiB, WS_PROJ = 244 * MiB, WS_END0 = 964 * MiB;
constexpr size_t WS_Y = 244 * MiB, WS_H = 436 * MiB, WS_HID = 628 * MiB, WS_EP = 628 * MiB, WS_END = 1016 * MiB;
constexpr int HIDP = 8192 + 64;
constexpr int LDS_BYTES = 147456;
constexpr int NTHREADS = 512;

struct Params {
    const float* x_p; const float* x_s; const float* p_p; const float* p_s;
    const float* ln_mix_pre; const float* w_in; const float* q_norm; const float* k_norm; const float* na_rpb;
    const float* w_na; const float* w_gqa; const float* w_mix; const float* ln_mix_post; const float* ln_mlp_pre;
    const float* w_ff1; const float* w_ff2; const float* ln_mlp_post; const float* ln_ple_pre; const float* w_ple_gate; const float* w_ple_proj; const float* ln_ple_post;
    float* out; unsigned char* ws;
};

__device__ __forceinline__ unsigned pk_bf16(float lo, float hi) { unsigned r; asm volatile("v_cvt_pk_bf16_f32 %0, %1, %2" : "=v"(r) : "v"(lo), "v"(hi)); return r; }
__device__ __forceinline__ float bflo(unsigned u) { return __uint_as_float(u << 16); }
__device__ __forceinline__ float bfhi(unsigned u) { return __uint_as_float(u & 0xffff0000u); }
__device__ __forceinline__ float wave_sum(float v) {
#pragma unroll
    for (int o = 1; o < 64; o <<= 1) v += __shfl_xor(v, o);
    return v;
}

__device__ __forceinline__ void transpose_item(const float* W, int K, int N, bf16_t* WT, int k0, int n0, int drow0, LAS float* scr, int lane, const float* gk) {
#pragma unroll 8
    for (int i = 0; i < 32; ++i) { const int kk = 2 * i + (lane >> 5); scr[kk * 33 + (lane & 31)] = W[(size_t)(k0 + kk) * N + n0 + (lane & 31)] * (gk ? gk[k0 + kk] : 1.f); }
    asm volatile("s_waitcnt lgkmcnt(0)" ::: "memory");
    const int c = lane & 7;
#pragma unroll
    for (int j = 0; j < 4; ++j) { const int n = (lane >> 3) + 8 * j; const LAS float* s = scr + (8 * c) * 33 + n;
        u32x4 o; o.x = pk_bf16(s[0 * 33], s[1 * 33]); o.y = pk_bf16(s[2 * 33], s[3 * 33]); o.z = pk_bf16(s[4 * 33], s[5 * 33]); o.w = pk_bf16(s[6 * 33], s[7 * 33]);
        *(u32x4*)(WT + (size_t)(drow0 + n) * K + k0 + 8 * c) = o; }
    asm volatile("s_waitcnt lgkmcnt(0)" ::: "memory");
}
__device__ __forceinline__ bool transpose_mat(int& r, const float* W, int K, int N, bf16_t* WT, LAS float* scr, int lane, bool remap_in, const float* gk = nullptr) {
    const int nblk = N / 32, items = (K / 64) * nblk;
    if (r >= items) { r -= items; return false; }
    const int kb = r / nblk, nb = r % nblk, n0 = nb * 32;
    int d0 = n0;
    if (remap_in) d0 = (n0 < 2048) ? n0 : (n0 < 3072 ? n0 - 2048 + 7680 : n0 - 1024);
    transpose_item(W, K, N, WT, kb * 64, n0, d0, scr, lane, gk);
    return true;
}

__device__ __forceinline__ const float* xrow_in(const Params& P, int m) { return m < TP ? P.x_p + (size_t)m * DM : P.x_s + (size_t)(m - TP) * DM; }

template <int MODE>
__device__ __forceinline__ void row_pass(const Params& P, const bf16_t* Y, const bf16_t* XS, bf16_t* XB, float* RS, const float* g1, int gw, int ngw, int grp = -1) {
    int tid_l = threadIdx.x; asm volatile("" : "+v"(tid_l)); const int lane = tid_l & 63;
    const int LIM = (grp >= 0) ? 6144 : T;
#define RP_ROW(j) ((grp >= 0) ? (((j) / 3072) * 24576 + 3072 * grp + ((j) % 3072)) : (j))
    for (int m0 = gw; m0 < LIM; m0 += 2 * ngw) {
        const int mr[2] = {RP_ROW(m0), RP_ROW(min(m0 + ngw, LIM - 1))}; const bool ok1 = (m0 + ngw < LIM);
        float x[2][4][8], y[2][4][8];
#pragma unroll
        for (int r = 0; r < 2; ++r) { const int mm = mr[r];
            if (MODE == 0 || MODE == 1) { const float* base = xrow_in(P, mm);
#pragma unroll
                for (int j = 0; j < 4; ++j) { const f32x4 a = *(const f32x4*)(base + j * 512 + lane * 8), b = *(const f32x4*)(base + j * 512 + lane * 8 + 4);
                    x[r][j][0] = a[0]; x[r][j][1] = a[1]; x[r][j][2] = a[2]; x[r][j][3] = a[3]; x[r][j][4] = b[0]; x[r][j][5] = b[1]; x[r][j][6] = b[2]; x[r][j][7] = b[3]; }
            } else {
#pragma unroll
                for (int j = 0; j < 4; ++j) { const u32x4 w = *(const u32x4*)(XS + (size_t)mm * DM + j * 512 + lane * 8);
                    x[r][j][0] = bflo(w.x); x[r][j][1] = bfhi(w.x); x[r][j][2] = bflo(w.y); x[r][j][3] = bfhi(w.y); x[r][j][4] = bflo(w.z); x[r][j][5] = bfhi(w.z); x[r][j][6] = bflo(w.w); x[r][j][7] = bfhi(w.w); }
            }
            if (MODE != 0) {
#pragma unroll
                for (int j = 0; j < 4; ++j) { const u32x4 w = *(const u32x4*)(Y + (size_t)mm * DM + j * 512 + lane * 8);
                    y[r][j][0] = bflo(w.x); y[r][j][1] = bfhi(w.x); y[r][j][2] = bflo(w.y); y[r][j][3] = bfhi(w.y); y[r][j][4] = bflo(w.z); y[r][j][5] = bfhi(w.z); y[r][j][6] = bflo(w.w); y[r][j][7] = bfhi(w.w); }
            }
        }
#pragma unroll
        for (int r = 0; r < 2; ++r) { const int mm = mr[r]; const bool ok = (r == 0) || ok1;
            if (MODE != 0) {
                float ss = 0.f;
#pragma unroll
                for (int j = 0; j < 4; ++j)
#pragma unroll
                    for (int i = 0; i < 8; ++i) ss += y[r][j][i] * y[r][j][i];
                const float rstd = __builtin_amdgcn_rsqf(wave_sum(ss) * (1.f / DM) + EPS);
#pragma unroll
                for (int j = 0; j < 4; ++j) { const f32x4 ga = *(const f32x4*)(g1 + j * 512 + lane * 8), gb = *(const f32x4*)(g1 + j * 512 + lane * 8 + 4);
                    const float gg[8] = {ga[0], ga[1], ga[2], ga[3], gb[0], gb[1], gb[2], gb[3]};
#pragma unroll
                    for (int i = 0; i < 8; ++i) x[r][j][i] += y[r][j][i] * rstd * gg[i]; }
            }
            if (MODE == 2) {
                if (ok) {
#pragma unroll
                    for (int j = 0; j < 4; ++j) { float* o = P.out + (size_t)mm * DM + j * 512 + lane * 8;
                        *(f32x4*)o = (f32x4){x[r][j][0], x[r][j][1], x[r][j][2], x[r][j][3]}; *(f32x4*)(o + 4) = (f32x4){x[r][j][4], x[r][j][5], x[r][j][6], x[r][j][7]}; } }
            } else {
                float ss = 0.f;
#pragma unroll
                for (int j = 0; j < 4; ++j)
#pragma unroll
                    for (int i = 0; i < 8; ++i) ss += x[r][j][i] * x[r][j][i];
                const float rstd = __builtin_amdgcn_rsqf(wave_sum(ss) * (1.f / DM) + EPS);
                if (ok) {
                    if (MODE == 0) {
#pragma unroll
                        for (int j = 0; j < 4; ++j) { const f32x4 ga = *(const f32x4*)(g1 + j * 512 + lane * 8), gb = *(const f32x4*)(g1 + j * 512 + lane * 8 + 4);
                            u32x4 w; w.x = pk_bf16(x[r][j][0] * rstd * ga[0], x[r][j][1] * rstd * ga[1]); w.y = pk_bf16(x[r][j][2] * rstd * ga[2], x[r][j][3] * rstd * ga[3]);
                            w.z = pk_bf16(x[r][j][4] * rstd * gb[0], x[r][j][5] * rstd * gb[1]); w.w = pk_bf16(x[r][j][6] * rstd * gb[2], x[r][j][7] * rstd * gb[3]);
                            *(u32x4*)(XB + (size_t)mm * DM + j * 512 + lane * 8) = w; }
                    } else {
                        if (lane == 0) RS[mm] = rstd;
#pragma unroll
                        for (int j = 0; j < 4; ++j) { u32x4 w; w.x = pk_bf16(x[r][j][0], x[r][j][1]); w.y = pk_bf16(x[r][j][2], x[r][j][3]); w.z = pk_bf16(x[r][j][4], x[r][j][5]); w.w = pk_bf16(x[r][j][6], x[r][j][7]);
                            *(u32x4*)(XB + (size_t)mm * DM + j * 512 + lane * 8) = w; }
                    }
                }
            }
        }
    }
}

#undef RP_ROW
__device__ __forceinline__ void qk_norm_rope(const Params& P, const bf16_t* PROJ, bf16_t* QC, bf16_t* KC, bf16_t* VC, const LAS float* tabl, int gw, int ngw, int lane_in) {
    (void)lane_in; int tid_l = threadIdx.x; asm volatile("" : "+v"(tid_l)); const int lane = tid_l & 63;
    const int hd4 = lane >> 4, c = lane & 15, half = c >> 3, isx2 = (c >> 2) & 1, i0 = (c & 3) * 8;
    float gq[8], gk[8];
#pragma unroll
    for (int i = 0; i < 8; ++i) { gq[i] = P.q_norm[c * 8 + i]; gk[i] = P.k_norm[c * 8 + i]; }
    for (int it0 = gw * 4; it0 < T; it0 += ngw * 4) {
        u32x4 wv[4];
#pragma unroll
        for (int k = 0; k < 4; ++k) { const int t = it0 + k, grp = 2;
            wv[k] = *(const u32x4*)(PROJ + (size_t)t * PP + C_GQ + (grp * 4 + hd4) * 128 + c * 8); }
#pragma unroll
        for (int k = 0; k < 4; ++k) {
            const int t = it0 + k, grp = 2;
            const u32x4 w = wv[k];
            float x[8] = {bflo(w.x), bfhi(w.x), bflo(w.y), bfhi(w.y), bflo(w.z), bfhi(w.z), bflo(w.w), bfhi(w.w)};
            float ss = 0.f;
#pragma unroll
            for (int i = 0; i < 8; ++i) ss += x[i] * x[i];
            ss += __shfl_xor(ss, 1); ss += __shfl_xor(ss, 2); ss += __shfl_xor(ss, 4); ss += __shfl_xor(ss, 8);
            const float rstd = __builtin_amdgcn_rsqf(ss * (1.f / 128.f) + EPS);
            const int sq = t & (SEQ - 1), pos = half ? (sq & 63) : (sq >> 6);
            const LAS float* tp = tabl + (pos * 32 + i0) * 2;
            float o[8];
#pragma unroll
            for (int i = 0; i < 8; ++i) { const float y = x[i] * rstd * (grp < 2 ? gq[i] : gk[i]); const float yp = __shfl_xor(y, 4);
                const float cs = tp[2 * i], sn = tp[2 * i + 1]; o[i] = isx2 ? (y * cs + yp * sn) : (y * cs - yp * sn); }
            u32x4 r; r.x = pk_bf16(o[0], o[1]); r.y = pk_bf16(o[2], o[3]); r.z = pk_bf16(o[4], o[5]); r.w = pk_bf16(o[6], o[7]);
            bf16_t* dst;
            if (grp < 2) dst = QC + (size_t)t * 1024 + (grp * 4 + hd4) * 128 + c * 8;
            else if (hd4 < 2) dst = KC + (size_t)t * 256 + hd4 * 128 + c * 8;
            else { dst = VC + (size_t)t * 256 + (hd4 - 2) * 128 + c * 8; r = w; }
            *(u32x4*)dst = r;
        }
    }
}

namespace na {
constexpr int KROW = 272, VROW = 144, VOFF = 64 * KROW, BUF = 36864, RPB_OFF = 2 * BUF, NA_LDS_END = RPB_OFF + 16384;
__device__ __forceinline__ void na_phase(const bf16_t* PROJ, const bf16_t* VT, const float* rpb, bf16_t* OUT, int opitch, int vcu, int G, LAS unsigned char* lds) {
    const int NU = NBATCH * 8 * 16, per = (NU + G - 1) / G;
    const bool xmap = (G == 256);
    const int ub = vcu * per, nun = xmap ? 6 : max(min(ub + per, NU) - ub, 0);
#define NA_UNIT(i) (xmap ? ((((vcu >> 5) * 12 + 2 * (i) + ((vcu & 31) >> 4)) << 4) + (vcu & 15)) : (ub + (i)))
    int tid_l = threadIdx.x; asm volatile("" : "+v"(tid_l));
    const int tid = tid_l, w = __builtin_amdgcn_readfirstlane(tid >> 6), lane = tid & 63, l15 = lane & 15, g = lane >> 4;
    const int qr = w >> 1, ch = w & 1;
    LAS float* rp = (LAS float*)(lds + RPB_OFF);
    for (int i = tid; i < 8 * 15 * 32; i += NTHREADS) { const int c31 = i & 31, hr = i >> 5; rp[i] = (c31 < 31) ? rpb[hr * 31 + c31] * 1.4426950408889634f : -1e30f; }
    if (nun <= 0) return;
    unsigned boff[2][8];
#pragma unroll
    for (int c2 = 0; c2 < 2; ++c2) { const int qc0 = 16 * (2 * ch + c2), cb = min(max(qc0 - 8, 0), 32), qcol = qc0 + l15, cs = min(max(qcol - 8, 0), 48);
#pragma unroll
        for (int e = 0; e < 8; ++e) { const int kc = cb + (e >> 2) * 16 + 4 * g + (e & 3); boff[c2][e] = ((kc >= cs) && (kc < cs + 16)) ? (unsigned)(kc - qcol + 15) * 4u : 124u; } }
    u32x4 st[2][4];
    unsigned koff[2], klds[2], vlds[2];
#pragma unroll
    for (int i_ = 0; i_ < 2; ++i_) { const int c_ = tid + 512 * i_;
        koff[i_] = (unsigned)((c_ >> 4) * PP + (c_ & 15) * 8) * 2u; klds[i_] = (unsigned)((c_ >> 4) * KROW + (c_ & 15) * 16);
        vlds[i_] = (unsigned)(VOFF + (c_ >> 3) * VROW + (c_ & 7) * 16); }
#define NA_DEC(uu) const int pr_ = (uu) >> 4, r0_ = 4 * ((uu) & 15), b_ = pr_ >> 3, hd_ = pr_ & 7, kr0_ = min(max(r0_ - 4, 0), 56), n_ = min(max(r0_ - 1, 0), 56) - kr0_ + 8
#define NA_LOADT(set, uu, t) do { NA_DEC(uu); { const int kr_ = min(kr0_ + (t), 63); (void)n_;     \
        const char* kb_ = (const char*)(PROJ + ((size_t)b_ * SEQ + (size_t)kr_ * 64) * PP + C_NAK + hd_ * 128); \
        const char* vb_ = (const char*)(VT + ((((size_t)b_ * 64 + kr_) * 8 + hd_) * 128) * 64); \
        st[set][0] = *(const u32x4*)(kb_ + koff[0]); st[set][1] = *(const u32x4*)(kb_ + koff[1]); \
        st[set][2] = *(const u32x4*)(vb_ + (unsigned)tid * 16u); st[set][3] = *(const u32x4*)(vb_ + (unsigned)(tid + 512) * 16u); } } while (0)
#define NA_WRITET(set, t) do { LAS unsigned char* bp_ = lds + ((t) & 1) * BUF; \
        *(LAS u32x4*)(bp_ + klds[0]) = st[set][0]; *(LAS u32x4*)(bp_ + klds[1]) = st[set][1]; *(LAS u32x4*)(bp_ + vlds[0]) = st[set][2]; *(LAS u32x4*)(bp_ + vlds[1]) = st[set][3]; } while (0)
    { const int u0 = NA_UNIT(0); NA_LOADT(0, u0, 0); NA_LOADT(1, u0, 1); }
    const float scale = 0.088388347648318440f, L2E = 1.4426950408889634f;
    for (int ui = 0; ui < nun; ++ui) {
        const bool has_next = (ui + 1 < nun);
        const int u = NA_UNIT(ui), un = has_next ? NA_UNIT(ui + 1) : u;
        const int pr = u >> 4, r0 = 4 * (u & 15), b = pr >> 3, head = pr & 7, kr0 = min(max(r0 - 4, 0), 56), n = min(max(r0 - 1, 0), 56) - kr0 + 8;
        const int r = r0 + qr, rsw = min(max(r - 4, 0), 56);
        const size_t tokq = (size_t)b * SEQ + r * 64;
        bf16x8 qf[2][4];
#pragma unroll
        for (int c2 = 0; c2 < 2; ++c2) { const bf16_t* qp = PROJ + (tokq + 16 * (2 * ch + c2) + l15) * PP + C_NAQ + head * 128 + 8 * g;
#pragma unroll
            for (int dc = 0; dc < 4; ++dc) qf[c2][dc] = *(const bf16x8*)(qp + dc * 32); }
#pragma unroll
        for (int c2 = 0; c2 < 2; ++c2)
#pragma unroll
            for (int dc = 0; dc < 4; ++dc) asm volatile("" : "+v"(qf[c2][dc]));
        float mrun[2] = {-1e30f, -1e30f}, lrun[2] = {0.f, 0.f};
        f32x4 O[2][8];
#pragma unroll
        for (int c2 = 0; c2 < 2; ++c2)
#pragma unroll
            for (int db = 0; db < 8; ++db) O[c2][db] = (f32x4){0.f, 0.f, 0.f, 0.f};
        const LAS unsigned char* rph = (const LAS unsigned char*)(rp + head * 480);
#pragma unroll
        for (int t = 0; t < 12; ++t) {
            NA_WRITET(t % 2, t);
            if (t + 2 < 12) NA_LOADT(t % 2, u, t + 2); else NA_LOADT(t % 2, un, t + 2 - 12);
            __syncthreads();
            const int kr = kr0 + t;
            if (kr >= rsw && kr < rsw + 8) {
                const LAS unsigned char* bp = lds + (t & 1) * BUF;
                const LAS unsigned char* brow = rph + (kr - r + 7) * 128;
                float bias[2][8]; f32x4 S[2][2]; float sv[2][8];
#pragma unroll
                for (int c2 = 0; c2 < 2; ++c2)
#pragma unroll
                    for (int e = 0; e < 8; ++e) bias[c2][e] = *(const LAS float*)(brow + boff[c2][e]);
#pragma unroll
                for (int c2 = 0; c2 < 2; ++c2) {
                    const int cb = min(max(16 * (2 * ch + c2) - 8, 0), 32);
                    const LAS unsigned char* kp = bp + (cb + l15) * KROW + 16 * g;
                    bf16x8 ka[2][4];
#pragma unroll
                    for (int kb = 0; kb < 2; ++kb)
#pragma unroll
                        for (int dc = 0; dc < 4; ++dc) ka[kb][dc] = *(const LAS bf16x8*)(kp + kb * 16 * KROW + dc * 64);
                    S[c2][0] = (f32x4){0.f, 0.f, 0.f, 0.f}; S[c2][1] = (f32x4){0.f, 0.f, 0.f, 0.f};
#pragma unroll
                    for (int dc = 0; dc < 4; ++dc)
#pragma unroll
                        for (int kb = 0; kb < 2; ++kb) S[c2][kb] = __builtin_amdgcn_mfma_f32_16x16x32_bf16(ka[kb][dc], qf[c2][dc], S[c2][kb], 0, 0, 0);
                }
                float tml[2];
#pragma unroll
                for (int c2 = 0; c2 < 2; ++c2) { float tm = -1e30f;
#pragma unroll
                    for (int e = 0; e < 8; ++e) { sv[c2][e] = fmaf(S[c2][e >> 2][e & 3], scale * L2E, bias[c2][e]); tm = fmaxf(tm, sv[c2][e]); }
                    tml[c2] = tm; }
                if (__any(tml[0] > mrun[0] + 40.f || tml[1] > mrun[1] + 40.f)) {
#pragma unroll
                    for (int c2 = 0; c2 < 2; ++c2) { float tm = tml[c2]; tm = fmaxf(tm, __shfl_xor(tm, 16)); tm = fmaxf(tm, __shfl_xor(tm, 32));
                        const float mn = fmaxf(mrun[c2], tm), alpha = __builtin_amdgcn_exp2f(mrun[c2] - mn);
                        mrun[c2] = mn; lrun[c2] *= alpha;
#pragma unroll
                        for (int db = 0; db < 8; ++db) O[c2][db] = O[c2][db] * alpha; }
                }
#pragma unroll
                for (int c2 = 0; c2 < 2; ++c2) { float ps = 0.f;
#pragma unroll
                    for (int e = 0; e < 8; ++e) { const float p = __builtin_amdgcn_exp2f(sv[c2][e] - mrun[c2]); sv[c2][e] = p; ps += p; }
                    lrun[c2] += ps; }
#pragma unroll
                for (int c2 = 0; c2 < 2; ++c2) {
                    const int cb = min(max(16 * (2 * ch + c2) - 8, 0), 32);
                    u32x4 pw; pw.x = pk_bf16(sv[c2][0], sv[c2][1]); pw.y = pk_bf16(sv[c2][2], sv[c2][3]); pw.z = pk_bf16(sv[c2][4], sv[c2][5]); pw.w = pk_bf16(sv[c2][6], sv[c2][7]);
                    const bf16x8 pj = __builtin_bit_cast(bf16x8, pw);
                    const LAS unsigned char* vp = bp + VOFF + l15 * VROW + (cb + 4 * g) * 2;
#pragma unroll
                    for (int dh = 0; dh < 2; ++dh) { u32x2 vlo[4], vhi[4];
#pragma unroll
                        for (int d4 = 0; d4 < 4; ++d4) { vlo[d4] = *(const LAS u32x2*)(vp + (dh * 4 + d4) * 16 * VROW); vhi[d4] = *(const LAS u32x2*)(vp + (dh * 4 + d4) * 16 * VROW + 32); }
#pragma unroll
                        for (int d4 = 0; d4 < 4; ++d4) { const u32x4 aw = {vlo[d4].x, vlo[d4].y, vhi[d4].x, vhi[d4].y};
                            O[c2][dh * 4 + d4] = __builtin_amdgcn_mfma_f32_16x16x32_bf16(__builtin_bit_cast(bf16x8, aw), pj, O[c2][dh * 4 + d4], 0, 0, 0); } }
                }
            }
        }
#pragma unroll
        for (int c2 = 0; c2 < 2; ++c2) {
            float lt = lrun[c2]; lt += __shfl_xor(lt, 16); lt += __shfl_xor(lt, 32);
            const float inv = 1.f / lt;
            bf16_t* op = OUT + (tokq + 16 * (2 * ch + c2) + l15) * opitch + head * 128 + 4 * g;
#pragma unroll
            for (int db = 0; db < 8; ++db) { u32x2 o; o.x = pk_bf16(O[c2][db][0] * inv, O[c2][db][1] * inv); o.y = pk_bf16(O[c2][db][2] * inv, O[c2][db][3] * inv); *(u32x2*)(op + db * 16) = o; }
        }
    }
#undef NA_LOADT
#undef NA_WRITET
#undef NA_DEC
#undef NA_UNIT
}
}

#define XB_TMO      128
#define XB_XCNT(j)  (256  + 64 * (j))
#define XB_XSUB(j)  (1280 + 64 * (j))
#define XB_XGEN(j)  (2304 + 64 * (j))
#define XB_TOP      3328
#define XB_TOPGEN   3392
#define XCD_BAR_WORDS 3456
#define XB_SPIN_CAP (1u << 18)

__device__ __forceinline__ unsigned xb_ld(unsigned* p)              { return __hip_atomic_load(p, __ATOMIC_RELAXED, __HIP_MEMORY_SCOPE_AGENT); }
__device__ __forceinline__ unsigned xb_add(unsigned* p, unsigned v) { return __hip_atomic_fetch_add(p, v, __ATOMIC_RELAXED, __HIP_MEMORY_SCOPE_AGENT); }
__device__ __forceinline__ unsigned xb_xcc_id() { return (unsigned)__builtin_amdgcn_s_getreg((3 << 11) | 20) & 0xFu; }
#define XB_SPIN(cond, bar) do { unsigned _sp = 0; while (cond) { __builtin_amdgcn_s_sleep(1); \
    if ((++_sp & 255u) == 0u) { if (xb_ld(&(bar)[XB_TMO])) break; if (_sp > XB_SPIN_CAP) { atomicAdd(&(bar)[XB_TMO], 1u); break; } } } } while (0)

struct XcdBarrier {
    unsigned* bar; unsigned x;
    volatile LAS unsigned* st;
};

__device__ __forceinline__ XcdBarrier xcd_barrier_post(unsigned* bar, volatile LAS unsigned* st) {
    XcdBarrier b; b.bar = bar; b.x = xb_xcc_id(); b.st = st;
    if (threadIdx.x == 0) (void)xb_add(&bar[XB_XCNT(b.x)], 1u);
    return b;
}
__device__ __forceinline__ void xcd_barrier_complete(unsigned* bar, unsigned x, unsigned& nloc, unsigned& nx) {
    const unsigned G = gridDim.x * gridDim.y * gridDim.z;
    unsigned sum, cnt, mine, sp = 0u;
    for (;;) {
        sum = 0u; cnt = 0u; mine = 0u;
#pragma unroll
        for (unsigned j = 0; j < 16; ++j) { const unsigned c = xb_ld(&bar[XB_XCNT(j)]); sum += c; cnt += (c > 0u) ? 1u : 0u; mine = (j == x) ? c : mine; }
        if (sum == G) break;
        __builtin_amdgcn_s_sleep(1);
        if ((++sp & 255u) == 0u) { if (xb_ld(&bar[XB_TMO])) break; if (sp > XB_SPIN_CAP) { atomicAdd(&bar[XB_TMO], 1u); break; } }
    }
    nloc = mine > 0u ? mine : 1u; nx = cnt > 0u ? cnt : 1u;
}

__device__ __forceinline__ void xcd_barrier(const XcdBarrier& b) {
    asm volatile("s_waitcnt vmcnt(0)" ::: "memory");
    __syncthreads();
    if (threadIdx.x == 0) {
        unsigned* bar = b.bar;
        __builtin_amdgcn_s_waitcnt(0);
        unsigned nloc = b.st[0], nx = b.st[1];
        if (nloc == 0u) { xcd_barrier_complete(bar, b.x, nloc, nx); b.st[0] = nloc; b.st[1] = nx; }
        const unsigned old = xb_add(&bar[XB_XSUB(b.x)], 1u);
        const unsigned gen = old / nloc;
        if (old + 1u == (gen + 1u) * nloc) {
            __builtin_amdgcn_fence(__ATOMIC_RELEASE, "agent");
            asm volatile("s_waitcnt vmcnt(0)" ::: "memory");
            const unsigned og = xb_add(&bar[XB_TOP], 1u);
            const unsigned tg = og / nx;
            if (og + 1u == (tg + 1u) * nx) xb_add(&bar[XB_TOPGEN], 1u);
            else XB_SPIN(xb_ld(&bar[XB_TOPGEN]) == tg, bar);
            __builtin_amdgcn_fence(__ATOMIC_ACQUIRE, "agent");
            xb_add(&bar[XB_XGEN(b.x)], 1u);
            asm volatile("s_waitcnt vmcnt(0)" ::: "memory");
        } else {
            XB_SPIN(xb_ld(&bar[XB_XGEN(b.x)]) == gen, bar);
            __builtin_amdgcn_fence(__ATOMIC_ACQUIRE, "agent");
            asm volatile("s_waitcnt vmcnt(0)" ::: "memory");
        }
    }
    __syncthreads();
}


#define LB_CNT(g) (64 * (g))
#define LB_GEN(g) (64 * (8 + (g)))
#define LB_TAB(g) (64 * (16 + (g)))
#define LB_FLAG   (64 * 24)
#define LB_WORDS  (64 * 25)
struct LocalBar { unsigned* w; unsigned g, n; bool on; };
__device__ __forceinline__ void seam(const XcdBarrier& xb, const LocalBar& lb) {
    if (!lb.on) { xcd_barrier(xb); return; }
    asm volatile("s_waitcnt vmcnt(0)" ::: "memory");
    __syncthreads();
    if (threadIdx.x == 0) {
        const unsigned old = xb_add(&lb.w[LB_CNT(lb.g)], 1u), gn = old / lb.n;
        if (old + 1u == (gn + 1u) * lb.n) xb_add(&lb.w[LB_GEN(lb.g)], 1u);
        else XB_SPIN(xb_ld(&lb.w[LB_GEN(lb.g)]) == gn, xb.bar);
        __builtin_amdgcn_fence(__ATOMIC_ACQUIRE, "agent");
        asm volatile("s_waitcnt vmcnt(0)" ::: "memory");
    }
    __syncthreads();
}

#ifndef MK_PHASES
#define MK_PHASES 0xffff
#endif
#define PH(k) (((MK_PHASES) >> (k)) & 1)
#ifndef WGM_WIDE
#define WGM_WIDE 4
#endif
#ifndef WGM_N8
#define WGM_N8 4
#endif
#ifndef MK_SKELETON
#define MK_SKELETON 0
#endif
__global__ void __launch_bounds__(NTHREADS, 2) fwd_megakernel(Params P) {
    extern __shared__ __attribute__((aligned(16))) unsigned char lds_raw[];
    cg::grid_group grid = cg::this_grid();
    LAS unsigned char* lds = (LAS unsigned char*)lds_raw;
    const int wave = __builtin_amdgcn_readfirstlane((int)threadIdx.x >> 6);
#define tid ((int)threadIdx.x)
#define lane ((int)threadIdx.x & 63)
    const int G = gridDim.x, bid = blockIdx.x;
    const int vcu = (G % 8 == 0) ? (bid % 8) * (G / 8) + bid / 8 : bid;
    const int gw = vcu * 8 + wave, ngw = G * 8;
    unsigned char* ws = P.ws;
    if (tid < 16) ((LAS unsigned*)(lds + LDS_BYTES - 64))[tid] = 0u;
    __syncthreads();
    unsigned* BARW = (unsigned*)(ws + 512 * 1024);
    if (bid == 0) for (int i = tid; i < XCD_BAR_WORDS; i += NTHREADS) __hip_atomic_store(BARW + i, 0u, __ATOMIC_RELAXED, __HIP_MEMORY_SCOPE_AGENT);
    unsigned* LBW = (unsigned*)(ws + 768 * 1024);
    if (bid == 0) for (int i = tid; i < LB_WORDS; i += NTHREADS) __hip_atomic_store(LBW + i, 0u, __ATOMIC_RELAXED, __HIP_MEMORY_SCOPE_AGENT);
    float* TAB = (float*)(ws + WS_TAB);
    bf16_t* WIN = (bf16_t*)(ws + WS_WIN); bf16_t* WNA = (bf16_t*)(ws + WS_WNA); bf16_t* WGQA = (bf16_t*)(ws + WS_WGQA); bf16_t* WMIX = (bf16_t*)(ws + WS_WMIX);
    bf16_t* WFF1 = (bf16_t*)(ws + WS_WFF1); bf16_t* WFF2 = (bf16_t*)(ws + WS_WFF2); bf16_t* WPG = (bf16_t*)(ws + WS_WPG); bf16_t* WPPJ = (bf16_t*)(ws + WS_WPP);
    bf16_t* PB = (bf16_t*)(ws + WS_PB); bf16_t* VT = (bf16_t*)(ws + WS_VT); bf16_t* PROJ = (bf16_t*)(ws + WS_PROJ);
    bf16_t* YB = (bf16_t*)(ws + WS_Y); bf16_t* HB = (bf16_t*)(ws + WS_H); bf16_t* HID = (bf16_t*)(ws + WS_HID); bf16_t* EP = (bf16_t*)(ws + WS_H);
    bf16_t* XN = (bf16_t*)P.out;
    bf16_t* MG = (bf16_t*)P.out;
    bf16_t* AB = (bf16_t*)((unsigned char*)P.out + 192 * MiB);
    bf16_t* X1B = (bf16_t*)P.out;
    float* RS2 = (float*)(ws + 64 * 1024); float* RS3 = (float*)(ws + 256 * 1024);
    bf16_t* KC = (bf16_t*)(ws + 964 * MiB); bf16_t* VC = (bf16_t*)(ws + 988 * MiB); bf16_t* QC = nullptr;

    if (PH(0)) {
        for (int idx = bid * NTHREADS + tid; idx < 64 * 32; idx += G * NTHREADS) {
            const int pos = idx >> 5, i = idx & 31;
            const float freq = __builtin_amdgcn_exp2f(-(float)i * (13.287712379549449f / 32.f));
            const float rev = (float)pos * freq * 0.15915494309189535f; const float fr = rev - floorf(rev);
            TAB[idx * 2] = __builtin_amdgcn_cosf(fr); TAB[idx * 2 + 1] = __builtin_amdgcn_sinf(fr);
        }
        LAS float* scr = (LAS float*)(lds + wave * 16384);
        constexpr int NITEMS = (2048 / 64) * (8704 / 32) + 2 * (1024 / 64) * (2048 / 32) + 2 * (2048 / 64) * (2048 / 32) + (2048 / 64) * (8192 / 32) + (8192 / 64) * (2048 / 32) + (256 / 64) * (2048 / 32);
        for (int it = gw; it < NITEMS; it += ngw) {
            int r = it;
            if (transpose_mat(r, P.w_in, 2048, 8704, WIN, scr, lane, true)) continue;
            if (transpose_mat(r, P.w_na, 1024, 2048, WNA, scr, lane, false)) continue;
            if (transpose_mat(r, P.w_gqa, 1024, 2048, WGQA, scr, lane, false)) continue;
            if (transpose_mat(r, P.w_mix, 2048, 2048, WMIX, scr, lane, false)) continue;
            if (transpose_mat(r, P.w_ple_gate, 2048, 2048, WPG, scr, lane, false, P.ln_ple_pre)) continue;
            if (transpose_mat(r, P.w_ff1, 2048, 8192, WFF1, scr, lane, false, P.ln_mlp_pre)) continue;
            if (transpose_mat(r, P.w_ff2, 8192, 2048, WFF2, scr, lane, false)) continue;
            transpose_mat(r, P.w_ple_proj, 256, 2048, WPPJ, scr, lane, false);
        }
        for (size_t i = (size_t)bid * NTHREADS + tid; i < (size_t)T * PLE / 8; i += (size_t)G * NTHREADS) {
            const size_t e = i * 8; const float* src = e < (size_t)TP * PLE ? P.p_p + e : P.p_s + (e - (size_t)TP * PLE);
            const f32x4 a = *(const f32x4*)src, b = *(const f32x4*)(src + 4);
            u32x4 w; w.x = pk_bf16(a[0], a[1]); w.y = pk_bf16(a[2], a[3]); w.z = pk_bf16(b[0], b[1]); w.w = pk_bf16(b[2], b[3]);
            *(u32x4*)(PB + e) = w;
        }
        row_pass<0>(P, nullptr, nullptr, XN, nullptr, P.ln_mix_pre, gw, ngw);
    }
    grid.sync();
    XcdBarrier xbar = xcd_barrier_post(BARW, (volatile LAS unsigned*)(lds + LDS_BYTES - 64));
    if (tid == 0) {
        unsigned expect = 0u; const unsigned mine = xb_xcc_id() + 1u;
        if (!__hip_atomic_compare_exchange_strong(&LBW[LB_TAB(bid & 7)], &expect, mine, __ATOMIC_RELAXED, __ATOMIC_RELAXED, __HIP_MEMORY_SCOPE_AGENT) && expect != mine)
            __hip_atomic_fetch_or(&LBW[LB_FLAG], 1u, __ATOMIC_RELAXED, __HIP_MEMORY_SCOPE_AGENT);
    }
#if !MK_SKELETON
    if (PH(1)) {
        pg8::Gemm g{XN, WIN, T, 7680, 2048, 2048, 2048}; pg8::StaticOrder S; S.init(T, 7680, G, bid, WGM_WIDE);
        pg8::EpiX<0> E{PROJ, PP, nullptr, 0};
        pg8::gemm_phase<pg8::EpiX<0>, pg8::StaticOrder, true, true>(lds, g, S, E);
        pg8::Gemm g2{WIN + (size_t)7680 * 2048, XN, 1024, T, 2048, 2048, 2048}; pg8::StaticOrder S2; S2.init(1024, T, G, bid);
        pg8::EpiX<5> E2{VT, T, nullptr, 0};
        pg8::gemm_phase<pg8::EpiX<5>, pg8::StaticOrder, true, true>(lds, g2, S2, E2);
    }
    xcd_barrier(xbar);
    LocalBar lbar; lbar.w = LBW; lbar.g = (unsigned)(bid & 7); lbar.n = (unsigned)(G / 8);
    lbar.on = (G % 8 == 0) && (__builtin_amdgcn_readfirstlane((int)__hip_atomic_load(&LBW[LB_FLAG], __ATOMIC_RELAXED, __HIP_MEMORY_SCOPE_AGENT)) == 0);
    const int lgw = (bid >> 3) * 8 + wave, lngw = (G / 8) * 8, lgrp = (G % 8 == 0) ? (bid & 7) : -1;
    if (PH(2)) {
        LAS float* tabl = (LAS float*)(lds + 98304);
        for (int i = tid; i < 64 * 32 * 2; i += NTHREADS) tabl[i] = TAB[i];
        __syncthreads();
        qk_norm_rope(P, PROJ, QC, KC, VC, tabl, gw, ngw, lane);
        na::na_phase(PROJ, VT, P.na_rpb, AB, 1024, vcu, G, lds);
        __syncthreads();
    }
    xcd_barrier(xbar);
    if (PH(3)) {
        const int NU = NBATCH * 2 * 64;
        for (int i = 0;; ++i) {
            int u;
            if (G == 256) { if (i >= 6) break; const int x = vcu >> 5, c = vcu & 31; u = (x * 3 + (i >> 1)) * 64 + (i & 1) * 32 + c; }
            else { u = bid + i * G; if (u >= NU) break; }
            const int pair = u >> 6, uu = u & 63, b = pair >> 1, kvh = pair & 1, h = kvh * 4 + (uu >> 4), qb = uu & 15;
            const gqa::bf16* Q = (const gqa::bf16*)(PROJ + ((size_t)b * SEQ + qb * 256) * PP + C_GQ + h * 128);
            const gqa::bf16* Kp = (const gqa::bf16*)(KC + (size_t)b * SEQ * 256 + kvh * 128);
            const gqa::bf16* Vp = (const gqa::bf16*)(VC + (size_t)b * SEQ * 256 + kvh * 128);
            gqa::attn_dense_body<gqa::bf16>(Q, Kp, Vp, (gqa::bf16*)(AB + (size_t)T * 1024 + ((size_t)b * SEQ + qb * 256) * 1024 + h * 128), SEQ, (char*)lds_raw, P.q_norm, TAB, qb * 256);
            __syncthreads();
        }
    }
    xcd_barrier(xbar);
    if (PH(4))
#pragma unroll
    for (int hh = 0; hh < 2; ++hh) { const size_t r0 = (size_t)hh * (T / 2);
        pg8::SegOrder S; S.base.init(T / 2, DM, G, bid, WGM_N8);
        pg8::Gemm g{AB + r0 * 1024, WNA, T / 2, DM, 1024, 1024, 1024, (size_t)T * 1024 * 2, (size_t)DM * 1024 * 2};
        pg8::EpiGate E{MG + r0 * DM, DM, PROJ + r0 * PP + C_GA, PROJ + r0 * PP + C_GB, PP};
        pg8::gemm_phase<pg8::EpiGate, pg8::SegOrder, true, true>(lds, g, S, E);
    }
    xcd_barrier(xbar);
    if (PH(5))
#pragma unroll
    for (int hh = 0; hh < 2; ++hh) { const size_t r0 = (size_t)hh * (T / 2);
        pg8::StaticOrder S; S.init(T / 2, DM, G, bid, WGM_N8);
        pg8::Gemm g{MG + r0 * DM, WMIX, T / 2, DM, DM, DM, DM}; pg8::EpiX<0> E{YB + r0 * DM, DM, nullptr, 0};
        pg8::gemm_phase<pg8::EpiX<0>, pg8::StaticOrder, true, true>(lds, g, S, E);
    }
    seam(xbar, lbar);
    if (PH(6)) { if (lgrp >= 0) row_pass<1>(P, YB, nullptr, X1B, RS2, P.ln_mix_post, lgw, lngw, lgrp); else row_pass<1>(P, YB, nullptr, X1B, RS2, P.ln_mix_post, gw, ngw); }
    seam(xbar, lbar);
    if (PH(7))
#pragma unroll
    for (int half = 0; half < 2; ++half) {
        const size_t r0 = (size_t)half * (T / 2);
        {
            pg8::StaticOrder S; S.init(T / 2, DFF, G, bid, WGM_WIDE);
            pg8::Gemm g{X1B + r0 * DM, WFF1, T / 2, DFF, DM, DM, DM}; pg8::EpiX<1> E{HID, HIDP, nullptr, 0, RS2 + r0};
            pg8::gemm_phase<pg8::EpiX<1>, pg8::StaticOrder, true, true>(lds, g, S, E);
        }
        seam(xbar, lbar);
        {
            pg8::StaticOrder S; S.init(T / 2, DM, G, bid, WGM_N8);
            pg8::Gemm g{HID, WFF2, T / 2, DM, DFF, HIDP, DFF}; pg8::EpiX<0> E{YB + r0 * DM, DM, nullptr, 0};
            pg8::gemm_phase<pg8::EpiX<0>, pg8::StaticOrder, true, true>(lds, g, S, E);
        }
        seam(xbar, lbar);
    }
    if (PH(8)) { if (lgrp >= 0) row_pass<3>(P, YB, X1B, YB, RS3, P.ln_mlp_post, lgw, lngw, lgrp); else row_pass<3>(P, YB, X1B, YB, RS3, P.ln_mlp_post, gw, ngw); }
    seam(xbar, lbar);
    if (PH(9))
#pragma unroll
    for (int hh = 0; hh < 2; ++hh) { const size_t r0 = (size_t)hh * (T / 2);
        pg8::StaticOrder S; S.init(T / 2, DM, G, bid, WGM_N8);
        pg8::Gemm g1{PB + r0 * PLE, WPPJ, T / 2, DM, PLE, PLE, PLE}; pg8::EpiX<0> E1{EP + r0 * DM, DM, nullptr, 0};
        pg8::gemm_phase<pg8::EpiX<0>, pg8::StaticOrder, true, true>(lds, g1, S, E1);
        pg8::Gemm g2{YB + r0 * DM, WPG, T / 2, DM, DM, DM, DM}; pg8::EpiX<4> E2{EP + r0 * DM, DM, nullptr, 0, RS3 + r0};
        pg8::gemm_phase<pg8::EpiX<4>, pg8::StaticOrder, true, true>(lds, g2, S, E2);
    }
    xcd_barrier(xbar);
    if (PH(10)) { if (lgrp >= 0) row_pass<2>(P, EP, YB, nullptr, nullptr, P.ln_ple_post, lgw, lngw, lgrp); else row_pass<2>(P, EP, YB, nullptr, nullptr, P.ln_ple_post, gw, ngw); }
#else
    for (int k = 0; k < 12; ++k) {
        for (size_t i = (size_t)bid * NTHREADS + tid; i < (size_t)T * DM / 64; i += (size_t)G * NTHREADS) P.out[i * 64 + k] = (float)k;
        xcd_barrier(xbar);
    }
#endif
}

#undef tid
#undef lane
extern "C" void kernel_launch(void* const* d_in, const int* in_sizes, int n_in, void* d_out, int out_size, void* d_ws, size_t ws_size, hipStream_t stream) {
    static int grid = 0;
    if (grid == 0) {
        if (n_in != 21 || out_size != T * DM || ws_size < WS_END) { fprintf(stderr, "kernel_launch: unexpected shapes: n_in %d out %d ws %zu (need >= %zu)\n", n_in, out_size, ws_size, (size_t)WS_END); grid = -1; return; }
        int dev = 0, cus = 0, per_cu = 0;
        if (hipGetDevice(&dev) != hipSuccess || hipDeviceGetAttribute(&cus, hipDeviceAttributeMultiprocessorCount, dev) != hipSuccess) { fprintf(stderr, "kernel_launch: device query failed\n"); grid = -1; return; }
        if (hipFuncSetAttribute((const void*)fwd_megakernel, hipFuncAttributeMaxDynamicSharedMemorySize, LDS_BYTES) != hipSuccess) { fprintf(stderr, "kernel_launch: hipFuncSetAttribute failed\n"); grid = -1; return; }
        if (hipOccupancyMaxActiveBlocksPerMultiprocessor(&per_cu, (const void*)fwd_megakernel, NTHREADS, LDS_BYTES) != hipSuccess || per_cu < 1) { fprintf(stderr, "kernel_launch: occupancy query says %d\n", per_cu); per_cu = 1; }
        (void)hipGetLastError();
        grid = cus * per_cu;
    }
    if (grid < 0) return;
    Params p{};
    p.x_p = (const float*)d_in[0]; p.x_s = (const float*)d_in[1]; p.p_p = (const float*)d_in[2]; p.p_s = (const float*)d_in[3];
    p.ln_mix_pre = (const float*)d_in[4]; p.w_in = (const float*)d_in[5]; p.q_norm = (const float*)d_in[6]; p.k_norm = (const float*)d_in[7]; p.na_rpb = (const float*)d_in[8];
    p.w_na = (const float*)d_in[9]; p.w_gqa = (const float*)d_in[10]; p.w_mix = (const float*)d_in[11]; p.ln_mix_post = (const float*)d_in[12]; p.ln_mlp_pre = (const float*)d_in[13];
    p.w_ff1 = (const float*)d_in[14]; p.w_ff2 = (const float*)d_in[15]; p.ln_mlp_post = (const float*)d_in[16]; p.ln_ple_pre = (const float*)d_in[17];
    p.w_ple_gate = (const float*)d_in[18]; p.w_ple_proj = (const float*)d_in[19]; p.ln_ple_post = (const float*)d_in[20];
    p.out = (float*)d_out; p.ws = (unsigned char*)d_ws;
    void* args[] = {&p};
    const hipError_t e = hipLaunchCooperativeKernel((const void*)fwd_megakernel, dim3(grid), dim3(NTHREADS), args, LDS_BYTES, stream);
    if (e != hipSuccess) fprintf(stderr, "kernel_launch: cooperative launch failed: %s (grid %d)\n", hipGetErrorString(e), grid);
}
```
